# Optimizing an MI355X kernel written in HIP

```python
import jax, jax.numpy as jnp
from jax import lax
import numpy as np

D_MODEL = 1024
BATCH = 8
SEQ = 2048
DEPTH = 4
DEC_BATCH = 128
DEC_SEQ = 1
PAST_LEN = 8192
PAGE_SIZE = 128

HEAD_DIM = 64
N_HEADS = 8
N_KV = 2
GQA_G = N_HEADS // N_KV
WINDOW = 128
BLK = WINDOW
ROPE_THETA = 10000.0
R_HEADS = 4
R_DK = 128
R_DV = 128
HGRN_CHUNK = 64
ATTN_W = N_HEADS * HEAD_DIM
KV_W = N_KV * HEAD_DIM
R_KW = R_HEADS * R_DK
R_VW = R_HEADS * R_DV
MIX_W = ATTN_W + R_VW
P_IN = ATTN_W + 2 * KV_W + 2 * R_KW + 2 * R_VW
N_MEM = 256
X_HEADS = 4
X_HEAD_DIM = D_MODEL // X_HEADS
D_FF = 2816
CONV_W = 3
EPS = 1e-6

kernel_name = 'hymba_swa_hgrn2_memxattn_convffn_step'


def rms_norm(x, g):
    x32 = x.astype(jnp.float32)
    y = x32 * lax.rsqrt(jnp.mean(x32 * x32, axis=-1, keepdims=True) + EPS)
    return (y * g.astype(jnp.float32)).astype(x.dtype)


def rope(x, pos):
    half = HEAD_DIM // 2
    inv_freq = ROPE_THETA ** (-jnp.arange(half, dtype=jnp.float32) / half)
    ang = pos.astype(jnp.float32)[:, None] * inv_freq[None, :]
    cos = jnp.cos(ang)[None, :, None, :]
    sin = jnp.sin(ang)[None, :, None, :]
    x32 = x.astype(jnp.float32)
    x1, x2 = x32[..., :half], x32[..., half:]
    return jnp.concatenate([x1 * cos - x2 * sin, x2 * cos + x1 * sin], axis=-1).astype(x.dtype)


def sink_attention(q, k, v, mask, sink):
    s = jnp.einsum('...qkgd,...skd->...kgqs', q.astype(jnp.float32), k.astype(jnp.float32)) * (HEAD_DIM ** -0.5)
    s = jnp.where(mask, s, -jnp.inf)
    sk = sink.astype(jnp.float32)[..., None, None]
    m = jnp.maximum(jnp.max(s, axis=-1, keepdims=True), sk)
    p = jnp.exp(s - m)
    p = p / (jnp.sum(p, axis=-1, keepdims=True) + jnp.exp(sk - m))
    return jnp.einsum('...kgqs,...skd->...qkgd', p, v.astype(jnp.float32))


def swa_prompt(q, k, v, sink):
    B, L = q.shape[0], q.shape[1]
    nb = L // BLK
    qb = q.reshape(B, nb, BLK, N_KV, GQA_G, HEAD_DIM)
    pad = ((0, 0), (BLK, 0), (0, 0), (0, 0))
    kp = jnp.pad(k, pad).reshape(B, nb + 1, BLK, N_KV, HEAD_DIM)
    vp = jnp.pad(v, pad).reshape(B, nb + 1, BLK, N_KV, HEAD_DIM)
    kb = jnp.concatenate([kp[:, :-1], kp[:, 1:]], axis=2)
    vb = jnp.concatenate([vp[:, :-1], vp[:, 1:]], axis=2)
    qpos = jnp.arange(nb)[:, None] * BLK + jnp.arange(BLK)[None, :]
    kpos = jnp.arange(nb)[:, None] * BLK - BLK + jnp.arange(2 * BLK)[None, :]
    diff = qpos[:, :, None] - kpos[:, None, :]
    mask = (diff >= 0) & (diff <= WINDOW) & (kpos[:, None, :] >= 0)
    mask = mask[None, :, None, None]
    o = sink_attention(qb, kb, vb, mask, sink.reshape(N_KV, GQA_G))
    return o.reshape(B, L, ATTN_W)


def swa_sample(q, k, v, buf_k, buf_v, pos, sink):
    DB, L = q.shape[0], q.shape[1]
    W = buf_k.shape[1]
    kk = jnp.concatenate([buf_k.astype(k.dtype), k], axis=1)
    vv = jnp.concatenate([buf_v.astype(v.dtype), v], axis=1)
    kpos = jnp.concatenate([pos[0] - W + jnp.arange(W, dtype=jnp.int32), pos])
    diff = pos[:, None] - kpos[None, :]
    mask = (diff >= 0) & (diff <= WINDOW)
    o = sink_attention(q.reshape(DB, L, N_KV, GQA_G, HEAD_DIM), kk, vv, mask, sink.reshape(N_KV, GQA_G))
    return o.reshape(DB, L, ATTN_W)


def hgrn_chunked(q, g, k, v, s0, chunk):
    B, L = q.shape[0], q.shape[1]
    n = L // chunk

    def to_chunks(t):
        return jnp.moveaxis(t.reshape(B, n, chunk, t.shape[2], t.shape[3]), 1, 0)

    tril = jnp.tril(jnp.ones((chunk, chunk), dtype=bool))[None, :, :, None, None]

    def step(S, inp):
        qc, gc, kc, vc = inp
        b = jnp.cumsum(gc, axis=1)
        dec = jnp.exp(jnp.where(tril, b[:, :, None] - b[:, None, :], -jnp.inf))
        att = jnp.einsum('btshk,bshk->bhts', qc[:, :, None] * dec, kc)
        o = jnp.einsum('bhts,bshv->bthv', att, vc) + jnp.einsum('bthk,bhkv->bthv', qc * jnp.exp(b), S)
        b_last = b[:, -1]
        S = jnp.exp(b_last)[..., None] * S + jnp.einsum('bshk,bshv->bhkv', kc * jnp.exp(b_last[:, None] - b), vc)
        return S, o

    S, o = lax.scan(step, s0, (to_chunks(q), to_chunks(g), to_chunks(k), to_chunks(v)))
    o = jnp.moveaxis(o, 0, 1).reshape(B, L, R_HEADS, R_DV)
    return o, S


def hgrn_branch(qr, fr, ir, gr, lb_l, gn_l, s0, chunk):
    B, L = qr.shape[0], qr.shape[1]
    lb = lb_l.reshape(R_HEADS, R_DK)
    z = fr.astype(jnp.float32).reshape(B, L, R_HEADS, R_DK)
    logf = jnp.logaddexp(jnp.log(lb), jnp.log1p(-lb) + jax.nn.log_sigmoid(z))
    k = (1.0 - lb) * jax.nn.sigmoid(-z)
    q = jax.nn.silu(qr.astype(jnp.float32)).reshape(B, L, R_HEADS, R_DK)
    v = ir.astype(jnp.float32).reshape(B, L, R_HEADS, R_DV)
    o, S = hgrn_chunked(q, logf, k, v, s0, chunk)
    o = o * lax.rsqrt(jnp.mean(o * o, axis=-1, keepdims=True) + EPS) * gn_l.astype(jnp.float32).reshape(R_HEADS, R_DV)
    o = o.reshape(B, L, R_VW) * jax.nn.silu(gr.astype(jnp.float32))
    return o, S


def token_mixer(h, pos, w_in_l, w_o_l, sink_l, lb_l, gn_l, s0, chunk, buf_k, buf_v):
    B, L = h.shape[0], h.shape[1]
    proj = h @ w_in_l
    offs = [ATTN_W, ATTN_W + KV_W, ATTN_W + 2 * KV_W, ATTN_W + 2 * KV_W + R_KW,
            ATTN_W + 2 * KV_W + 2 * R_KW, ATTN_W + 2 * KV_W + 2 * R_KW + R_VW]
    qa, ka, va, qr, fr, ir, gr = jnp.split(proj, offs, axis=-1)
    qa = rope(qa.reshape(B, L, N_HEADS, HEAD_DIM), pos)
    ka = rope(ka.reshape(B, L, N_KV, HEAD_DIM), pos)
    va = va.reshape(B, L, N_KV, HEAD_DIM)
    if buf_k is None:
        attn = swa_prompt(qa, ka, va, sink_l)
    else:
        attn = swa_sample(qa, ka, va, buf_k, buf_v, pos, sink_l)
    rec, S = hgrn_branch(qr, fr, ir, gr, lb_l, gn_l, s0, chunk)
    mixed = jnp.concatenate([attn, rec], axis=-1).astype(h.dtype) @ w_o_l
    return mixed, ka, va, S


def cross_attention(h, mk, mv, w_xq_l, w_xo_l):
    B, L = h.shape[0], h.shape[1]
    q = (h @ w_xq_l).reshape(B, L, X_HEADS, X_HEAD_DIM)
    s = jnp.einsum('bqhd,bmhd->bhqm', q.astype(jnp.float32), mk.astype(jnp.float32)) * (X_HEAD_DIM ** -0.5)
    p = jax.nn.softmax(s, axis=-1)
    o = jnp.einsum('bhqm,bmhd->bqhd', p, mv.astype(jnp.float32))
    return o.reshape(B, L, D_MODEL).astype(h.dtype) @ w_xo_l


def conv_ffn(h, w_up_l, conv_w_l, conv_b_l, w_down_l, buf):
    u = h @ w_up_l
    L = u.shape[1]
    up = jnp.concatenate([buf.astype(u.dtype), u], axis=1)
    c = conv_b_l
    for j in range(CONV_W):
        c = c + up[:, j:j + L] * conv_w_l[j]
    a, b = jnp.split(c, 2, axis=-1)
    y = (jax.nn.silu(a) * b) @ w_down_l
    return y, up[:, -(CONV_W - 1):]


def setup_inputs(seed: int = 0) -> dict:
    key = jax.random.key(seed)
    ks = jax.random.split(key, 32)
    nrm = jax.random.normal
    f32 = jnp.float32
    w_buf = min(WINDOW, PAST_LEN)

    def gain(k, shape):
        return 1.0 + 0.05 * nrm(k, shape, f32)

    return {
        'x_prompt': nrm(ks[0], (BATCH, SEQ, D_MODEL), f32),
        'x_sample': nrm(ks[1], (DEC_BATCH, DEC_SEQ, D_MODEL), f32),
        'cache_win_k': nrm(ks[2], (DEPTH, DEC_BATCH, w_buf, N_KV, HEAD_DIM), f32),
        'cache_win_v': nrm(ks[3], (DEPTH, DEC_BATCH, w_buf, N_KV, HEAD_DIM), f32),
        'cache_mem_k': nrm(ks[4], (DEPTH, DEC_BATCH, N_MEM, X_HEADS, X_HEAD_DIM), f32),
        'cache_mem_v': nrm(ks[5], (DEPTH, DEC_BATCH, N_MEM, X_HEADS, X_HEAD_DIM), f32),
        'state_hgrn': 0.3 * nrm(ks[6], (DEPTH, DEC_BATCH, R_HEADS, R_DK, R_DV), f32),
        'cache_ffn_conv': nrm(ks[7], (DEPTH, DEC_BATCH, CONV_W - 1, 2 * D_FF), f32),
        'mem_prompt': nrm(ks[8], (BATCH, N_MEM, D_MODEL), f32),
        'w_in': nrm(ks[9], (DEPTH, D_MODEL, P_IN), f32) * D_MODEL ** -0.5,
        'w_o': nrm(ks[10], (DEPTH, MIX_W, D_MODEL), f32) * MIX_W ** -0.5,
        'attn_sinks': 0.5 * nrm(ks[11], (DEPTH, N_HEADS), f32),
        'lb_logits': 0.5 * nrm(ks[12], (DEPTH, R_KW), f32),
        'hgrn_norm': gain(ks[13], (DEPTH, R_VW)),
        'w_xq': nrm(ks[14], (DEPTH, D_MODEL, D_MODEL), f32) * D_MODEL ** -0.5,
        'w_xk': nrm(ks[15], (DEPTH, D_MODEL, D_MODEL), f32) * D_MODEL ** -0.5,
        'w_xv': nrm(ks[16], (DEPTH, D_MODEL, D_MODEL), f32) * D_MODEL ** -0.5,
        'w_xo': nrm(ks[17], (DEPTH, D_MODEL, D_MODEL), f32) * D_MODEL ** -0.5,
        'w_up': nrm(ks[18], (DEPTH, D_MODEL, 2 * D_FF), f32) * D_MODEL ** -0.5,
        'conv_w': nrm(ks[19], (DEPTH, CONV_W, 2 * D_FF), f32) * CONV_W ** -0.5,
        'conv_b': 0.02 * nrm(ks[20], (DEPTH, 2 * D_FF), f32),
        'w_down': nrm(ks[21], (DEPTH, D_FF, D_MODEL), f32) * D_FF ** -0.5,
        'g_pre_mix': gain(ks[22], (DEPTH, D_MODEL)),
        'g_post_mix': gain(ks[23], (DEPTH, D_MODEL)),
        'g_pre_x': gain(ks[24], (DEPTH, D_MODEL)),
        'g_post_x': gain(ks[25], (DEPTH, D_MODEL)),
        'g_mem': gain(ks[26], (DEPTH, D_MODEL)),
        'g_pre_ffn': gain(ks[27], (DEPTH, D_MODEL)),
        'g_post_ffn': gain(ks[28], (DEPTH, D_MODEL)),
    }


def reference(x_prompt, x_sample, cache_win_k, cache_win_v, cache_mem_k, cache_mem_v, state_hgrn, cache_ffn_conv,
              mem_prompt, w_in, w_o, attn_sinks, lb_logits, hgrn_norm, w_xq, w_xk, w_xv, w_xo, w_up, conv_w, conv_b,
              w_down, g_pre_mix, g_post_mix, g_pre_x, g_post_x, g_mem, g_pre_ffn, g_post_ffn):
    c = jnp.cumsum(jax.nn.softmax(lb_logits.astype(jnp.float32), axis=0), axis=0)
    lb = c - c[0:1]

    xp, xs = x_prompt, x_sample
    Bp, Lp = xp.shape[0], xp.shape[1]
    Ls = xs.shape[1]
    pos_p = jnp.arange(Lp, dtype=jnp.int32)
    pos_s = PAST_LEN + jnp.arange(Ls, dtype=jnp.int32)
    n_keep = min(WINDOW, Lp)
    chunk_p = min(HGRN_CHUNK, Lp)

    wkp, wvp, wks, wvs, mkp, mvp, hsp, hss, cvp, cvs = [], [], [], [], [], [], [], [], [], []
    for l in range(DEPTH):
        mp, kp_, vp_, Sp = token_mixer(rms_norm(xp, g_pre_mix[l]), pos_p, w_in[l], w_o[l], attn_sinks[l], lb[l],
                                       hgrn_norm[l], jnp.zeros((Bp, R_HEADS, R_DK, R_DV), jnp.float32), chunk_p,
                                       None, None)
        xp = xp + rms_norm(mp, g_post_mix[l])
        ms, ks_, vs_, Ss = token_mixer(rms_norm(xs, g_pre_mix[l]), pos_s, w_in[l], w_o[l], attn_sinks[l], lb[l],
                                       hgrn_norm[l], state_hgrn[l].astype(jnp.float32), Ls,
                                       cache_win_k[l], cache_win_v[l])
        xs = xs + rms_norm(ms, g_post_mix[l])
        wkp.append(kp_[:, -n_keep:])
        wvp.append(vp_[:, -n_keep:])
        wks.append(ks_)
        wvs.append(vs_)
        hsp.append(Sp.astype(x_prompt.dtype))
        hss.append(Ss.astype(state_hgrn.dtype))

        hm = rms_norm(mem_prompt, g_mem[l])
        mk = (hm @ w_xk[l]).reshape(Bp, N_MEM, X_HEADS, X_HEAD_DIM)
        mv = (hm @ w_xv[l]).reshape(Bp, N_MEM, X_HEADS, X_HEAD_DIM)
        xp = xp + rms_norm(cross_attention(rms_norm(xp, g_pre_x[l]), mk, mv, w_xq[l], w_xo[l]), g_post_x[l])
        xs = xs + rms_norm(cross_attention(rms_norm(xs, g_pre_x[l]), cache_mem_k[l], cache_mem_v[l], w_xq[l],
                                           w_xo[l]), g_post_x[l])
        mkp.append(mk)
        mvp.append(mv)

        fp, bufp = conv_ffn(rms_norm(xp, g_pre_ffn[l]), w_up[l], conv_w[l], conv_b[l], w_down[l],
                            jnp.zeros((Bp, CONV_W - 1, 2 * D_FF), xp.dtype))
        xp = xp + rms_norm(fp, g_post_ffn[l])
        fs, bufs = conv_ffn(rms_norm(xs, g_pre_ffn[l]), w_up[l], conv_w[l], conv_b[l], w_down[l], cache_ffn_conv[l])
        xs = xs + rms_norm(fs, g_post_ffn[l])
        cvp.append(bufp)
        cvs.append(bufs)

    y_prompt, y_sample = xp, xs
    win_k_prompt, win_v_prompt = jnp.stack(wkp), jnp.stack(wvp)
    win_k_sample, win_v_sample = jnp.stack(wks), jnp.stack(wvs)
    mem_k_prompt, mem_v_prompt = jnp.stack(mkp), jnp.stack(mvp)
    hgrn_prompt, hgrn_sample = jnp.stack(hsp), jnp.stack(hss)
    conv_prompt, conv_sample = jnp.stack(cvp), jnp.stack(cvs)
    return (y_prompt, y_sample, win_k_prompt, win_v_prompt, win_k_sample, win_v_sample, mem_k_prompt, mem_v_prompt,
            hgrn_prompt, hgrn_sample, conv_prompt, conv_sample)
```

```cpp
#include <hip/hip_runtime.h>
#include <cstdio>
#include <cstdint>
#include <cmath>
namespace pg8 {
#define PG8_LAS __attribute__((address_space(3)))
typedef unsigned short bf16_t;
typedef short bf16x8 __attribute__((ext_vector_type(8)));
typedef float f32x4 __attribute__((ext_vector_type(4)));
typedef unsigned u32x4 __attribute__((ext_vector_type(4)));
constexpr int BM = 256, BK = 64, HALF = 128, HTB = HALF * BK * 2  , STAGE_BYTES = 8 * HTB, NXCD = 8, WGM = 8;

__host__ __device__ __forceinline__ int lds_byte(int r, int c) { const int st = (r >> 4) * 2 + (c >> 5), rr = r & 15, cc = c & 31, ob = rr * 64 + cc * 2; return st * 1024 + (ob ^ (((ob >> 9) & 1) << 5)); }
__host__ __device__ __forceinline__ void stage_rc(int b, int& R, int& C) { const int st = b / 1024, sb = b % 1024, swz = sb ^ (((sb >> 9) & 1) << 5); R = (st >> 1) * 16 + swz / 64; C = (st & 1) * 32 + (swz % 64) / 2; }
__host__ __device__ __forceinline__ int perm32(int rho) { const int n = rho >> 4, i = rho & 15; return 8 * (i >> 2) + 4 * n + (i & 3); }

struct Unit { int pm, pn; };
struct Gemm { const bf16_t* A; const bf16_t* Bt; int M, N, K; };

struct StaticOrder {
    int nM, nN, nwg, G, c;
    __host__ __device__ void init(int M, int N, int G_, int c_) { nM = M / BM; nN = N / BM; nwg = nM * nN; G = G_; c = c_; }
    __host__ __device__ bool next(int i, Unit& u) const {
        const long L = (long)i * G + c; if (L >= nwg) return false;
        int wgid = (int)L; { const int q = nwg / NXCD, r = nwg % NXCD, xcd = wgid % NXCD, off = wgid / NXCD; wgid = (xcd < r ? xcd * (q + 1) : r * (q + 1) + (xcd - r) * q) + off; }
        const int nig = WGM * nN, gid = wgid / nig, fm = gid * WGM, gsz = (nM - fm) < WGM ? (nM - fm) : WGM;
        u.pm = fm + ((wgid % nig) % gsz); u.pn = (wgid % nig) / gsz; return true;
    }
    __device__ __forceinline__ void a_ready(const Unit&) const {}
    __device__ __forceinline__ void done(const Unit&) const {}
};

__device__ __forceinline__ unsigned cvt_pk_bf16(float lo, float hi) { unsigned r; asm volatile("v_cvt_pk_bf16_f32 %0, %1, %2" : "=v"(r) : "v"(lo), "v"(hi)); return r; }
typedef float f32x2 __attribute__((ext_vector_type(2)));
template <class Epi, class Sched, bool ALIGN_EPI = false, bool SP2 = false>
__device__ __forceinline__ void gemm_phase(PG8_LAS unsigned char* lds, const Gemm g, const Sched& S, const Epi& E, int wave_) {
    int tid_ = (int)__builtin_amdgcn_mbcnt_hi(~0u, __builtin_amdgcn_mbcnt_lo(~0u, 0u)) + 64 * wave_; asm volatile("" : "+v"(tid_));
    const int tid = tid_, wid = __builtin_amdgcn_readfirstlane(tid >> 6), lane = tid & 63, wr = wid >> 2, wc = wid & 3, fr = lane & 15, fq = lane >> 4;
    const int K = g.K, nt = K / BK;
    unsigned voffA[2], voffB[2];
#pragma unroll
    for (int i = 0; i < 2; ++i) { int R, C; stage_rc(tid * 16 + i * 8192, R, C); const int Rb = Epi::PERM ? ((R & ~31) + perm32(R & 31)) : R;
        voffA[i] = (unsigned)(R * K + C) * 2u; voffB[i] = (unsigned)(Rb * K + C) * 2u; }
    const size_t kstep = (size_t)(BK * 2);
    const size_t hstep = (size_t)HALF * K * 2;
    const size_t tstep = 2 * hstep;
    const unsigned ldsw = (unsigned)wid * 1024u;
    const int aoff = lds_byte(wr * 64 + fr, fq * 8), boff = lds_byte(wc * 32 + fr, fq * 8);
#define PG8_SA(b, h) (((b) * 2 + (h)) * HTB)
#define PG8_SB(b, h) ((4 + (b) * 2 + (h)) * HTB)
#define PG8_STAGE(bufoff, gbase, voff) do { _Pragma("unroll") for (int _i = 0; _i < 2; ++_i) \
        __builtin_amdgcn_global_load_lds((const unsigned*)((const char*)(gbase) + (voff)[_i]), (PG8_LAS unsigned*)(lds + (bufoff) + ldsw + _i * 8192), 16, 0, 0); } while (0)
#define PG8_LDA(dst, b, h) do { _Pragma("unroll") for (int m = 0; m < 4; ++m) _Pragma("unroll") for (int k = 0; k < 2; ++k) dst[m][k] = *(const PG8_LAS bf16x8*)(lds + PG8_SA(b, h) + aoff + m * 2048 + k * 1024); } while (0)
#define PG8_LDB(dst, b, h) do { _Pragma("unroll") for (int n = 0; n < 2; ++n) _Pragma("unroll") for (int k = 0; k < 2; ++k) dst[n][k] = *(const PG8_LAS bf16x8*)(lds + PG8_SB(b, h) + boff + n * 2048 + k * 1024); } while (0)
#define PG8_MMA(ai, bj, At, Bt) do { __builtin_amdgcn_s_setprio(1); _Pragma("unroll") for (int m = 0; m < 4; ++m) _Pragma("unroll") for (int n = 0; n < 2; ++n) _Pragma("unroll") for (int k = 0; k < 2; ++k) \
        acc[ai][bj][m][n] = __builtin_amdgcn_mfma_f32_16x16x32_bf16(Bt[n][k], At[m][k], acc[ai][bj][m][n], 0, 0, 0); __builtin_amdgcn_s_setprio(0); } while (0)
#define PG8_WAIT_V(n) asm volatile("s_waitcnt vmcnt(" #n ")" ::: "memory")
#define PG8_WAIT_L(n) asm volatile("s_waitcnt lgkmcnt(" #n ")" ::: "memory")
#define PG8_BAR __builtin_amdgcn_s_barrier()
#define PG8_SCHED __builtin_amdgcn_sched_barrier(0)
    Unit cur, nxt; int ui = 0;
    if (!S.next(0, cur)) return;
    f32x4 acc[2][2][4][2];
#pragma unroll
    for (int a = 0; a < 2; ++a)
#pragma unroll
        for (int b = 0; b < 2; ++b)
#pragma unroll
            for (int m = 0; m < 4; ++m)
#pragma unroll
                for (int n = 0; n < 2; ++n) acc[a][b][m][n] = (f32x4){0.f, 0.f, 0.f, 0.f};
    bf16x8 At[4][2], B0[2][2], B1[2][2];
    const char* cA = (const char*)g.A + (size_t)cur.pm * tstep; const char* cB = (const char*)g.Bt + (size_t)cur.pn * tstep;
    S.a_ready(cur);
    if constexpr (SP2) {
        PG8_STAGE(PG8_SB(0, 0), cB, voffB); PG8_STAGE(PG8_SB(0, 1), cB + hstep, voffB); PG8_STAGE(PG8_SA(0, 0), cA, voffA); PG8_STAGE(PG8_SA(0, 1), cA + hstep, voffA);
        if (wr == 1) PG8_BAR;
        PG8_WAIT_V(2); PG8_BAR;
        PG8_STAGE(PG8_SB(1, 0), cB + kstep, voffB); PG8_STAGE(PG8_SA(1, 0), cA + kstep, voffA); PG8_STAGE(PG8_SB(1, 1), cB + hstep + kstep, voffB);
        PG8_WAIT_V(6); PG8_BAR;
    } else {
        PG8_STAGE(PG8_SB(0, 0), cB, voffB); PG8_STAGE(PG8_SA(0, 0), cA, voffA); PG8_STAGE(PG8_SB(0, 1), cB + hstep, voffB); PG8_STAGE(PG8_SA(0, 1), cA + hstep, voffA);
        if (wr == 1) PG8_BAR;
        PG8_WAIT_V(4); PG8_BAR;
        PG8_STAGE(PG8_SB(1, 0), cB + kstep, voffB); PG8_STAGE(PG8_SA(1, 0), cA + kstep, voffA); PG8_STAGE(PG8_SB(1, 1), cB + hstep + kstep, voffB);
        PG8_WAIT_V(6); PG8_BAR;
    }
    for (;;) {
        const bool has_next = S.next(ui + 1, nxt);
        const char* nA = has_next ? (const char*)g.A + (size_t)nxt.pm * tstep : cA; const char* nB = has_next ? (const char*)g.Bt + (size_t)nxt.pn * tstep : cB;
        for (int t = 0; t < nt; t += 2) {
            const bool last = (t == nt - 2);
            const char* a1 = cA + (size_t)(t + 1) * kstep;
            const char* a2 = last ? nA : cA + (size_t)(t + 2) * kstep; const char* b2 = last ? nB : cB + (size_t)(t + 2) * kstep;
            const char* a3 = a2 + kstep; const char* b3 = b2 + kstep;
            if (last && has_next) S.a_ready(nxt);
            if constexpr (SP2) {
            PG8_LDB(B0, 0, 0); PG8_LDB(B1, 0, 1); PG8_SCHED; PG8_LDA(At, 0, 0); PG8_STAGE(PG8_SA(1, 1), a1 + hstep, voffA);
            PG8_WAIT_V(8); PG8_WAIT_L(0); PG8_BAR; PG8_MMA(0, 0, At, B0); PG8_MMA(0, 1, At, B1); PG8_BAR; PG8_SCHED;
            PG8_LDA(At, 0, 1); PG8_STAGE(PG8_SB(0, 0), b2, voffB); PG8_STAGE(PG8_SB(0, 1), b2 + hstep, voffB); PG8_STAGE(PG8_SA(0, 0), a2, voffA);
            PG8_WAIT_V(8); PG8_WAIT_L(0); PG8_BAR; PG8_MMA(1, 0, At, B0); PG8_MMA(1, 1, At, B1); PG8_BAR; PG8_SCHED;
            PG8_LDB(B0, 1, 0); PG8_LDB(B1, 1, 1); PG8_SCHED; PG8_LDA(At, 1, 0); PG8_STAGE(PG8_SA(0, 1), a2 + hstep, voffA);
            PG8_WAIT_V(8); PG8_WAIT_L(0); PG8_BAR; PG8_MMA(0, 0, At, B0); PG8_MMA(0, 1, At, B1); PG8_BAR; PG8_SCHED;
            PG8_LDA(At, 1, 1); PG8_STAGE(PG8_SB(1, 0), b3, voffB); PG8_STAGE(PG8_SB(1, 1), b3 + hstep, voffB); PG8_STAGE(PG8_SA(1, 0), a3, voffA);
            PG8_WAIT_V(8); PG8_WAIT_L(0); PG8_BAR; PG8_MMA(1, 0, At, B0); PG8_MMA(1, 1, At, B1); PG8_BAR; PG8_SCHED;
            } else {
            PG8_LDB(B0, 0, 0); PG8_SCHED; PG8_LDA(At, 0, 0); PG8_STAGE(PG8_SA(1, 1), a1 + hstep, voffA);
            PG8_WAIT_L(8); PG8_BAR; PG8_WAIT_L(0); PG8_MMA(0, 0, At, B0); PG8_BAR; PG8_SCHED;
            PG8_LDB(B1, 0, 1); PG8_STAGE(PG8_SB(0, 0), b2, voffB);
            PG8_BAR; PG8_WAIT_L(0); PG8_MMA(0, 1, At, B1); PG8_BAR;
            PG8_LDA(At, 0, 1); PG8_STAGE(PG8_SA(0, 0), a2, voffA);
            PG8_BAR; PG8_WAIT_L(0); PG8_MMA(1, 0, At, B0); PG8_BAR; PG8_SCHED;
            PG8_STAGE(PG8_SB(0, 1), b2 + hstep, voffB);
            PG8_WAIT_V(6); PG8_BAR; PG8_MMA(1, 1, At, B1); PG8_BAR;
            PG8_LDB(B0, 1, 0); PG8_SCHED; PG8_LDA(At, 1, 0); PG8_STAGE(PG8_SA(0, 1), a2 + hstep, voffA);
            PG8_WAIT_L(8); PG8_BAR; PG8_WAIT_L(0); PG8_MMA(0, 0, At, B0); PG8_BAR; PG8_SCHED;
            PG8_LDB(B1, 1, 1); PG8_STAGE(PG8_SB(1, 0), b3, voffB);
            PG8_BAR; PG8_WAIT_L(0); PG8_MMA(0, 1, At, B1); PG8_BAR;
            PG8_LDA(At, 1, 1); PG8_STAGE(PG8_SA(1, 0), a3, voffA);
            PG8_BAR; PG8_WAIT_L(0); PG8_MMA(1, 0, At, B0); PG8_BAR; PG8_SCHED;
            PG8_STAGE(PG8_SB(1, 1), b3 + hstep, voffB);
            PG8_WAIT_V(6); PG8_BAR; PG8_MMA(1, 1, At, B1); PG8_BAR;
            }
        }
        if constexpr (ALIGN_EPI) { if (wr == 0) PG8_BAR; }
        if constexpr (!Epi::AFTER_DRAIN) { E(acc, cur, wr, wc, fr, fq); S.done(cur); }
        if (!has_next) break;
#pragma unroll
        for (int a = 0; a < 2; ++a)
#pragma unroll
            for (int b = 0; b < 2; ++b)
#pragma unroll
                for (int m = 0; m < 4; ++m)
#pragma unroll
                    for (int n = 0; n < 2; ++n) acc[a][b][m][n] = (f32x4){0.f, 0.f, 0.f, 0.f};
        cur = nxt; cA = nA; cB = nB; ++ui;
        if constexpr (ALIGN_EPI) { if (wr == 1) PG8_BAR; }
    }
    PG8_WAIT_V(0);
    if constexpr (!ALIGN_EPI) { if (wr == 0) PG8_BAR; }
    PG8_BAR;
    if constexpr (Epi::AFTER_DRAIN) { E.fused(acc, cur, wr, wc, fr, fq, lds, wid, lane); S.done(cur); }
#undef PG8_SA
#undef PG8_SB
#undef PG8_STAGE
#undef PG8_LDA
#undef PG8_LDB
#undef PG8_MMA
#undef PG8_WAIT_V
#undef PG8_WAIT_L
#undef PG8_BAR
#undef PG8_SCHED
}
}

#define GAS __attribute__((address_space(1)))
#define LAS __attribute__((address_space(3)))
typedef unsigned short bf16;
typedef unsigned v4u __attribute__((ext_vector_type(4)));
typedef unsigned v2u __attribute__((ext_vector_type(2)));
typedef float f32x4 __attribute__((ext_vector_type(4)));
typedef float f32x2 __attribute__((ext_vector_type(2)));
typedef short bf16x8 __attribute__((ext_vector_type(8)));
typedef float f32x16 __attribute__((ext_vector_type(16)));
#define RLX_AGENT __ATOMIC_RELAXED, __HIP_MEMORY_SCOPE_AGENT
#define LDS_WAIT() asm volatile("s_waitcnt lgkmcnt(0)" ::: "memory")
#define VM_WAIT() asm volatile("s_waitcnt vmcnt(0)" ::: "memory")

constexpr int NWAVES = 8, NTHR = 512, GRID = 256;
constexpr int DM = 1024, NB = 8, SEQ = 2048, DEPTH = 4, DB = 128;
constexpr int MP = NB * SEQ;
constexpr int MS = DB;
constexpr int MR = MP + MS;
constexpr int MT = 16640;
constexpr int PIN = 2816, DFF = 2816, UPW = 5632;
constexpr int C_K = 512, C_V = 640, C_QR = 768, C_FR = 1280, C_IR = 1792, C_GR = 2304;
constexpr int NMEM = 256, XH = 4, XHD = 256;
constexpr int WIN = 128, PAST = 8192;
constexpr float EPS = 1e-6f;

constexpr size_t O_YP = 0;
constexpr size_t O_YS = O_YP + (size_t)MP * DM;
constexpr size_t O_WKP = O_YS + (size_t)MS * DM;
constexpr size_t O_WVP = O_WKP + (size_t)DEPTH * NB * 128 * 128;
constexpr size_t O_WKS = O_WVP + (size_t)DEPTH * NB * 128 * 128;
constexpr size_t O_WVS = O_WKS + (size_t)DEPTH * DB * 128;
constexpr size_t O_MKP = O_WVS + (size_t)DEPTH * DB * 128;
constexpr size_t O_MVP = O_MKP + (size_t)DEPTH * NB * NMEM * DM;
constexpr size_t O_HP = O_MVP + (size_t)DEPTH * NB * NMEM * DM;
constexpr size_t O_HS = O_HP + (size_t)DEPTH * NB * 4 * 128 * 128;
constexpr size_t O_CP = O_HS + (size_t)DEPTH * DB * 4 * 128 * 128;
constexpr size_t O_CS = O_CP + (size_t)DEPTH * NB * 2 * UPW;
constexpr size_t O_END = O_CS + (size_t)DEPTH * DB * 2 * UPW;

constexpr size_t MiB = 1u << 20;
constexpr size_t WS_CTL = 0, CTL_ZERO_BYTES = 1 * MiB;
constexpr size_t WS_TAB = 1 * MiB;
constexpr size_t TAB_COS = 0, TAB_SIN = 2049 * 32 * 4, TAB_LB = 2 * 2049 * 32 * 4;
constexpr size_t WS_WIN = 2 * MiB;
constexpr size_t WS_WO = WS_WIN + (size_t)DEPTH * PIN * DM * 2;
constexpr size_t WS_WXQ = WS_WO + (size_t)DEPTH * DM * DM * 2;
constexpr size_t WS_WXKV = WS_WXQ + (size_t)DEPTH * DM * DM * 2;
constexpr size_t WS_WXO = WS_WXKV + (size_t)DEPTH * 2 * DM * DM * 2;
constexpr size_t WS_WUP = WS_WXO + (size_t)DEPTH * DM * DM * 2;
constexpr size_t WS_WDN = WS_WUP + (size_t)DEPTH * UPW * DM * 2;
constexpr size_t WS_X = WS_WDN + (size_t)DEPTH * DM * DFF * 2;
constexpr size_t WS_XN = WS_X + (size_t)MT * DM * 4;
constexpr size_t WS_PROJ = WS_XN + (size_t)MT * DM * 2;
constexpr size_t WS_LF = WS_PROJ + (size_t)MT * PIN * 2;
constexpr size_t WS_MIX = WS_LF + (size_t)MT * 512 * 4;
constexpr size_t WS_Y = WS_MIX + (size_t)MT * DM * 2;
constexpr size_t WS_QX = WS_Y + (size_t)MT * DM * 4;
constexpr size_t WS_OX = WS_QX + (size_t)MT * DM * 2;
constexpr size_t WS_U = WS_OX + (size_t)MT * DM * 2;
constexpr size_t WS_G = WS_U + (size_t)MT * UPW * 2;
constexpr size_t WS_MEMN = WS_G + (size_t)MT * DFF * 2;
constexpr size_t WS_MK = WS_MEMN + (size_t)DEPTH * 2048 * DM * 2;
constexpr size_t WS_MVT = WS_MK + (size_t)DEPTH * 2048 * DM * 2;
constexpr size_t WS_HQ = WS_MVT + (size_t)DEPTH * 2048 * DM * 2;
constexpr size_t WS_HK = WS_HQ + (size_t)NB * 4 * 128 * SEQ * 2;
constexpr size_t WS_HV = WS_HK + (size_t)NB * 4 * 128 * SEQ * 2;
constexpr size_t WS_HLF = WS_HV + (size_t)NB * 4 * 128 * SEQ * 2;
constexpr size_t WS_HQB = WS_HLF + (size_t)NB * 4 * 128 * SEQ * 4;
constexpr size_t WS_HOP = WS_HQB + (size_t)MP * 512 * 2;
constexpr size_t WS_HSL = WS_HOP + (size_t)MP * 512 * 4;
constexpr size_t WS_HDE = WS_HSL + (size_t)256 * 128 * 128 * 4;
constexpr size_t WS_RS = WS_HDE + (size_t)256 * 128 * 4;
constexpr size_t WS_END = WS_RS + (size_t)MT * 4;
static_assert(WS_HK - WS_HQ == (size_t)NB * 4 * 128 * SEQ * 2 && WS_HV - WS_HK == WS_HK - WS_HQ, "HQ | HK | HV consecutive");

constexpr int CW_TMO = 0, CW_CODE = 1;
constexpr int CW_BAR = 4096;

constexpr int RING_OFF = 0, RING_BYTES = 131072;
constexpr int LDSCTL_OFF = RING_BYTES, MISC_OFF = LDSCTL_OFF + 320;
constexpr int LDS_BYTES = 147456;

__device__ __forceinline__ unsigned f2bf(float f) { unsigned u = __builtin_bit_cast(unsigned, f); return (u + 0x7fffu + ((u >> 16) & 1u)) >> 16; }
__device__ __forceinline__ unsigned pk2(float lo, float hi) { return f2bf(lo) | (f2bf(hi) << 16); }
__device__ __forceinline__ float bf2f(unsigned short b) { return __builtin_bit_cast(float, (unsigned)b << 16); }
__device__ __forceinline__ float bflo(unsigned w) { return __builtin_bit_cast(float, w << 16); }
__device__ __forceinline__ float bfhi(unsigned w) { return __builtin_bit_cast(float, w & 0xffff0000u); }
__device__ __forceinline__ float sigmoidf_(float z) { return 1.0f / (1.0f + __expf(-z)); }
__device__ __forceinline__ float siluf_(float z) { return z * __builtin_amdgcn_rcpf(1.0f + __expf(-z)); }
typedef __bf16 bf16x2_t __attribute__((ext_vector_type(2)));
__device__ __forceinline__ unsigned cvtpk(float lo, float hi) { f32x2 v = {lo, hi}; bf16x2_t b = __builtin_convertvector(v, bf16x2_t); return __builtin_bit_cast(unsigned, b); }
#define MFMA32(a, b, c) __builtin_amdgcn_mfma_f32_32x32x16_bf16((a), (b), (c), 0, 0, 0)
#define LDS_BAR() do { asm volatile("s_waitcnt lgkmcnt(0)" ::: "memory"); __builtin_amdgcn_s_barrier(); asm volatile("" ::: "memory"); } while (0)
__device__ __forceinline__ float wave_sum(float v) {
#pragma unroll
    for (int o = 1; o < 64; o <<= 1) v += __shfl_xor(v, o);
    return v;
}
__device__ __forceinline__ float wave_max(float v) {
#pragma unroll
    for (int o = 1; o < 64; o <<= 1) v = fmaxf(v, __shfl_xor(v, o));
    return v;
}

namespace pg8 {
struct EpiF32 {
    static constexpr bool PERM = false, AFTER_DRAIN = false;
    float* O; int ldc;
    __device__ __forceinline__ void operator()(const f32x4 (&acc)[2][2][4][2], const Unit& u, int wr, int wc, int fr, int fq) const {
        const int row0 = u.pm * BM + wr * 64 + fr, col0 = u.pn * BM + wc * 32 + 4 * fq;
#pragma unroll
        for (int ai = 0; ai < 2; ++ai)
#pragma unroll
            for (int m = 0; m < 4; ++m) { float* rowp = O + (size_t)(row0 + ai * HALF + m * 16) * ldc + col0;
#pragma unroll
                for (int bj = 0; bj < 2; ++bj)
#pragma unroll
                    for (int n = 0; n < 2; ++n) *(f32x4*)(rowp + bj * HALF + n * 16) = acc[ai][bj][m][n]; }
    }
};
struct EpiB16 {
    static constexpr bool PERM = true, AFTER_DRAIN = false;
    bf16_t* O; int ldc; float sc; const float* rs;
    __device__ __forceinline__ void operator()(const f32x4 (&acc)[2][2][4][2], const Unit& u, int wr, int wc, int fr, int fq) const {
        const int row0 = u.pm * BM + wr * 64 + fr, col0 = u.pn * BM + wc * 32 + 8 * fq;
#pragma unroll
        for (int ai = 0; ai < 2; ++ai)
#pragma unroll
            for (int m = 0; m < 4; ++m) { const int row = row0 + ai * HALF + m * 16; bf16_t* rowp = O + (size_t)row * ldc + col0; const float s = rs ? sc * rs[row] : sc;
#pragma unroll
                for (int bj = 0; bj < 2; ++bj) { const f32x4 v0 = acc[ai][bj][m][0] * s, v1 = acc[ai][bj][m][1] * s;
                    u32x4 w; w.x = cvt_pk_bf16(v0[0], v0[1]); w.y = cvt_pk_bf16(v0[2], v0[3]); w.z = cvt_pk_bf16(v1[0], v1[1]); w.w = cvt_pk_bf16(v1[2], v1[3]);
                    *(u32x4*)(rowp + bj * HALF) = w; } }
    }
};
struct EpiProj {
    static constexpr bool PERM = true, AFTER_DRAIN = false;
    bf16_t* P; float* LF; const float* lb;
    bf16_t* HQ; bf16_t* HK; bf16_t* HV; float* HLF;
    __device__ __forceinline__ void operator()(const f32x4 (&acc)[2][2][4][2], const Unit& u, int wr, int wc, int fr, int fq) const {
        const int row0 = u.pm * BM + wr * 64 + fr, col0 = u.pn * BM + wc * 32 + 8 * fq;
        const int pn = u.pn;
        const int mode = (pn == 3 || pn == 4 || pn == 9 || pn == 10) ? 1 : ((pn == 5 || pn == 6) ? 2 : 0);
        if (pn >= 3 && pn <= 8 && u.pm < 64) {
            const int grp = (pn - 3) >> 1;
            bf16_t* T16 = HQ + (size_t)grp * ((size_t)NB * 4 * 128 * SEQ);
#pragma unroll
            for (int bj = 0; bj < 2; ++bj) { const int hd = ((pn - 3) & 1) * 2 + bj, k0 = wc * 32 + 8 * fq; const int c = hd * 128 + k0;
                f32x4 l0 = {0.f, 0.f, 0.f, 0.f}, l1 = l0; if (grp == 1) { l0 = *(const f32x4*)(lb + c); l1 = *(const f32x4*)(lb + c + 4); }
#pragma unroll
                for (int ai = 0; ai < 2; ++ai)
#pragma unroll
                    for (int m = 0; m < 4; ++m) { const int row = row0 + ai * HALF + m * 16; const int b_ = row >> 11, t_ = row & 2047;
                        const unsigned base = ((((unsigned)(b_ * 4 + hd) * 32u + (unsigned)(t_ >> 6)) * 4u + (unsigned)((t_ >> 4) & 3)) * 128u + (unsigned)k0) * 16u + (unsigned)(t_ & 15);
#pragma unroll
                        for (int n = 0; n < 2; ++n)
#pragma unroll
                            for (int e = 0; e < 4; ++e) { float z = acc[ai][bj][m][n][e]; const unsigned a = base + (unsigned)(4 * n + e) * 16u;
                                if (grp == 0) { z = z * __builtin_amdgcn_rcpf(1.f + __expf(-z)); T16[a] = (bf16_t)(cvt_pk_bf16(z, 0.f) & 0xffffu); }
                                else if (grp == 2) { T16[a] = (bf16_t)(cvt_pk_bf16(z, 0.f) & 0xffffu); }
                                else { z = fminf(fmaxf(z, -40.f), 40.f); const float lbv = n ? l1[e] : l0[e]; const float ez = __expf(-z);
                                    const float rz = __builtin_amdgcn_rcpf(1.f + ez); const float f = lbv + (1.f - lbv) * rz, kk = (1.f - lbv) * ez * rz;
                                    HLF[a] = __log2f(f); T16[a] = (bf16_t)(cvt_pk_bf16(kk, 0.f) & 0xffffu); } } } }
        } else if (mode == 2) {
#pragma unroll
            for (int bj = 0; bj < 2; ++bj) { const int c = col0 + bj * HALF - 1280;
                const f32x4 l0 = *(const f32x4*)(lb + c), l1 = *(const f32x4*)(lb + c + 4);
#pragma unroll
                for (int ai = 0; ai < 2; ++ai)
#pragma unroll
                    for (int m = 0; m < 4; ++m) { const size_t row = (size_t)(row0 + ai * HALF + m * 16);
                        f32x4 z0 = acc[ai][bj][m][0], z1 = acc[ai][bj][m][1]; f32x4 f0, f1, k0, k1;
#pragma unroll
                        for (int e = 0; e < 4; ++e) { z0[e] = fminf(fmaxf(z0[e], -40.f), 40.f); z1[e] = fminf(fmaxf(z1[e], -40.f), 40.f); }
#pragma unroll
                        for (int e = 0; e < 4; ++e) { const float ez0 = __expf(-z0[e]), ez1 = __expf(-z1[e]);
                            const float r0_ = __builtin_amdgcn_rcpf(1.f + ez0), r1_ = __builtin_amdgcn_rcpf(1.f + ez1);
                            f0[e] = l0[e] + (1.f - l0[e]) * r0_; k0[e] = (1.f - l0[e]) * ez0 * r0_;
                            f1[e] = l1[e] + (1.f - l1[e]) * r1_; k1[e] = (1.f - l1[e]) * ez1 * r1_; }
#pragma unroll
                        for (int e = 0; e < 4; ++e) { f0[e] = __log2f(f0[e]); f1[e] = __log2f(f1[e]); }
                        *(f32x4*)(LF + row * 512 + c) = f0; *(f32x4*)(LF + row * 512 + c + 4) = f1;
                        u32x4 w; w.x = cvt_pk_bf16(k0[0], k0[1]); w.y = cvt_pk_bf16(k0[2], k0[3]); w.z = cvt_pk_bf16(k1[0], k1[1]); w.w = cvt_pk_bf16(k1[2], k1[3]);
                        *(u32x4*)(P + row * PIN + col0 + bj * HALF) = w; } }
        } else {
#pragma unroll
            for (int ai = 0; ai < 2; ++ai)
#pragma unroll
                for (int m = 0; m < 4; ++m) { bf16_t* rowp = P + (size_t)(row0 + ai * HALF + m * 16) * PIN + col0;
#pragma unroll
                    for (int bj = 0; bj < 2; ++bj) { f32x4 v0 = acc[ai][bj][m][0], v1 = acc[ai][bj][m][1];
                        if (mode == 1) {
#pragma unroll
                            for (int e = 0; e < 4; ++e) { v0[e] = v0[e] * __builtin_amdgcn_rcpf(1.f + __expf(-v0[e])); v1[e] = v1[e] * __builtin_amdgcn_rcpf(1.f + __expf(-v1[e])); } }
                        u32x4 w; w.x = cvt_pk_bf16(v0[0], v0[1]); w.y = cvt_pk_bf16(v0[2], v0[3]); w.z = cvt_pk_bf16(v1[0], v1[1]); w.w = cvt_pk_bf16(v1[2], v1[3]);
                        *(u32x4*)(rowp + bj * HALF) = w; } }
        }
    }
};
struct EpiMemKV {
    static constexpr bool PERM = false, AFTER_DRAIN = false;
    float* OK; float* OV; bf16_t* MK; bf16_t* MVT;
    __device__ __forceinline__ void operator()(const f32x4 (&acc)[2][2][4][2], const Unit& u, int wr, int wc, int fr, int fq) const {
        const int layer = u.pm >> 3, pml = u.pm & 7, pnl = u.pn & 7;
        const int row0 = pml * BM + wr * 64 + fr; const int col0 = (pnl & 3) * BM + wc * 32 + 4 * fq;
        if (pnl < 4) {
            float* O = OK + (size_t)layer * 2048 * 1024; bf16_t* B = MK + (size_t)layer * 2048 * 1024;
#pragma unroll
            for (int ai = 0; ai < 2; ++ai)
#pragma unroll
                for (int m = 0; m < 4; ++m) { const size_t off = (size_t)(row0 + ai * HALF + m * 16) * 1024 + col0;
#pragma unroll
                    for (int bj = 0; bj < 2; ++bj)
#pragma unroll
                        for (int n = 0; n < 2; ++n) { const f32x4 v = acc[ai][bj][m][n]; *(f32x4*)(O + off + bj * HALF + n * 16) = v;
                            v2u w; w.x = cvt_pk_bf16(v[0], v[1]); w.y = cvt_pk_bf16(v[2], v[3]); *(v2u*)(B + off + bj * HALF + n * 16) = w; } }
        } else {
            float* O = OV + (size_t)layer * 2048 * 1024; bf16_t* T = MVT + (size_t)layer * 2048 * 1024;
#pragma unroll
            for (int ai = 0; ai < 2; ++ai)
#pragma unroll
                for (int m = 0; m < 4; ++m) { const int row = row0 + ai * HALF + m * 16; const size_t off = (size_t)row * 1024 + col0; const int b_ = row >> 8, mm = row & 255;
#pragma unroll
                    for (int bj = 0; bj < 2; ++bj)
#pragma unroll
                        for (int n = 0; n < 2; ++n) { const f32x4 v = acc[ai][bj][m][n]; *(f32x4*)(O + off + bj * HALF + n * 16) = v;
                            const int c = col0 + bj * HALF + n * 16; const int hd = c >> 8, d = c & 255;
                            bf16_t* tp = T + ((size_t)(b_ * 4 + hd) * 256 + d) * 256 + mm;
                            const unsigned w0 = cvt_pk_bf16(v[0], v[1]), w1 = cvt_pk_bf16(v[2], v[3]);
                            tp[0] = (bf16_t)(w0 & 0xffffu); tp[256] = (bf16_t)(w0 >> 16); tp[512] = (bf16_t)(w1 & 0xffffu); tp[768] = (bf16_t)(w1 >> 16); } }
        }
    }
};
struct BlockDiagOrder {
    int G, c;
    __device__ __forceinline__ bool next(int i, Unit& u) const { const int L = i * G + c; if (L >= 256) return false; const int layer = L >> 6, r = L & 63; u.pm = layer * 8 + (r & 7); u.pn = layer * 8 + (r >> 3); return true; }
    __device__ __forceinline__ void a_ready(const Unit&) const {}
    __device__ __forceinline__ void done(const Unit&) const {}
};
}
#define XB_TMO      128
#define XB_XCNT(j)  (256  + 64 * (j))
#define XB_XSUB(j)  (1280 + 64 * (j))
#define XB_XGEN(j)  (2304 + 64 * (j))
#define XB_TOP      3328
#define XB_TOPGEN   3392
#define XCD_BAR_WORDS 3456
#define XB_SPIN_CAP (1u << 18)

__device__ __forceinline__ unsigned xb_ld(unsigned* p)              { return __hip_atomic_load(p, __ATOMIC_RELAXED, __HIP_MEMORY_SCOPE_AGENT); }
__device__ __forceinline__ unsigned xb_add(unsigned* p, unsigned v) { return __hip_atomic_fetch_add(p, v, __ATOMIC_RELAXED, __HIP_MEMORY_SCOPE_AGENT); }
__device__ __forceinline__ unsigned xb_xcc_id() { return (unsigned)__builtin_amdgcn_s_getreg((3 << 11) | 20) & 0xFu; }
#define XB_SPIN(cond, bar) do { unsigned _sp = 0; while (cond) { __builtin_amdgcn_s_sleep(1); \
    if ((++_sp & 255u) == 0u) { if (xb_ld(&(bar)[XB_TMO])) break; if (_sp > XB_SPIN_CAP) { atomicAdd(&(bar)[XB_TMO], 1u); break; } } } } while (0)

struct XcdBarrier {
    unsigned* bar; unsigned x;
    volatile LAS unsigned* st;
};

__device__ __forceinline__ XcdBarrier xcd_barrier_post(unsigned* bar, volatile LAS unsigned* st) {
    XcdBarrier b; b.bar = bar; b.x = xb_xcc_id(); b.st = st;
    if (threadIdx.x == 0) (void)xb_add(&bar[XB_XCNT(b.x)], 1u);
    return b;
}
__device__ __forceinline__ void xcd_barrier_complete(unsigned* bar, unsigned x, unsigned& nloc, unsigned& nx) {
    const unsigned G = gridDim.x * gridDim.y * gridDim.z;
    unsigned sum, cnt, mine, sp = 0u;
    for (;;) {
        sum = 0u; cnt = 0u; mine = 0u;
#pragma unroll
        for (unsigned j = 0; j < 16; ++j) { const unsigned c = xb_ld(&bar[XB_XCNT(j)]); sum += c; cnt += (c > 0u) ? 1u : 0u; mine = (j == x) ? c : mine; }
        if (sum == G) break;
        __builtin_amdgcn_s_sleep(1);
        if ((++sp & 255u) == 0u) { if (xb_ld(&bar[XB_TMO])) break; if (sp > XB_SPIN_CAP) { atomicAdd(&bar[XB_TMO], 1u); break; } }
    }
    nloc = mine > 0u ? mine : 1u; nx = cnt > 0u ? cnt : 1u;
}

__device__ __forceinline__ void xcd_barrier(const XcdBarrier& b) {
    asm volatile("s_waitcnt vmcnt(0)" ::: "memory");
    __syncthreads();
    if (threadIdx.x == 0) {
        unsigned* bar = b.bar;
        __builtin_amdgcn_s_waitcnt(0);
        unsigned nloc = b.st[0], nx = b.st[1];
        if (nloc == 0u) { xcd_barrier_complete(bar, b.x, nloc, nx); b.st[0] = nloc; b.st[1] = nx; }
        const unsigned old = xb_add(&bar[XB_XSUB(b.x)], 1u);
        const unsigned gen = old / nloc;
        if (old + 1u == (gen + 1u) * nloc) {
            __builtin_amdgcn_fence(__ATOMIC_RELEASE, "agent");
            asm volatile("s_waitcnt vmcnt(0)" ::: "memory");
            const unsigned og = xb_add(&bar[XB_TOP], 1u);
            const unsigned tg = og / nx;
            if (og + 1u == (tg + 1u) * nx) xb_add(&bar[XB_TOPGEN], 1u);
            else XB_SPIN(xb_ld(&bar[XB_TOPGEN]) == tg, bar);
            __builtin_amdgcn_fence(__ATOMIC_ACQUIRE, "agent");
            xb_add(&bar[XB_XGEN(b.x)], 1u);
            asm volatile("s_waitcnt vmcnt(0)" ::: "memory");
        } else {
            XB_SPIN(xb_ld(&bar[XB_XGEN(b.x)]) == gen, bar);
            __builtin_amdgcn_fence(__ATOMIC_ACQUIRE, "agent");
            asm volatile("s_waitcnt vmcnt(0)" ::: "memory");
        }
    }
    __syncthreads();
}

struct Frame {
    LAS unsigned char* lds;
    volatile LAS unsigned* MISC;
    unsigned* ctl;
    int tid, lane, wave, G, gw, ngw;
    const float* const* in; float* out; unsigned char* ws;
};
#define IN_XP 0
#define IN_XS 1
#define IN_CWK 2
#define IN_CWV 3
#define IN_CMK 4
#define IN_CMV 5
#define IN_SH 6
#define IN_CFC 7
#define IN_MEM 8
#define IN_WIN 9
#define IN_WO 10
#define IN_SINK 11
#define IN_LBL 12
#define IN_HN 13
#define IN_WXQ 14
#define IN_WXK 15
#define IN_WXV 16
#define IN_WXO 17
#define IN_WUP 18
#define IN_CW 19
#define IN_CB 20
#define IN_WDN 21
#define IN_GPM 22
#define IN_GQM 23
#define IN_GPX 24
#define IN_GQX 25
#define IN_GMEM 26
#define IN_GPF 27
#define IN_GQF 28

__device__ __forceinline__ void p0_transpose_item(const float* W, int K, int N, bf16* WT, int row_off, LAS float* scr, int item, int lane, const float* gk = nullptr, bf16* WTT = nullptr) {
    const int nblk = N / 32, kb = item / nblk, nb = item % nblk, k0 = 64 * kb, n0 = 32 * nb;
#pragma unroll 8
    for (int i = 0; i < 32; ++i) { const int kk = 2 * i + (lane >> 5); scr[kk * 33 + (lane & 31)] = W[(size_t)(k0 + kk) * N + n0 + (lane & 31)]; }
    LDS_WAIT(); asm volatile("" ::: "memory");
    const int c = lane & 7;
    float g8[8];
    if (gk) { const f32x4 a_ = *(const f32x4*)(gk + k0 + 8 * c), b_ = *(const f32x4*)(gk + k0 + 8 * c + 4); g8[0] = a_.x; g8[1] = a_.y; g8[2] = a_.z; g8[3] = a_.w; g8[4] = b_.x; g8[5] = b_.y; g8[6] = b_.z; g8[7] = b_.w; } else {
#pragma unroll
        for (int e = 0; e < 8; ++e) g8[e] = 1.f; }
#pragma unroll
    for (int j = 0; j < 4; ++j) { const int n = (lane >> 3) + 8 * j; const LAS float* s = scr + (8 * c) * 33 + n;
        v4u o; o.x = cvtpk(s[0 * 33] * g8[0], s[1 * 33] * g8[1]); o.y = cvtpk(s[2 * 33] * g8[2], s[3 * 33] * g8[3]); o.z = cvtpk(s[4 * 33] * g8[4], s[5 * 33] * g8[5]); o.w = cvtpk(s[6 * 33] * g8[6], s[7 * 33] * g8[7]);
        *(GAS v4u*)(WT + (size_t)(row_off + n0 + n) * K + k0 + 8 * c) = o;
        if (WTT) { const int nn = n0 + n, kk_ = k0 + 8 * c; *(GAS v4u*)(WTT + ((size_t)((nn >> 4) * (K >> 5) + (kk_ >> 5)) * 64 + ((kk_ & 31) >> 3) * 16 + (nn & 15)) * 8) = o; } }
    LDS_WAIT(); asm volatile("" ::: "memory");
}
__device__ __forceinline__ void row_load(const float* p, int lane, f32x4 (&v)[4]) {
    const GAS f32x4* r = (const GAS f32x4*)p + lane;
#pragma unroll
    for (int j = 0; j < 4; ++j) v[j] = r[64 * j];
}
__device__ __forceinline__ float row_ss(const f32x4 (&v)[4]) {
    float s = 0.f;
#pragma unroll
    for (int j = 0; j < 4; ++j) s += (v[j].x * v[j].x + v[j].y * v[j].y) + (v[j].z * v[j].z + v[j].w * v[j].w);
    return wave_sum(s);
}
__device__ __forceinline__ void row_store_bf16(bf16* p, int lane, const f32x4 (&v)[4]) {
    GAS unsigned long long* o8 = (GAS unsigned long long*)p + lane;
#pragma unroll
    for (int j = 0; j < 4; ++j) o8[64 * j] = (unsigned long long)pk2(v[j].x, v[j].y) | ((unsigned long long)pk2(v[j].z, v[j].w) << 32);
}
__device__ __forceinline__ void row_store_f32(float* p, int lane, const f32x4 (&v)[4]) {
    GAS f32x4* r = (GAS f32x4*)p + lane;
#pragma unroll
    for (int j = 0; j < 4; ++j) r[64 * j] = v[j];
}

__device__ __forceinline__ void p0_prologue(Frame& F) {
    LAS float* scr = (LAS float*)(F.lds + RING_OFF + F.wave * 16384);
    unsigned char* ws = F.ws;
    constexpr int I_IN = 16 * (PIN / 32), I_SQ = 16 * (DM / 32), I_UP = 16 * (UPW / 32), I_DN = (DFF / 64) * (DM / 32);
    constexpr int I_LAYER = I_IN + 5 * I_SQ + I_UP + I_DN;
    for (int it = F.gw; it < DEPTH * I_LAYER; it += F.ngw) {
        const int l = it / I_LAYER; int r = it % I_LAYER;
        if (r < I_IN) { p0_transpose_item(F.in[IN_WIN] + (size_t)l * DM * PIN, DM, PIN, (bf16*)(ws + WS_WIN) + (size_t)l * PIN * DM, 0, scr, r, F.lane); continue; } r -= I_IN;
        if (r < I_SQ) { p0_transpose_item(F.in[IN_WO] + (size_t)l * DM * DM, DM, DM, (bf16*)(ws + WS_WO) + (size_t)l * DM * DM, 0, scr, r, F.lane); continue; } r -= I_SQ;
        if (r < I_SQ) { p0_transpose_item(F.in[IN_WXQ] + (size_t)l * DM * DM, DM, DM, (bf16*)(ws + WS_WXQ) + (size_t)l * DM * DM, 0, scr, r, F.lane, F.in[IN_GPX] + l * DM); continue; } r -= I_SQ;
        if (r < I_SQ) { p0_transpose_item(F.in[IN_WXK] + (size_t)l * DM * DM, DM, DM, (bf16*)(ws + WS_WXKV) + (size_t)l * 2 * DM * DM, 0, scr, r, F.lane); continue; } r -= I_SQ;
        if (r < I_SQ) { p0_transpose_item(F.in[IN_WXV] + (size_t)l * DM * DM, DM, DM, (bf16*)(ws + WS_WXKV) + (size_t)l * 2 * DM * DM, DM, scr, r, F.lane); continue; } r -= I_SQ;
        if (r < I_SQ) { p0_transpose_item(F.in[IN_WXO] + (size_t)l * DM * DM, DM, DM, (bf16*)(ws + WS_WXO) + (size_t)l * DM * DM, 0, scr, r, F.lane); continue; } r -= I_SQ;
        if (r < I_UP) { p0_transpose_item(F.in[IN_WUP] + (size_t)l * DM * UPW, DM, UPW, (bf16*)(ws + WS_WUP) + (size_t)l * UPW * DM, 0, scr, r, F.lane, F.in[IN_GPF] + l * DM); continue; } r -= I_UP;
        p0_transpose_item(F.in[IN_WDN] + (size_t)l * DFF * DM, DFF, DM, (bf16*)(ws + WS_WDN) + (size_t)l * DM * DFF, 0, scr, r, F.lane);
    }
    {
        f32x4 g[4]; row_load(F.in[IN_GPM], F.lane, g);
        for (int m = F.gw; m < MR; m += F.ngw) {
            const float* src = (m < MP) ? F.in[IN_XP] + (size_t)m * DM : F.in[IN_XS] + (size_t)(m - MP) * DM;
            f32x4 v[4]; row_load(src, F.lane, v);
            row_store_bf16((bf16*)(ws + WS_X) + (size_t)m * DM, F.lane, v);
            const float r = rsqrtf(row_ss(v) * (1.f / DM) + EPS);
#pragma unroll
            for (int j = 0; j < 4; ++j) v[j] = v[j] * r * g[j];
            row_store_bf16((bf16*)(ws + WS_XN) + (size_t)m * DM, F.lane, v);
        }
    }
    for (int m = F.gw; m < NB * NMEM; m += F.ngw) {
        f32x4 v[4]; row_load(F.in[IN_MEM] + (size_t)m * DM, F.lane, v);
        const float r = rsqrtf(row_ss(v) * (1.f / DM) + EPS);
        for (int l = 0; l < DEPTH; ++l) { f32x4 g[4], o[4]; row_load(F.in[IN_GMEM] + (size_t)l * DM, F.lane, g);
#pragma unroll
            for (int j = 0; j < 4; ++j) o[j] = v[j] * r * g[j];
            row_store_bf16((bf16*)(ws + WS_MEMN) + ((size_t)l * 2048 + m) * DM, F.lane, o); }
    }
    {
        float* cs = (float*)(ws + WS_TAB + TAB_COS); float* sn = (float*)(ws + WS_TAB + TAB_SIN); float* lbt = (float*)(ws + WS_TAB + TAB_LB);
        const int gt = blockIdx.x * NTHR + F.tid; constexpr int nt = GRID * NTHR;
        for (int i = gt; i < 2049 * 32; i += nt) { const int p = i >> 5, d = i & 31; const double pos = (p == 2048) ? (double)PAST : (double)p;
            const double inv = pow(10000.0, -(double)d / 32.0); const double a = pos * inv; cs[i] = (float)cos(a); sn[i] = (float)sin(a); }
        for (int c = gt; c < 512; c += nt) { float z[DEPTH], mx = -1e30f;
            for (int l = 0; l < DEPTH; ++l) { z[l] = F.in[IN_LBL][l * 512 + c]; mx = fmaxf(mx, z[l]); }
            float s = 0.f; for (int l = 0; l < DEPTH; ++l) { z[l] = expf(z[l] - mx); s += z[l]; }
            float cum = 0.f, c0 = 0.f; for (int l = 0; l < DEPTH; ++l) { cum += z[l] / s; if (l == 0) c0 = cum; lbt[l * 512 + c] = cum - c0; } }
    }
}

__device__ __forceinline__ void row_load_bf16(const bf16* p, int lane, f32x4 (&v)[4]) {
    const GAS v2u* r = (const GAS v2u*)p + lane;
#pragma unroll
    for (int j = 0; j < 4; ++j) { const v2u w = r[64 * j]; v[j] = (f32x4){bflo(w.x), bfhi(w.x), bflo(w.y), bfhi(w.y)}; }
}
__device__ __forceinline__ void norm_row(Frame& F, int m, f32x4 (&y)[4], f32x4 (&x)[4], const f32x4 (&gq)[4], const f32x4 (&gp)[4], bool final_, bool xn_) {
    unsigned char* ws = F.ws;
    const float r = rsqrtf(row_ss(y) * (1.f / DM) + EPS);
#pragma unroll
    for (int j = 0; j < 4; ++j) x[j] = x[j] + y[j] * r * gq[j];
    if (final_) { float* o = (m < MP) ? F.out + O_YP + (size_t)m * DM : F.out + O_YS + (size_t)(m - MP) * DM; row_store_f32(o, F.lane, x); }
    else {
        row_store_bf16((bf16*)(ws + WS_X) + (size_t)m * DM, F.lane, x);
        const float r2 = rsqrtf(row_ss(x) * (1.f / DM) + EPS);
        if (xn_) {
#pragma unroll
            for (int j = 0; j < 4; ++j) x[j] = x[j] * r2 * gp[j];
            row_store_bf16((bf16*)(ws + WS_XN) + (size_t)m * DM, F.lane, x);
        } else if (F.lane == 0) ((float*)(ws + WS_RS))[m] = r2;
    }
}
__device__ __forceinline__ void norm_phase(Frame& F, const float* gpost, const float* gpre, bool final_) {
    unsigned char* ws = F.ws;
    f32x4 gq[4], gp[4]; row_load(gpost, F.lane, gq); row_load(gpre ? gpre : gpost, F.lane, gp);
    const bool xn_ = gpre != nullptr;
    const bf16* Y = (const bf16*)(ws + WS_Y); const bf16* X = (const bf16*)(ws + WS_X);
    for (int m = F.gw; m < MR; m += 2 * F.ngw) {
        const int m2 = m + F.ngw; const bool two = m2 < MR;
        f32x4 y0[4], x0[4], y1[4], x1[4];
        row_load_bf16(Y + (size_t)m * DM, F.lane, y0); row_load_bf16(X + (size_t)m * DM, F.lane, x0);
        if (two) { row_load_bf16(Y + (size_t)m2 * DM, F.lane, y1); row_load_bf16(X + (size_t)m2 * DM, F.lane, x1); }
        norm_row(F, m, y0, x0, gq, gp, final_, xn_);
        if (two) norm_row(F, m2, y1, x1, gq, gp, final_, xn_);
    }
}

__device__ __forceinline__ void unpack8(const v4u w, float (&f)[8]) {
    f[0] = bflo(w.x); f[1] = bfhi(w.x); f[2] = bflo(w.y); f[3] = bfhi(w.y); f[4] = bflo(w.z); f[5] = bfhi(w.z); f[6] = bflo(w.w); f[7] = bfhi(w.w);
}
__device__ __forceinline__ void load8f(const float* p, float (&f)[8]) { const f32x4 a = *(const f32x4*)p, b = *(const f32x4*)(p + 4); f[0] = a.x; f[1] = a.y; f[2] = a.z; f[3] = a.w; f[4] = b.x; f[5] = b.y; f[6] = b.z; f[7] = b.w; }

__device__ __forceinline__ void conv_phase(Frame& F, int l) {
    unsigned char* ws = F.ws;
    const bf16* U = (const bf16*)(ws + WS_U); bf16* Gb = (bf16*)(ws + WS_G);
    const float* cw = F.in[IN_CW] + (size_t)l * 3 * UPW; const float* cb = F.in[IN_CB] + (size_t)l * UPW;
    const float* cfc = F.in[IN_CFC] + (size_t)l * DB * 2 * UPW;
    const int gt = blockIdx.x * NTHR + F.tid; constexpr int nthr = GRID * NTHR;
    constexpr int NCG = DFF / 8;
    constexpr int RG = 8;
    constexpr int N_P = (MP / RG) * NCG, N_S = MS * NCG;
    for (int it = gt; it < N_P + N_S; it += nthr) {
        const bool samp = it >= N_P; const int it2 = samp ? it - N_P : it;
        const int rg = it2 / NCG, cg = it2 % NCG, c0 = cg * 8;
        float wa[3][8], wb[3][8], ba[8], bb[8];
#pragma unroll
        for (int j = 0; j < 3; ++j) { load8f(cw + j * UPW + c0, wa[j]); load8f(cw + j * UPW + DFF + c0, wb[j]); }
        load8f(cb + c0, ba); load8f(cb + DFF + c0, bb);
        if (samp) {
            const int m0 = MP + rg; const float* c = cfc + (size_t)rg * 2 * UPW;
            float a2[8], a1[8], b2[8], b1[8], a0[8], b0[8];
            load8f(c + c0, a2); load8f(c + DFF + c0, b2); load8f(c + UPW + c0, a1); load8f(c + UPW + DFF + c0, b1);
            unpack8(*(const v4u*)(U + (size_t)m0 * UPW + c0), a0); unpack8(*(const v4u*)(U + (size_t)m0 * UPW + DFF + c0), b0);
            float o[8];
#pragma unroll
            for (int e = 0; e < 8; ++e) { const float a = ba[e] + wa[0][e] * a2[e] + wa[1][e] * a1[e] + wa[2][e] * a0[e]; const float b = bb[e] + wb[0][e] * b2[e] + wb[1][e] * b1[e] + wb[2][e] * b0[e]; o[e] = siluf_(a) * b; }
            *(v4u*)(Gb + (size_t)m0 * DFF + c0) = (v4u){cvtpk(o[0], o[1]), cvtpk(o[2], o[3]), cvtpk(o[4], o[5]), cvtpk(o[6], o[7])};
        } else {
            const int m0 = rg * RG; const bool first = (m0 % SEQ) == 0;
            v4u ra[RG + 2], rb[RG + 2];
#pragma unroll
            for (int r = 0; r < RG + 2; ++r) { const int mm = (first && r < 2) ? m0 : m0 + r - 2;
                ra[r] = *(const v4u*)(U + (size_t)mm * UPW + c0); rb[r] = *(const v4u*)(U + (size_t)mm * UPW + DFF + c0); }
            if (first) { ra[0] = (v4u){0u, 0u, 0u, 0u}; ra[1] = ra[0]; rb[0] = ra[0]; rb[1] = ra[0]; }
            float a2[8], a1[8], b2[8], b1[8];
            unpack8(ra[0], a2); unpack8(ra[1], a1); unpack8(rb[0], b2); unpack8(rb[1], b1);
#pragma unroll
            for (int r = 0; r < RG; ++r) {
                float a0[8], b0[8], o[8]; unpack8(ra[r + 2], a0); unpack8(rb[r + 2], b0);
#pragma unroll
                for (int e = 0; e < 8; ++e) { const float a = ba[e] + wa[0][e] * a2[e] + wa[1][e] * a1[e] + wa[2][e] * a0[e]; const float b = bb[e] + wb[0][e] * b2[e] + wb[1][e] * b1[e] + wb[2][e] * b0[e];
                    o[e] = siluf_(a) * b; a2[e] = a1[e]; a1[e] = a0[e]; b2[e] = b1[e]; b1[e] = b0[e]; }
                *(v4u*)(Gb + (size_t)(m0 + r) * DFF + c0) = (v4u){cvtpk(o[0], o[1]), cvtpk(o[2], o[3]), cvtpk(o[4], o[5]), cvtpk(o[6], o[7])};
            }
        }
    }
    float* ocp = F.out + O_CP + (size_t)l * NB * 2 * UPW; float* ocs = F.out + O_CS + (size_t)l * DB * 2 * UPW;
    for (int i = gt; i < NB * 2 * UPW; i += nthr) { const int b = i / (2 * UPW), j = (i / UPW) % 2, c = i % UPW; ocp[i] = bf2f(U[(size_t)(b * SEQ + SEQ - 2 + j) * UPW + c]); }
    for (int i = gt; i < DB * 2 * UPW; i += nthr) { const int s = i / (2 * UPW), j = (i / UPW) % 2, c = i % UPW;
        ocs[i] = (j == 0) ? cfc[(size_t)s * 2 * UPW + UPW + c] : bf2f(U[(size_t)(MP + s) * UPW + c]); }
}

__device__ __forceinline__ void xattn_unit_sample(Frame& F, int l, int s, int h) {
    unsigned char* ws = F.ws; const bf16* QX = (const bf16*)(ws + WS_QX); bf16* OX = (bf16*)(ws + WS_OX);
    const int lane = F.lane, wave = F.wave, m = MP + s;
    LAS float* scl = (LAS float*)(F.lds + RING_OFF); LAS float* part = scl + 256;
    const v2u qw = *(const v2u*)(QX + (size_t)m * DM + h * 256 + 4 * lane);
    const f32x4 q = {bflo(qw.x), bfhi(qw.x), bflo(qw.y), bfhi(qw.y)};
    const GAS f32x4* CK = (const GAS f32x4*)(F.in[IN_CMK] + ((size_t)(l * DB + s) * 256 + 32 * wave) * DM + h * 256) + lane;
    const GAS f32x4* CV = (const GAS f32x4*)(F.in[IN_CMV] + ((size_t)(l * DB + s) * 256 + 32 * wave) * DM + h * 256) + lane;
    LDS_BAR();
    {
        f32x4 k[32];
#pragma unroll
        for (int i = 0; i < 32; ++i) k[i] = CK[(size_t)i * (DM / 4)];
#pragma unroll
        for (int i = 0; i < 32; ++i) { const float d = wave_sum((k[i].x * q.x + k[i].y * q.y) + (k[i].z * q.z + k[i].w * q.w)); if (lane == 0) scl[32 * wave + i] = d; }
    }
    f32x4 v[32];
#pragma unroll
    for (int i = 0; i < 32; ++i) v[i] = CV[(size_t)i * (DM / 4)];
    LDS_BAR();
    float mx, inv;
    { const float s0 = scl[lane], s1 = scl[64 + lane], s2 = scl[128 + lane], s3 = scl[192 + lane];
      mx = wave_max(fmaxf(fmaxf(s0, s1), fmaxf(s2, s3)));
      inv = 1.f / wave_sum((exp2f(s0 - mx) + exp2f(s1 - mx)) + (exp2f(s2 - mx) + exp2f(s3 - mx))); }
    f32x4 o = {0.f, 0.f, 0.f, 0.f};
#pragma unroll
    for (int i = 0; i < 32; ++i) { const float p = exp2f(scl[32 * wave + i] - mx); o = o + v[i] * p; }
    *(LAS f32x4*)(part + wave * 256 + 4 * lane) = o;
    LDS_BAR();
    if (F.tid < 256) { float t = 0.f;
#pragma unroll
        for (int w = 0; w < 8; ++w) t += part[w * 256 + F.tid];
        OX[(size_t)m * DM + h * 256 + F.tid] = (bf16)(cvtpk(t * inv, 0.f) & 0xffffu); }
}

__device__ __forceinline__ void hgrn_unit_sample(Frame& F, int l, int s) {
    unsigned char* ws = F.ws; const bf16* P = (const bf16*)(ws + WS_PROJ); bf16* MIX = (bf16*)(ws + WS_MIX); const float* LFp = (const float*)(ws + WS_LF);
    const int lane = F.lane, wave = F.wave, m = MP + s, hd = wave >> 1, kh = wave & 1, vq = lane & 31, kp = lane >> 5;
    LAS float* wl = (LAS float*)(F.lds + RING_OFF + 102400 + wave * 2048);
    LAS f32x4* red = (LAS f32x4*)(F.lds + RING_OFF + 98304);
    LDS_BAR();
    { const int k = 64 * kh + lane; wl[lane] = exp2f(LFp[(size_t)m * 512 + hd * 128 + k]); wl[64 + lane] = bf2f(P[(size_t)m * PIN + C_FR + hd * 128 + k]); wl[128 + lane] = bf2f(P[(size_t)m * PIN + C_QR + hd * 128 + k]); }
    LDS_WAIT(); asm volatile("" ::: "memory");
    const v2u vw = *(const v2u*)(P + (size_t)m * PIN + C_IR + hd * 128 + 4 * vq);
    const f32x4 vv = {bflo(vw.x), bfhi(vw.x), bflo(vw.y), bfhi(vw.y)};
    const size_t sb = (((size_t)(l * DB + s) * 4 + hd) * 128 + 64 * kh) * 128 + 4 * vq;
    const GAS float* S0 = (const GAS float*)F.in[IN_SH] + sb; GAS float* S1 = (GAS float*)F.out + O_HS + sb;
    f32x4 o = {0.f, 0.f, 0.f, 0.f};
#pragma unroll 1
    for (int g = 0; g < 4; ++g) {
        f32x4 s0[8];
#pragma unroll
        for (int i = 0; i < 8; ++i) s0[i] = *(const GAS f32x4*)(S0 + (size_t)(16 * g + 2 * i + kp) * 128);
#pragma unroll
        for (int i = 0; i < 8; ++i) { const int kr = 16 * g + 2 * i + kp; const float f = wl[kr], kk = wl[64 + kr], q = wl[128 + kr];
            const f32x4 s1 = s0[i] * f + vv * kk; *(GAS f32x4*)(S1 + (size_t)kr * 128) = s1; o = o + s1 * q; }
    }
    o.x += __shfl_xor(o.x, 32); o.y += __shfl_xor(o.y, 32); o.z += __shfl_xor(o.z, 32); o.w += __shfl_xor(o.w, 32);
    if (lane < 32) red[wave * 32 + vq] = o;
    LDS_BAR();
    o = red[(2 * hd) * 32 + vq] + red[(2 * hd + 1) * 32 + vq];
    float ss = (o.x * o.x + o.y * o.y) + (o.z * o.z + o.w * o.w);
    ss += __shfl_xor(ss, 1); ss += __shfl_xor(ss, 2); ss += __shfl_xor(ss, 4); ss += __shfl_xor(ss, 8); ss += __shfl_xor(ss, 16);
    const float r = rsqrtf(ss * (1.f / 128.f) + EPS);
    if (kh == 0 && lane < 32) { const f32x4 g4 = *(const f32x4*)(F.in[IN_HN] + l * 512 + hd * 128 + 4 * vq); const v2u gw = *(const v2u*)(P + (size_t)m * PIN + C_GR + hd * 128 + 4 * vq);
        v2u w; w.x = cvtpk(o.x * r * g4.x * bflo(gw.x), o.y * r * g4.y * bfhi(gw.x)); w.y = cvtpk(o.z * r * g4.z * bflo(gw.y), o.w * r * g4.w * bfhi(gw.y));
        *(v2u*)(MIX + (size_t)m * DM + 512 + hd * 128 + 4 * vq) = w; }
}
__device__ __forceinline__ void swa_unit_sample(Frame& F, int l, int s) {
    unsigned char* ws = F.ws; const bf16* P = (const bf16*)(ws + WS_PROJ); bf16* MIX = (bf16*)(ws + WS_MIX);
    const float* cs = (const float*)(ws + WS_TAB + TAB_COS) + 2048 * 32; const float* sn = (const float*)(ws + WS_TAB + TAB_SIN) + 2048 * 32;
    constexpr int RS = 136;
    LAS unsigned char* KL = F.lds + RING_OFF; LAS unsigned char* VL = KL + 128 * RS * 2;
    const int lane = F.lane, h = F.wave, m = MP + s, kvh = h >> 2;
    LAS float* wl = (LAS float*)(F.lds + RING_OFF + 102400 + h * 2048);
    const GAS float* ck = (const GAS float*)F.in[IN_CWK] + (size_t)(l * DB + s) * 128 * 128; const GAS float* cv = (const GAS float*)F.in[IN_CWV] + (size_t)(l * DB + s) * 128 * 128;
    LDS_BAR();
    { f32x4 kx[8], vx[8];
#pragma unroll
      for (int i = 0; i < 8; ++i) { const int ch = F.tid + 512 * i; kx[i] = *(const GAS f32x4*)(ck + (size_t)(ch >> 5) * 128 + 4 * (ch & 31)); vx[i] = *(const GAS f32x4*)(cv + (size_t)(ch >> 5) * 128 + 4 * (ch & 31)); }
#pragma unroll
      for (int i = 0; i < 8; ++i) { const int ch = F.tid + 512 * i; const int off = ((ch >> 5) * RS + 4 * (ch & 31)) * 2;
          *(LAS v2u*)(KL + off) = (v2u){cvtpk(kx[i].x, kx[i].y), cvtpk(kx[i].z, kx[i].w)}; *(LAS v2u*)(VL + off) = (v2u){cvtpk(vx[i].x, vx[i].y), cvtpk(vx[i].z, vx[i].w)}; } }
    float knew = 0.f;
    { const int d = lane & 31; const float c = cs[d], sv = sn[d];
      const float q1 = bf2f(P[(size_t)m * PIN + h * 64 + d]), q2 = bf2f(P[(size_t)m * PIN + h * 64 + 32 + d]);
      const float k1 = bf2f(P[(size_t)m * PIN + C_K + kvh * 64 + d]), k2 = bf2f(P[(size_t)m * PIN + C_K + kvh * 64 + 32 + d]);
      if (lane < 32) { wl[lane] = (q1 * c - q2 * sv) * 0.125f; knew = k1 * c - k2 * sv; } else { wl[lane] = (q2 * c + q1 * sv) * 0.125f; knew = k2 * c + k1 * sv; } }
    const float vnew = bf2f(P[(size_t)m * PIN + C_V + kvh * 64 + lane]);
    if ((h & 3) == 0) { F.out[O_WKS + ((size_t)(l * DB + s) * 2 + kvh) * 64 + lane] = knew; F.out[O_WVS + ((size_t)(l * DB + s) * 2 + kvh) * 64 + lane] = vnew; }
    LDS_BAR();
    const float snew = wave_sum(wl[lane] * knew);
    float sc[2];
#pragma unroll
    for (int i = 0; i < 2; ++i) { const LAS unsigned char* kr = KL + ((lane + 64 * i) * RS + kvh * 64) * 2; float acc = 0.f;
#pragma unroll
        for (int c8 = 0; c8 < 8; ++c8) { float kf[8]; unpack8(*(const LAS v4u*)(kr + 16 * c8), kf);
#pragma unroll
            for (int e = 0; e < 8; ++e) acc += wl[c8 * 8 + e] * kf[e]; }
        sc[i] = acc; }
    const float sink = F.in[IN_SINK][l * 8 + h];
    const float mx = fmaxf(fmaxf(wave_max(fmaxf(sc[0], sc[1])), snew), sink);
    const float p0 = __expf(sc[0] - mx), p1 = __expf(sc[1] - mx), pn = __expf(snew - mx);
    const float den = wave_sum(p0 + p1) + pn + __expf(sink - mx);
    wl[64 + lane] = p0; wl[128 + lane] = p1;
    LDS_WAIT(); asm volatile("" ::: "memory");
    float o = pn * vnew;
    const LAS bf16* vp = (const LAS bf16*)VL + kvh * 64 + lane;
#pragma unroll 8
    for (int j = 0; j < 128; ++j) o += wl[64 + j] * bf2f(vp[j * RS]);
    MIX[(size_t)m * DM + h * 64 + lane] = (bf16)(cvtpk(o / den, 0.f) & 0xffffu);
}

__device__ __forceinline__ void hgrn_pass1(Frame& F, int l, int b, int h, int seg) {
    unsigned char* ws = F.ws; bf16* QB = (bf16*)(ws + WS_HQB); float* OP = (float*)(ws + WS_HOP);
    constexpr int RSK = 136, RST = 72;
    constexpr int O_QT = 0, O_KT = O_QT + 64 * RSK * 2, O_KTT = O_KT + 64 * RSK * 2, O_VT = O_KTT + 128 * RST * 2, O_SP = O_VT + 128 * RST * 2,
                  O_SEG = O_SP + 128 * RSK * 2, O_EB = O_SEG + 2048, O_EBR = O_EB + 512, O_SSQ = O_EBR + 512, O_ENDL = O_SSQ + 1024;
    static_assert(O_ENDL <= RING_BYTES, "hgrn LDS map");
    LAS unsigned char* L = F.lds + RING_OFF;
    LAS bf16* QT = (LAS bf16*)(L + O_QT); LAS bf16* KT = (LAS bf16*)(L + O_KT);
    LAS float* SEG = (LAS float*)(L + O_SEG); LAS float* EB = (LAS float*)(L + O_EB); LAS float* EBR = (LAS float*)(L + O_EBR);
    const int tid = F.tid, lane = F.lane, wave = F.wave;
    const int vt = wave >> 1, tt = wave & 1;
    int k = tid & 127, sg = tid >> 7, l32 = lane & 31, hh = lane >> 5;
    f32x16 S0, S1;
#pragma unroll
    for (int r = 0; r < 16; ++r) { S0[r] = 0.f; S1[r] = 0.f; }
    float Bseg = 0.f;
    const size_t hb = ((size_t)(b * 4 + h) * 32 * 4 + sg) * 128 * 16 + (size_t)k * 16;
    const bf16* HQp = (const bf16*)(ws + WS_HQ) + hb; const bf16* HKp = (const bf16*)(ws + WS_HK) + hb; const bf16* HVp = (const bf16*)(ws + WS_HV) + hb; const float* HLp = (const float*)(ws + WS_HLF) + hb;
    v4u n_q0, n_q1, n_k0, n_k1, n_v0, n_v1; f32x4 n_l[4];
#define HG_LOAD_L(cn) do { const int o_ = 8192 * (cn); _Pragma("unroll") for (int j_ = 0; j_ < 4; ++j_) n_l[j_] = *(const f32x4*)(HLp + o_ + 4 * j_); } while (0)
#define HG_LOAD_QKV(cn) do { const int o_ = 8192 * (cn); n_q0 = *(const v4u*)(HQp + o_); n_q1 = *(const v4u*)(HQp + o_ + 8); n_k0 = *(const v4u*)(HKp + o_); n_k1 = *(const v4u*)(HKp + o_ + 8); \
        n_v0 = *(const v4u*)(HVp + o_); n_v1 = *(const v4u*)(HVp + o_ + 8); } while (0)
    HG_LOAD_L(4 * seg); HG_LOAD_QKV(4 * seg);
    LDS_BAR();
    for (int c = 4 * seg; c < 4 * seg + 4; ++c) {
        const int mb = b * SEQ + c * 64;
        asm volatile("" : "+v"(k), "+v"(sg), "+v"(l32), "+v"(hh));
        float cl[16], q[16], kk[16];
        { float run = 0.f;
#pragma unroll
          for (int j = 0; j < 4; ++j) { run += n_l[j].x; cl[4 * j] = run; run += n_l[j].y; cl[4 * j + 1] = run; run += n_l[j].z; cl[4 * j + 2] = run; run += n_l[j].w; cl[4 * j + 3] = run; }
          SEG[sg * 128 + k] = run; }
#define HG_UNP(dst, o, V_) do { const v4u u_ = (V_); dst[o] = bflo(u_.x); dst[o + 1] = bfhi(u_.x); dst[o + 2] = bflo(u_.y); dst[o + 3] = bfhi(u_.y); dst[o + 4] = bflo(u_.z); dst[o + 5] = bfhi(u_.z); dst[o + 6] = bflo(u_.w); dst[o + 7] = bfhi(u_.w); } while (0)
        HG_UNP(q, 0, n_q0); HG_UNP(q, 8, n_q1); HG_UNP(kk, 0, n_k0); HG_UNP(kk, 8, n_k1);
#undef HG_UNP
        const v4u vv0 = n_v0, vv1 = n_v1;
        if (c + 1 < 4 * seg + 4) { HG_LOAD_L(c + 1); HG_LOAD_QKV(c + 1); }
        LDS_BAR();
#pragma unroll
        for (int kti = 0; kti < 2; ++kti) { const int kt = 2 * tt + kti;
#pragma unroll
            for (int g = 0; g < 4; ++g) { const int k0 = 32 * kt + 8 * g + 4 * hh;
                const f32x4 r0 = *(const LAS f32x4*)(SEG + k0), r1 = *(const LAS f32x4*)(SEG + 128 + k0);
                const float s0 = kti ? S1[4 * g] : S0[4 * g], s1 = kti ? S1[4 * g + 1] : S0[4 * g + 1], s2 = kti ? S1[4 * g + 2] : S0[4 * g + 2], s3 = kti ? S1[4 * g + 3] : S0[4 * g + 3];
                v2u w; w.x = cvtpk(s0 * __builtin_amdgcn_exp2f(r0.x + r1.x), s1 * __builtin_amdgcn_exp2f(r0.y + r1.y));
                w.y = cvtpk(s2 * __builtin_amdgcn_exp2f(r0.z + r1.z), s3 * __builtin_amdgcn_exp2f(r0.w + r1.w));
                *(LAS v2u*)(L + O_SP + ((32 * vt + l32) * RSK + k0) * 2) = w; } }
        {
            const float t0 = SEG[k], t1 = SEG[128 + k], t2 = SEG[256 + k], t3 = SEG[384 + k];
            const float pre = (sg > 0 ? t0 : 0.f) + (sg > 1 ? t1 : 0.f) + (sg > 2 ? t2 : 0.f);
            const float ref = t0 + t1, blast = ref + t2 + t3;
            unsigned kp[8];
#pragma unroll
            for (int i = 0; i < 16; i += 2) {
                const float b0 = pre + cl[i], b1 = pre + cl[i + 1];
                const float qt0 = q[i] * __builtin_amdgcn_exp2f(b0 - ref), qt1 = q[i + 1] * __builtin_amdgcn_exp2f(b1 - ref);
                const float kt0 = kk[i] * __builtin_amdgcn_exp2f(ref - b0), kt1 = kk[i + 1] * __builtin_amdgcn_exp2f(ref - b1);
                const unsigned wq = cvtpk(qt0, qt1), wk = cvtpk(kt0, kt1), wb = cvtpk(q[i] * __builtin_amdgcn_exp2f(Bseg + b0), q[i + 1] * __builtin_amdgcn_exp2f(Bseg + b1));
                const int t = 16 * sg + i;
                QB[(size_t)(mb + t) * 512 + h * 128 + k] = (bf16)(wb & 0xffffu); QB[(size_t)(mb + t + 1) * 512 + h * 128 + k] = (bf16)(wb >> 16);
                QT[t * RSK + k] = (bf16)(wq & 0xffffu); QT[(t + 1) * RSK + k] = (bf16)(wq >> 16);
                KT[t * RSK + k] = (bf16)(wk & 0xffffu); KT[(t + 1) * RSK + k] = (bf16)(wk >> 16);
                kp[i >> 1] = wk;
            }
            *(LAS v4u*)(L + O_KTT + (k * RST + 16 * sg) * 2) = (v4u){kp[0], kp[1], kp[2], kp[3]};
            *(LAS v4u*)(L + O_KTT + (k * RST + 16 * sg + 8) * 2) = (v4u){kp[4], kp[5], kp[6], kp[7]};
            *(LAS v4u*)(L + O_VT + (k * RST + 16 * sg) * 2) = vv0;
            *(LAS v4u*)(L + O_VT + (k * RST + 16 * sg + 8) * 2) = vv1;
            if (sg == 0) { EB[k] = __builtin_amdgcn_exp2f(blast); EBR[k] = __builtin_amdgcn_exp2f(blast - ref); }
            Bseg += blast;
        }
        LDS_BAR();
        __builtin_amdgcn_sched_barrier(0);
        f32x16 oT;
#pragma unroll
        for (int r = 0; r < 16; ++r) oT[r] = 0.f;
#pragma unroll
        for (int st = 0; st < 2; ++st) {
            if (st <= tt) {
                f32x16 a;
#pragma unroll
                for (int r = 0; r < 16; ++r) a[r] = 0.f;
#pragma unroll
                for (int ks = 0; ks < 8; ++ks) {
                    const bf16x8 A = *(const LAS bf16x8*)(L + O_KT + ((32 * st + l32) * RSK + 16 * ks + 8 * hh) * 2);
                    const bf16x8 B = *(const LAS bf16x8*)(L + O_QT + ((32 * tt + l32) * RSK + 16 * ks + 8 * hh) * 2);
                    a = MFMA32(A, B, a);
                    if (ks & 1) __builtin_amdgcn_sched_barrier(0);
                }
                if (st == tt) {
#pragma unroll
                    for (int r = 0; r < 16; ++r) { const int sl = 8 * (r >> 2) + 4 * hh + (r & 3); if (sl > l32) a[r] = 0.f; }
                }
#pragma unroll
                for (int j = 0; j < 2; ++j) {
                    v4u bp; bp.x = cvtpk(a[8 * j], a[8 * j + 1]); bp.y = cvtpk(a[8 * j + 2], a[8 * j + 3]); bp.z = cvtpk(a[8 * j + 4], a[8 * j + 5]); bp.w = cvtpk(a[8 * j + 6], a[8 * j + 7]);
                    const v2u lo = *(const LAS v2u*)(L + O_VT + ((32 * vt + l32) * RST + 32 * st + 16 * j + 4 * hh) * 2);
                    const v2u hi = *(const LAS v2u*)(L + O_VT + ((32 * vt + l32) * RST + 32 * st + 16 * j + 8 + 4 * hh) * 2);
                    const v4u av = (v4u){lo.x, lo.y, hi.x, hi.y};
                    oT = MFMA32(__builtin_bit_cast(bf16x8, av), __builtin_bit_cast(bf16x8, bp), oT);
                    __builtin_amdgcn_sched_barrier(0);
                }
            }
            __builtin_amdgcn_sched_barrier(0);
        }
#pragma unroll
        for (int ks = 0; ks < 8; ++ks) {
            const bf16x8 A = *(const LAS bf16x8*)(L + O_SP + ((32 * vt + l32) * RSK + 16 * ks + 8 * hh) * 2);
            const bf16x8 B = *(const LAS bf16x8*)(L + O_QT + ((32 * tt + l32) * RSK + 16 * ks + 8 * hh) * 2);
            oT = MFMA32(A, B, oT);
            if (ks & 1) __builtin_amdgcn_sched_barrier(0);
        }
        __builtin_amdgcn_sched_barrier(0);
#pragma unroll
        for (int kti = 0; kti < 2; ++kti) {
            const int kt = 2 * tt + kti;
            f32x16 T;
#pragma unroll
            for (int r = 0; r < 16; ++r) T[r] = 0.f;
#pragma unroll
            for (int ts = 0; ts < 4; ++ts) {
                const bf16x8 A = *(const LAS bf16x8*)(L + O_KTT + ((32 * kt + l32) * RST + 16 * ts + 8 * hh) * 2);
                const bf16x8 B = *(const LAS bf16x8*)(L + O_VT + ((32 * vt + l32) * RST + 16 * ts + 8 * hh) * 2);
                T = MFMA32(A, B, T);
                if (ts & 1) __builtin_amdgcn_sched_barrier(0);
            }
#pragma unroll
            for (int g = 0; g < 4; ++g) {
                const f32x4 eb = *(const LAS f32x4*)(EB + 32 * kt + 8 * g + 4 * hh), ebr = *(const LAS f32x4*)(EBR + 32 * kt + 8 * g + 4 * hh);
#pragma unroll
                for (int e = 0; e < 4; ++e) { if (kti) S1[4 * g + e] = eb[e] * S1[4 * g + e] + ebr[e] * T[4 * g + e]; else S0[4 * g + e] = eb[e] * S0[4 * g + e] + ebr[e] * T[4 * g + e]; }
            }
            __builtin_amdgcn_sched_barrier(0);
        }
        {
            float* op = OP + ((size_t)(((b * 4 + h) * 8 + seg) * 4 + (c & 3)) * 8 + wave) * 1024 + (size_t)lane * 4;
#pragma unroll
            for (int g = 0; g < 4; ++g) *(f32x4*)(op + 256 * g) = (f32x4){oT[4 * g], oT[4 * g + 1], oT[4 * g + 2], oT[4 * g + 3]};
        }
    }
#undef HG_LOAD_L
#undef HG_LOAD_QKV
    asm volatile("" : "+v"(l32), "+v"(hh));
    const int un = (b * 4 + h) * 8 + seg;
    float* So = (float*)(ws + WS_HSL) + (size_t)un * 128 * 128;
    if (sg == 0) ((float*)(ws + WS_HDE))[un * 128 + k] = __builtin_amdgcn_exp2f(Bseg);
#pragma unroll
    for (int kti = 0; kti < 2; ++kti)
#pragma unroll
        for (int g = 0; g < 4; ++g) *(f32x4*)(So + (size_t)(((wave * 2 + kti) * 4 + g) * 64 + lane) * 4) = kti ? (f32x4){S1[4 * g], S1[4 * g + 1], S1[4 * g + 2], S1[4 * g + 3]} : (f32x4){S0[4 * g], S0[4 * g + 1], S0[4 * g + 2], S0[4 * g + 3]};
    LDS_BAR();
}

__device__ __forceinline__ void hgrn_pass2(Frame& F, int l, int b, int h, int seg) {
    unsigned char* ws = F.ws; const bf16* P = (const bf16*)(ws + WS_PROJ); bf16* MIX = (bf16*)(ws + WS_MIX); const bf16* QB = (const bf16*)(ws + WS_HQB); const float* OP = (const float*)(ws + WS_HOP);
    constexpr int RSK = 136;
    constexpr int O_SP = 0, O_QB = 128 * RSK * 2, O_SSQ = O_QB + 256 * RSK * 2, O_ENDL = O_SSQ + 4096;
    static_assert(O_ENDL <= RING_BYTES, "hgrn pass 2 LDS map");
    LAS unsigned char* L = F.lds + RING_OFF; LAS float* SSQ = (LAS float*)(L + O_SSQ);
    const int tid = F.tid, lane = F.lane, wave = F.wave, vt = wave >> 1, tt = wave & 1;
    int l32 = lane & 31, hh = lane >> 5;
    const int u0 = (b * 4 + h) * 8, m0 = b * SEQ + seg * 256;
    const float* SL = (const float*)(ws + WS_HSL); const float* DE = (const float*)(ws + WS_HDE);
    f32x16 S0, S1;
    {
        f32x4 w[8], acc[8];
#pragma unroll
        for (int q = 0; q < 8; ++q) { w[q] = (f32x4){1.f, 1.f, 1.f, 1.f}; acc[q] = (f32x4){0.f, 0.f, 0.f, 0.f}; }
#pragma unroll 1
        for (int j = seg - 1; j >= 0; --j) {
            const float* sl = SL + (size_t)(u0 + j) * 128 * 128 + (size_t)(wave * 8 * 64 + lane) * 4;
            f32x4 x[8];
#pragma unroll
            for (int q = 0; q < 8; ++q) x[q] = *(const f32x4*)(sl + (size_t)q * 256);
#pragma unroll
            for (int q = 0; q < 8; ++q) acc[q] = acc[q] + w[q] * x[q];
            if (j > 0) { const float* de = DE + (u0 + j) * 128;
#pragma unroll
                for (int q = 0; q < 8; ++q) w[q] = w[q] * *(const f32x4*)(de + 32 * (2 * tt + (q >> 2)) + 8 * (q & 3) + 4 * hh); }
        }
#pragma unroll
        for (int g = 0; g < 4; ++g) { S0[4 * g] = acc[g].x; S0[4 * g + 1] = acc[g].y; S0[4 * g + 2] = acc[g].z; S0[4 * g + 3] = acc[g].w;
            S1[4 * g] = acc[4 + g].x; S1[4 * g + 1] = acc[4 + g].y; S1[4 * g + 2] = acc[4 + g].z; S1[4 * g + 3] = acc[4 + g].w; }
    }
    v4u qv[8];
    if (seg > 0) {
#pragma unroll
        for (int i = 0; i < 8; ++i) { const int ch = tid + 512 * i; qv[i] = *(const v4u*)(QB + (size_t)(m0 + (ch >> 4)) * 512 + h * 128 + 8 * (ch & 15)); } }
    LDS_BAR();
#pragma unroll
    for (int kti = 0; kti < 2; ++kti) { const int kt = 2 * tt + kti;
#pragma unroll
        for (int g = 0; g < 4; ++g) { const int k0 = 32 * kt + 8 * g + 4 * hh;
            v2u w; w.x = kti ? cvtpk(S1[4 * g], S1[4 * g + 1]) : cvtpk(S0[4 * g], S0[4 * g + 1]); w.y = kti ? cvtpk(S1[4 * g + 2], S1[4 * g + 3]) : cvtpk(S0[4 * g + 2], S0[4 * g + 3]);
            *(LAS v2u*)(L + O_SP + ((32 * vt + l32) * RSK + k0) * 2) = w; } }
    if (seg > 0) {
#pragma unroll
        for (int i = 0; i < 8; ++i) { const int ch = tid + 512 * i; *(LAS v4u*)(L + O_QB + ((ch >> 4) * RSK + 8 * (ch & 15)) * 2) = qv[i]; } }
    if (seg == 7) {
        const float* sl = SL + (size_t)(u0 + 7) * 128 * 128 + (size_t)(wave * 8 * 64 + lane) * 4; const float* de = DE + (u0 + 7) * 128;
        float* So = F.out + O_HP + ((size_t)(l * NB + b) * 4 + h) * 128 * 128 + 32 * vt + l32;
#pragma unroll
        for (int kti = 0; kti < 2; ++kti) { const int kt = 2 * tt + kti;
#pragma unroll
            for (int g = 0; g < 4; ++g) { const int k0 = 32 * kt + 8 * g + 4 * hh; const f32x4 d4 = *(const f32x4*)(de + k0); const f32x4 x4 = *(const f32x4*)(sl + (size_t)(kti * 4 + g) * 256);
#pragma unroll
                for (int e = 0; e < 4; ++e) So[(size_t)(k0 + e) * 128] = d4[e] * (kti ? S1[4 * g + e] : S0[4 * g + e]) + x4[e]; } }
    }
    LDS_BAR();
    asm volatile("" : "+v"(l32), "+v"(hh));
    f32x16 oT[4];
#pragma unroll
    for (int i = 0; i < 4; ++i) {
        { const float* op = OP + ((size_t)((u0 + seg) * 4 + i) * 8 + wave) * 1024 + (size_t)lane * 4;
#pragma unroll
          for (int g = 0; g < 4; ++g) { const f32x4 x = *(const f32x4*)(op + 256 * g); oT[i][4 * g] = x.x; oT[i][4 * g + 1] = x.y; oT[i][4 * g + 2] = x.z; oT[i][4 * g + 3] = x.w; } }
        if (seg > 0) {
            LAS unsigned char* spb = L + O_SP + ((32 * vt + l32) * RSK + 8 * hh) * 2; asm volatile("" : "+v"(spb));
            LAS unsigned char* qbb = L + O_QB + ((64 * i + 32 * tt + l32) * RSK + 8 * hh) * 2; asm volatile("" : "+v"(qbb));
#pragma unroll
            for (int ks = 0; ks < 8; ++ks) { const bf16x8 A = *(const LAS bf16x8*)(spb + 32 * ks); const bf16x8 B = *(const LAS bf16x8*)(qbb + 32 * ks); oT[i] = MFMA32(A, B, oT[i]);
                if (ks & 1) __builtin_amdgcn_sched_barrier(0); }
        }
        float ss = 0.f;
#pragma unroll
        for (int r = 0; r < 16; ++r) ss += oT[i][r] * oT[i][r];
        ss += __shfl_xor(ss, 32);
        if (hh == 0) SSQ[vt * 256 + 64 * i + 32 * tt + l32] = ss;
    }
    LDS_BAR();
    const float* gn = F.in[IN_HN] + l * 512 + h * 128;
#pragma unroll
    for (int i = 0; i < 4; ++i) {
        const int tl = 64 * i + 32 * tt + l32;
        const float tot = (SSQ[tl] + SSQ[256 + tl]) + (SSQ[512 + tl] + SSQ[768 + tl]);
        const float rinv = rsqrtf(tot * (1.f / 128.f) + EPS);
#pragma unroll
        for (int g = 0; g < 4; ++g) { const int v0 = 32 * vt + 8 * g + 4 * hh; const f32x4 g4 = *(const f32x4*)(gn + v0);
            v2u w; w.x = cvtpk(oT[i][4 * g] * rinv * g4.x, oT[i][4 * g + 1] * rinv * g4.y); w.y = cvtpk(oT[i][4 * g + 2] * rinv * g4.z, oT[i][4 * g + 3] * rinv * g4.w);
            *(LAS v2u*)(L + O_QB + (tl * RSK + v0) * 2) = w; }
    }
    LDS_BAR();
#pragma unroll
    for (int i = 0; i < 8; ++i) { const int ch = tid + 512 * i, row = ch >> 4, c8 = 8 * (ch & 15);
        float o[8], g[8]; unpack8(*(const LAS v4u*)(L + O_QB + (row * RSK + c8) * 2), o); unpack8(*(const v4u*)(P + (size_t)(m0 + row) * PIN + C_GR + h * 128 + c8), g);
        *(v4u*)(MIX + (size_t)(m0 + row) * DM + 512 + h * 128 + c8) = (v4u){cvtpk(o[0] * g[0], o[1] * g[1]), cvtpk(o[2] * g[2], o[3] * g[3]), cvtpk(o[4] * g[4], o[5] * g[5]), cvtpk(o[6] * g[6], o[7] * g[7])}; }
}

__device__ __forceinline__ void swa_unit_prompt(Frame& F, int l, int b, int kvh, int jb) {
    unsigned char* ws = F.ws; const bf16* P = (const bf16*)(ws + WS_PROJ); bf16* MIX = (bf16*)(ws + WS_MIX);
    const float* cs = (const float*)(ws + WS_TAB + TAB_COS); const float* sn = (const float*)(ws + WS_TAB + TAB_SIN);
    constexpr int RK = 72, RV = 264;
    constexpr int O_KR = 0, O_VT = 256 * RK * 2, O_E = O_VT + 64 * RV * 2;
    static_assert(O_E <= 100 * 1024, "swa LDS map");
    LAS unsigned char* L = F.lds + RING_OFF;
    const int tid = F.tid, lane = F.lane, wave = F.wave;
    const int l32 = lane & 31, hh = lane >> 5;
    const int p0 = jb * 128 - 128;
    LDS_BAR();
#pragma unroll
    for (int i = 0; i < 2; ++i) { const int item = tid + 512 * i, ci = item >> 2, c8 = item & 3, kp = p0 + ci;
        v4u w1 = {0u, 0u, 0u, 0u}, w2 = w1;
        if (kp >= 0) { const bf16* kr = P + (size_t)(b * SEQ + kp) * PIN + C_K + kvh * 64 + c8 * 8;
            float k1[8], k2[8], cc[8], ss[8]; unpack8(*(const v4u*)kr, k1); unpack8(*(const v4u*)(kr + 32), k2); load8f(cs + kp * 32 + c8 * 8, cc); load8f(sn + kp * 32 + c8 * 8, ss);
            float r1[8], r2[8];
#pragma unroll
            for (int e = 0; e < 8; ++e) { r1[e] = k1[e] * cc[e] - k2[e] * ss[e]; r2[e] = k2[e] * cc[e] + k1[e] * ss[e]; }
            w1 = (v4u){cvtpk(r1[0], r1[1]), cvtpk(r1[2], r1[3]), cvtpk(r1[4], r1[5]), cvtpk(r1[6], r1[7])};
            w2 = (v4u){cvtpk(r2[0], r2[1]), cvtpk(r2[2], r2[3]), cvtpk(r2[4], r2[5]), cvtpk(r2[6], r2[7])};
            if (jb == SEQ / 128 - 1 && ci >= 128) { float* ok = F.out + O_WKP + (((size_t)(l * NB + b) * 128 + (ci - 128)) * 2 + kvh) * 64 + c8 * 8;
                *(f32x4*)ok = (f32x4){r1[0], r1[1], r1[2], r1[3]}; *(f32x4*)(ok + 4) = (f32x4){r1[4], r1[5], r1[6], r1[7]};
                *(f32x4*)(ok + 32) = (f32x4){r2[0], r2[1], r2[2], r2[3]}; *(f32x4*)(ok + 36) = (f32x4){r2[4], r2[5], r2[6], r2[7]}; } }
        *(LAS v4u*)(L + O_KR + (ci * RK + c8 * 8) * 2) = w1; *(LAS v4u*)(L + O_KR + (ci * RK + 32 + c8 * 8) * 2) = w2; }
    { const int d = tid & 63, kg = tid >> 6;
#pragma unroll
      for (int q4 = 0; q4 < 4; ++q4) { unsigned w[4];
#pragma unroll
          for (int e = 0; e < 4; ++e) { const int ci = 32 * kg + 8 * q4 + 2 * e, kp = p0 + ci; unsigned short a = 0, c = 0;
              if (kp >= 0) { a = P[(size_t)(b * SEQ + kp) * PIN + C_V + kvh * 64 + d]; c = P[(size_t)(b * SEQ + kp + 1) * PIN + C_V + kvh * 64 + d];
                  if (jb == SEQ / 128 - 1 && ci >= 128) { float* ov = F.out + O_WVP + (((size_t)(l * NB + b) * 128 + (ci - 128)) * 2 + kvh) * 64 + d; ov[0] = bf2f(a); ov[128] = bf2f(c); } }
              w[e] = (unsigned)a | ((unsigned)c << 16); }
          *(LAS v4u*)(L + O_VT + (d * RV + 32 * kg + 8 * q4) * 2) = (v4u){w[0], w[1], w[2], w[3]}; } }
    LDS_BAR();
    const int g = wave >> 1, h = kvh * 4 + g;
    const float sink2 = F.in[IN_SINK][l * 8 + h] * 1.4426950408889634f;
#pragma unroll 1
    for (int s = 0; s < 2; ++s) {
        const int r0 = 64 * (wave & 1) + 32 * s;
        const int t = jb * 128 + r0 + l32;
        bf16x8 qf[4];
        { const bf16* qr = P + (size_t)(b * SEQ + t) * PIN + h * 64 + 8 * hh;
          float x[4][8]; unpack8(*(const v4u*)qr, x[0]); unpack8(*(const v4u*)(qr + 16), x[1]); unpack8(*(const v4u*)(qr + 32), x[2]); unpack8(*(const v4u*)(qr + 48), x[3]);
          const float qs = 0.125f * 1.4426950408889634f;
#pragma unroll
          for (int ks = 0; ks < 2; ++ks) { float cc[8], ss[8]; load8f(cs + t * 32 + 16 * ks + 8 * hh, cc); load8f(sn + t * 32 + 16 * ks + 8 * hh, ss); float r1[8], r2[8];
#pragma unroll
              for (int e = 0; e < 8; ++e) { r1[e] = (x[ks][e] * cc[e] - x[ks + 2][e] * ss[e]) * qs; r2[e] = (x[ks + 2][e] * cc[e] + x[ks][e] * ss[e]) * qs; }
              qf[ks] = __builtin_bit_cast(bf16x8, (v4u){cvtpk(r1[0], r1[1]), cvtpk(r1[2], r1[3]), cvtpk(r1[4], r1[5]), cvtpk(r1[6], r1[7])});
              qf[ks + 2] = __builtin_bit_cast(bf16x8, (v4u){cvtpk(r2[0], r2[1]), cvtpk(r2[2], r2[3]), cvtpk(r2[4], r2[5]), cvtpk(r2[6], r2[7])}); } }
        f32x16 sc[5];
#pragma unroll
        for (int kt = 0; kt < 5; ++kt) {
#pragma unroll
            for (int r = 0; r < 16; ++r) sc[kt][r] = 0.f;
#pragma unroll
            for (int ks = 0; ks < 4; ++ks) { const bf16x8 A = *(const LAS bf16x8*)(L + O_KR + ((r0 + 32 * kt + l32) * RK + 16 * ks + 8 * hh) * 2); sc[kt] = MFMA32(A, qf[ks], sc[kt]); }
            __builtin_amdgcn_sched_barrier(0);
        }
        const int kt_lo = (jb == 0) ? 4 - (r0 >> 5) : 0;
        float mx = sink2;
#pragma unroll
        for (int kt = 0; kt < 5; ++kt)
#pragma unroll
            for (int r = 0; r < 16; ++r) { const int kl = 8 * (r >> 2) + 4 * hh + (r & 3);
                bool ok = kt >= kt_lo; if (kt == 0) ok = ok && (kl >= l32); if (kt == 4) ok = ok && (kl <= l32);
                const float v = ok ? sc[kt][r] : -INFINITY; sc[kt][r] = v; mx = fmaxf(mx, v); }
        mx = fmaxf(mx, __shfl_xor(mx, 32));
        float sum = 0.f;
#pragma unroll
        for (int kt = 0; kt < 5; ++kt)
#pragma unroll
            for (int r = 0; r < 16; ++r) { const float p = __builtin_amdgcn_exp2f(sc[kt][r] - mx); sc[kt][r] = p; sum += p; }
        sum += __shfl_xor(sum, 32);
        const float inv = 1.f / (sum + __builtin_amdgcn_exp2f(sink2 - mx));
        f32x16 o[2];
#pragma unroll
        for (int dt = 0; dt < 2; ++dt) {
#pragma unroll
            for (int r = 0; r < 16; ++r) o[dt][r] = 0.f; }
#pragma unroll
        for (int kt = 0; kt < 5; ++kt) {
#pragma unroll
            for (int j = 0; j < 2; ++j) {
                const v4u bp = {cvtpk(sc[kt][8 * j], sc[kt][8 * j + 1]), cvtpk(sc[kt][8 * j + 2], sc[kt][8 * j + 3]), cvtpk(sc[kt][8 * j + 4], sc[kt][8 * j + 5]), cvtpk(sc[kt][8 * j + 6], sc[kt][8 * j + 7])};
#pragma unroll
                for (int dt = 0; dt < 2; ++dt) {
                    const v2u lo = *(const LAS v2u*)(L + O_VT + ((32 * dt + l32) * RV + r0 + 32 * kt + 16 * j + 4 * hh) * 2);
                    const v2u hi = *(const LAS v2u*)(L + O_VT + ((32 * dt + l32) * RV + r0 + 32 * kt + 16 * j + 8 + 4 * hh) * 2);
                    o[dt] = MFMA32(__builtin_bit_cast(bf16x8, (v4u){lo.x, lo.y, hi.x, hi.y}), __builtin_bit_cast(bf16x8, bp), o[dt]);
                }
            }
            __builtin_amdgcn_sched_barrier(0);
        }
        bf16* orow = MIX + (size_t)(b * SEQ + t) * DM + h * 64 + 4 * hh;
#pragma unroll
        for (int dt = 0; dt < 2; ++dt)
#pragma unroll
            for (int g4 = 0; g4 < 4; ++g4) { v2u w; w.x = cvtpk(o[dt][4 * g4] * inv, o[dt][4 * g4 + 1] * inv); w.y = cvtpk(o[dt][4 * g4 + 2] * inv, o[dt][4 * g4 + 3] * inv);
                *(v2u*)(orow + 32 * dt + 8 * g4) = w; }
    }
}

#define MFMA16(a, b, c) __builtin_amdgcn_mfma_f32_16x16x32_bf16((a), (b), (c), 0, 0, 0)
__device__ __forceinline__ void xattn_unit_prompt(Frame& F, int l, int b, int h, int qb) {
    unsigned char* ws = F.ws; const bf16* QX = (const bf16*)(ws + WS_QX); bf16* OX = (bf16*)(ws + WS_OX);
    const bf16* MK = (const bf16*)(ws + WS_MK) + ((size_t)l * 2048 + b * 256) * DM + h * 256;
    const bf16* MVT = (const bf16*)(ws + WS_MVT) + ((size_t)((l * NB + b) * 4 + h) * 256) * 256;
    constexpr int RKX = 264, RVX = 68;
    constexpr int TILE_K = 64 * RKX * 2, TILE_V = 256 * RVX * 2;
    static_assert(2 * TILE_V <= 100 * 1024, "xattn LDS map");
    LAS unsigned char* L = F.lds + RING_OFF;
    const int tid = F.tid, lane = F.lane, wave = F.wave;
    const int l32 = lane & 31, hh = lane >> 5;
    const int row = b * SEQ + qb * 256 + wave * 32 + l32;
    bf16x8 qf[16];
    { const bf16* qr = QX + (size_t)row * DM + h * 256 + 8 * hh;
#pragma unroll
      for (int ks = 0; ks < 16; ++ks) qf[ks] = *(const bf16x8*)(qr + 16 * ks); }
    v4u pre[2];
    bf16x8 pf[16];
    float tmx[4], runM = -INFINITY, runL = 0.f;
    unsigned koff[4];
#pragma unroll
    for (int j_ = 0; j_ < 4; ++j_) { const int ch_ = tid + 512 * j_; koff[j_] = (unsigned)(((ch_ >> 5) * DM + 8 * (ch_ & 31)) * 2); }
#define XK_LOAD(mt, hf) do { const char* kb_ = (const char*)MK + (size_t)(64 * (mt)) * DM * 2; _Pragma("unroll") for (int j_ = 0; j_ < 2; ++j_) pre[j_] = *(const v4u*)(kb_ + koff[2 * (hf) + j_]); } while (0)
#define XK_STORE(buf, hf) do { _Pragma("unroll") for (int j_ = 0; j_ < 2; ++j_) { const int ch_ = tid + 512 * (2 * (hf) + j_); *(LAS v4u*)(L + (buf) * TILE_K + ((ch_ >> 5) * RKX + 8 * (ch_ & 31)) * 2) = pre[j_]; } } while (0)
    LDS_BAR();
    XK_LOAD(0, 0); XK_STORE(0, 0); XK_LOAD(0, 1); XK_STORE(0, 1);
#pragma unroll
    for (int mt = 0; mt < 4; ++mt) {
        LDS_BAR();
        LAS unsigned char* kbp = L + (mt & 1) * TILE_K + (l32 * RKX + 8 * hh) * 2; asm volatile("" : "+v"(kbp));
        f32x16 sc[2];
#pragma unroll
        for (int i = 0; i < 2; ++i) {
            if (mt + 1 < 4) XK_LOAD(mt + 1, i);
#pragma unroll
            for (int r = 0; r < 16; ++r) sc[i][r] = 0.f;
#pragma unroll
            for (int ks = 0; ks < 16; ++ks) { const bf16x8 A = *(const LAS bf16x8*)(kbp + (32 * i * RKX + 16 * ks) * 2); sc[i] = MFMA32(A, qf[ks], sc[i]);
                if ((ks & 3) == 3) __builtin_amdgcn_sched_barrier(0); }
            if (mt + 1 < 4) XK_STORE((mt + 1) & 1, i);
        }
        float m_ = -INFINITY;
#pragma unroll
        for (int i = 0; i < 2; ++i)
#pragma unroll
            for (int r = 0; r < 16; ++r) m_ = fmaxf(m_, sc[i][r]);
        m_ = fmaxf(m_, __shfl_xor(m_, 32));
        float s_ = 0.f;
#pragma unroll
        for (int i = 0; i < 2; ++i) {
#pragma unroll
            for (int r = 0; r < 16; ++r) { const float p = __builtin_amdgcn_exp2f(sc[i][r] - m_); sc[i][r] = p; s_ += p; }
#pragma unroll
            for (int j = 0; j < 2; ++j) pf[4 * mt + 2 * i + j] = __builtin_bit_cast(bf16x8, (v4u){cvtpk(sc[i][8 * j], sc[i][8 * j + 1]), cvtpk(sc[i][8 * j + 2], sc[i][8 * j + 3]), cvtpk(sc[i][8 * j + 4], sc[i][8 * j + 5]), cvtpk(sc[i][8 * j + 6], sc[i][8 * j + 7])});
        }
        tmx[mt] = m_; { const float nM = fmaxf(runM, m_); runL = runL * __builtin_amdgcn_exp2f(runM - nM) + s_ * __builtin_amdgcn_exp2f(m_ - nM); runM = nM; }
    }
#undef XK_LOAD
#undef XK_STORE
    const float mx = runM;
    float sum = runL;
#pragma unroll
    for (int mt = 0; mt < 4; ++mt) { const float scl_ = __builtin_amdgcn_exp2f(tmx[mt] - mx);
#pragma unroll
        for (int f = 0; f < 4; ++f) { const v4u w = __builtin_bit_cast(v4u, pf[4 * mt + f]);
            pf[4 * mt + f] = __builtin_bit_cast(bf16x8, (v4u){cvtpk(bflo(w.x) * scl_, bfhi(w.x) * scl_), cvtpk(bflo(w.y) * scl_, bfhi(w.y) * scl_), cvtpk(bflo(w.z) * scl_, bfhi(w.z) * scl_), cvtpk(bflo(w.w) * scl_, bfhi(w.w) * scl_)}); } }
    sum += __shfl_xor(sum, 32);
    const float inv = 1.f / sum;
    constexpr int TILE_H = 128 * RVX * 2;
    unsigned voff[2];
#pragma unroll
    for (int j_ = 0; j_ < 2; ++j_) { const int ch_ = tid + 512 * j_; voff[j_] = (unsigned)(((ch_ >> 3) * 256 + 8 * (ch_ & 7)) * 2); }
#define XV_LOAD(st) do { const char* vb_ = (const char*)MVT + ((size_t)(128 * ((st) >> 2)) * 256 + 64 * ((st) & 3)) * 2; _Pragma("unroll") for (int j_ = 0; j_ < 2; ++j_) pre[j_] = *(const v4u*)(vb_ + voff[j_]); } while (0)
#define XV_STORE(buf) do { _Pragma("unroll") for (int j_ = 0; j_ < 2; ++j_) { const int ch_ = tid + 512 * j_; LAS unsigned char* d_ = L + (buf) * TILE_H + ((ch_ >> 3) * RVX + 8 * (ch_ & 7)) * 2; *(LAS v2u*)d_ = (v2u){pre[j_].x, pre[j_].y}; *(LAS v2u*)(d_ + 8) = (v2u){pre[j_].z, pre[j_].w}; } } while (0)
    XV_LOAD(0);
    LDS_BAR();
    XV_STORE(0);
    bf16* orow = OX + (size_t)row * DM + h * 256 + 4 * hh;
#pragma unroll
    for (int dh = 0; dh < 2; ++dh) {
        f32x16 o[4];
#pragma unroll
        for (int i = 0; i < 4; ++i)
#pragma unroll
            for (int r = 0; r < 16; ++r) o[i][r] = 0.f;
#pragma unroll
        for (int mt = 0; mt < 4; ++mt) {
            const int st = 4 * dh + mt;
            if (st + 1 < 8) XV_LOAD(st + 1);
            LDS_BAR();
            LAS unsigned char* vbp = L + (st & 1) * TILE_H + (l32 * RVX + 4 * hh) * 2; asm volatile("" : "+v"(vbp));
#pragma unroll
            for (int dt = 0; dt < 4; ++dt) {
#pragma unroll
                for (int k4 = 0; k4 < 4; ++k4) {
                    const v2u lo = *(const LAS v2u*)(vbp + (32 * dt * RVX + 16 * k4) * 2);
                    const v2u hi = *(const LAS v2u*)(vbp + (32 * dt * RVX + 16 * k4 + 8) * 2);
                    o[dt] = MFMA32(__builtin_bit_cast(bf16x8, (v4u){lo.x, lo.y, hi.x, hi.y}), pf[4 * mt + k4], o[dt]);
                }
                __builtin_amdgcn_sched_barrier(0);
            }
            if (st + 1 < 8) XV_STORE((st + 1) & 1);
        }
#pragma unroll
        for (int dt = 0; dt < 4; ++dt)
#pragma unroll
            for (int g = 0; g < 4; ++g) { v2u w; w.x = cvtpk(o[dt][4 * g] * inv, o[dt][4 * g + 1] * inv); w.y = cvtpk(o[dt][4 * g + 2] * inv, o[dt][4 * g + 3] * inv); *(v2u*)(orow + 128 * dh + 32 * dt + 8 * g) = w; }
    }
#undef XV_LOAD
#undef XV_STORE
}

template <int K>
__device__ __forceinline__ void sample_slice_gemm(Frame& F, const bf16* A, const bf16* Wt, float* Yf, bf16* Qb, float sc, const float* rs = nullptr) {
    const int lane = F.lane, l16 = lane & 15, hq = lane >> 4, wave = F.wave;
    const int rg = blockIdx.x & 7, cs = blockIdx.x >> 3;
    constexpr int NKS = (K >> 5) / 8;
    const GAS bf16* ap = (const GAS bf16*)A + (size_t)(16 * rg + l16) * K + 8 * hq + 32 * NKS * wave;
    const GAS bf16* wp = (const GAS bf16*)Wt + (size_t)(32 * cs + l16) * K + 8 * hq + 32 * NKS * wave;
    f32x4 acc0 = {0.f, 0.f, 0.f, 0.f}, acc1 = acc0;
    bf16x8 a[NKS], b0[NKS], b1[NKS];
#pragma unroll
    for (int i = 0; i < NKS; ++i) { a[i] = *(const GAS bf16x8*)(ap + 32 * i); b0[i] = *(const GAS bf16x8*)(wp + 32 * i); b1[i] = *(const GAS bf16x8*)(wp + (size_t)16 * K + 32 * i); }
#pragma unroll
    for (int i = 0; i < NKS; ++i) { acc0 = MFMA16(a[i], b0[i], acc0); acc1 = MFMA16(a[i], b1[i], acc1); }
    LAS f32x4* red = (LAS f32x4*)(F.lds + RING_OFF);
    LDS_BAR();
    red[(wave * 2 + 0) * 64 + lane] = acc0; red[(wave * 2 + 1) * 64 + lane] = acc1;
    LDS_BAR();
    if (wave < 2) {
        f32x4 s = {0.f, 0.f, 0.f, 0.f};
#pragma unroll
        for (int w = 0; w < 8; ++w) s = s + red[(w * 2 + wave) * 64 + lane];
        const int n = 32 * cs + 16 * wave + l16;
#pragma unroll
        for (int e = 0; e < 4; ++e) { const size_t off = (size_t)(MP + 16 * rg + 4 * hq + e) * DM + n;
            const float rv = rs ? rs[16 * rg + 4 * hq + e] : 1.f;
            if (Yf) Yf[off] = s[e] * rv; else Qb[off] = (bf16)(cvtpk(s[e] * sc * rv, 0.f) & 0xffffu); }
    }
    LDS_BAR();
}

#ifndef MK_PER_PHASE
#define MK_PER_PHASE 0
#endif
#ifndef EN_CONV
#define EN_CONV 1
#endif
#ifndef EN_DOWN
#define EN_DOWN 1
#endif
#ifndef EN_INPROJ
#define EN_INPROJ 1
#endif
#ifndef EN_MEMKV
#define EN_MEMKV 1
#endif
#ifndef EN_MIX
#define EN_MIX 1
#endif
#ifndef EN_NORM
#define EN_NORM 1
#endif
#ifndef EN_PROLOG
#define EN_PROLOG 1
#endif
#ifndef EN_UP
#define EN_UP 1
#endif
#ifndef EN_WO
#define EN_WO 1
#endif
#ifndef EN_XATTN
#define EN_XATTN 1
#endif
#ifndef EN_XO
#define EN_XO 1
#endif
#ifndef EN_XQ
#define EN_XQ 1
#endif
#ifndef HGRN_NAIVE
#define HGRN_NAIVE 0
#endif
#ifndef DUP_PROLOG
#define DUP_PROLOG 0
#endif
#ifndef DUP_UP
#define DUP_UP 0
#endif
#ifndef DUP_WO
#define DUP_WO 0
#endif
#ifndef DUP_DOWN
#define DUP_DOWN 0
#endif
#ifndef DUP_P1
#define DUP_P1 0
#endif
#ifndef DUP_SWA
#define DUP_SWA 0
#endif
#ifndef DUP_SMP
#define DUP_SMP 0
#endif
#ifndef DUP_XP
#define DUP_XP 0
#endif
#ifndef DUP_XS
#define DUP_XS 0
#endif
#ifndef DUP_MIXB
#define DUP_MIXB 0
#endif
#ifndef DUP_MIX
#define DUP_MIX 0
#endif
#ifndef DUP_XATTN
#define DUP_XATTN 0
#endif
#ifndef DUP_CONV
#define DUP_CONV 0
#endif
#ifndef DUP_INPROJ
#define DUP_INPROJ 0
#endif
constexpr int N_PHASES = 2 + 13 * DEPTH;

struct Args { const float* in[29]; float* out; unsigned char* ws; int ph_lo, ph_hi; };

__global__ void __launch_bounds__(NTHR, 2) mk_fwd(Args args) {
    extern __shared__ __attribute__((aligned(16))) unsigned char lds[];
    Frame F;
    F.lds = (LAS unsigned char*)lds;
    F.MISC = (volatile LAS unsigned*)(F.lds + MISC_OFF);
    F.tid = threadIdx.x; F.lane = F.tid & 63; F.wave = __builtin_amdgcn_readfirstlane(F.tid >> 6);
    F.G = gridDim.x; F.gw = blockIdx.x * NWAVES + F.wave; F.ngw = F.G * NWAVES;
    F.ws = args.ws; F.out = args.out; F.ctl = (unsigned*)(args.ws + WS_CTL);
    F.in = args.in;
    for (int u = F.tid; u < (LDS_BYTES - LDSCTL_OFF) / 4; u += NTHR) ((LAS unsigned*)(F.lds + LDSCTL_OFF))[u] = 0u;
    __syncthreads();
    XcdBarrier bar = xcd_barrier_post(F.ctl + CW_BAR, F.MISC + 8);
    const int lo = args.ph_lo, hi = args.ph_hi;
    unsigned char* ws = args.ws; int bx = blockIdx.x;
#define FRESH() do { bx = blockIdx.x; F.lane = (int)__builtin_amdgcn_mbcnt_hi(~0u, __builtin_amdgcn_mbcnt_lo(~0u, 0u)); F.tid = F.wave * 64 + F.lane; asm volatile("" : "+s"(ws), "+v"(F.tid), "+v"(F.lane), "+s"(F.wave), "+s"(F.gw), "+s"(bx)); F.ws = ws; } while (0)
#define IN(k) (lo <= (k) && (k) < hi)
#define SEAM(k) do { if (IN((k) + 1)) xcd_barrier(bar); } while (0)
    LAS float* wl = (LAS float*)(F.lds + RING_OFF + 102400 + F.wave * 2048);

    if (EN_PROLOG && IN(0)) { _Pragma("unroll 1") for (int rep_ = 0; rep_ <= DUP_PROLOG; ++rep_) { FRESH(); p0_prologue(F); } SEAM(0); }
    if (EN_MEMKV && IN(1)) { FRESH();
        pg8::Gemm g{(const pg8::bf16_t*)(ws + WS_MEMN), (const pg8::bf16_t*)(ws + WS_WXKV), DEPTH * 2048, DEPTH * 2048, DM};
        pg8::BlockDiagOrder S{F.G, bx};
        pg8::EpiMemKV E{F.out + O_MKP, F.out + O_MVP, (pg8::bf16_t*)(ws + WS_MK), (pg8::bf16_t*)(ws + WS_MVT)};
        pg8::gemm_phase<pg8::EpiMemKV, pg8::BlockDiagOrder, true, true>(F.lds + RING_OFF, g, S, E, F.wave);
        SEAM(1);
    }
    for (int l = 0; l < DEPTH; ++l) {
        const int pb = 2 + 13 * l;
        if (EN_INPROJ && IN(pb + 0)) { FRESH();
            pg8::Gemm g{(const pg8::bf16_t*)(ws + WS_XN), (const pg8::bf16_t*)(ws + WS_WIN) + (size_t)l * PIN * DM, MT, PIN, DM};
            pg8::StaticOrder S; S.init(MT, PIN, F.G, bx);
            pg8::EpiProj E{(pg8::bf16_t*)(ws + WS_PROJ), (float*)(ws + WS_LF), (const float*)(ws + WS_TAB + TAB_LB) + l * 512, (pg8::bf16_t*)(ws + WS_HQ), (pg8::bf16_t*)(ws + WS_HK), (pg8::bf16_t*)(ws + WS_HV), (float*)(ws + WS_HLF)};
            _Pragma("unroll 1") for (int rep_ = 0; rep_ <= DUP_INPROJ; ++rep_) pg8::gemm_phase<pg8::EpiProj, pg8::StaticOrder, true, true>(F.lds + RING_OFF, g, S, E, F.wave);
            SEAM(pb + 0);
        }
        if (EN_MIX && IN(pb + 1)) { FRESH();
          _Pragma("unroll 1") for (int rep_ = 0; rep_ <= DUP_MIX; ++rep_) { FRESH();
            _Pragma("unroll 1") for (int r2_ = 0; r2_ <= DUP_P1; ++r2_) { FRESH(); for (int u = bx; u < NB * 4 * 8; u += F.G) hgrn_pass1(F, l, u >> 5, (u >> 3) & 3, u & 7); }
            _Pragma("unroll 1") for (int r2_ = 0; r2_ <= DUP_SWA; ++r2_) { FRESH(); for (int u = bx; u < NB * 2 * 16; u += F.G) swa_unit_prompt(F, l, u >> 5, (u >> 4) & 1, u & 15); }
            _Pragma("unroll 1") for (int r2_ = 0; r2_ <= DUP_SMP; ++r2_) { FRESH(); if (bx < DB) hgrn_unit_sample(F, l, bx); else if (bx < 2 * DB) swa_unit_sample(F, l, bx - DB); }
          }
            SEAM(pb + 1);
        }
        if (EN_MIX && IN(pb + 2)) { FRESH();
            _Pragma("unroll 1") for (int rep_ = 0; rep_ <= DUP_MIXB; ++rep_) { FRESH(); for (int u = bx; u < NB * 4 * 8; u += F.G) hgrn_pass2(F, l, u >> 5, (u >> 3) & 3, u & 7); }
            SEAM(pb + 2);
        }
        if (EN_WO && IN(pb + 3)) { FRESH();
            sample_slice_gemm<DM>(F, (const bf16*)(ws + WS_MIX) + (size_t)MP * DM, (const bf16*)(ws + WS_WO) + (size_t)l * DM * DM, nullptr, (bf16*)(ws + WS_Y), 1.f);
            pg8::Gemm g{(const pg8::bf16_t*)(ws + WS_MIX), (const pg8::bf16_t*)(ws + WS_WO) + (size_t)l * DM * DM, MP, DM, DM};
            pg8::StaticOrder S; S.init(MP, DM, F.G, bx);
            pg8::EpiB16 E{(pg8::bf16_t*)(ws + WS_Y), DM, 1.0f, nullptr};
            _Pragma("unroll 1") for (int rep_ = 0; rep_ <= DUP_WO; ++rep_) pg8::gemm_phase<pg8::EpiB16, pg8::StaticOrder, true, true>(F.lds + RING_OFF, g, S, E, F.wave);
            SEAM(pb + 3);
        }
        if (EN_NORM && IN(pb + 4)) { FRESH(); norm_phase(F, F.in[IN_GQM] + l * DM, nullptr, false); SEAM(pb + 4); }
        if (EN_XQ && IN(pb + 5)) { FRESH();
            sample_slice_gemm<DM>(F, (const bf16*)(ws + WS_X) + (size_t)MP * DM, (const bf16*)(ws + WS_WXQ) + (size_t)l * DM * DM, nullptr, (bf16*)(ws + WS_QX), 0.0625f * 1.4426950408889634f, (const float*)(ws + WS_RS) + MP);
            pg8::Gemm g{(const pg8::bf16_t*)(ws + WS_X), (const pg8::bf16_t*)(ws + WS_WXQ) + (size_t)l * DM * DM, MP, DM, DM};
            pg8::StaticOrder S; S.init(MP, DM, F.G, bx);
            pg8::EpiB16 E{(pg8::bf16_t*)(ws + WS_QX), DM, 0.0625f * 1.4426950408889634f, (const float*)(ws + WS_RS)};
            pg8::gemm_phase<pg8::EpiB16, pg8::StaticOrder, true, true>(F.lds + RING_OFF, g, S, E, F.wave);
            SEAM(pb + 5);
        }
        if (EN_XATTN && IN(pb + 6)) { FRESH();
          _Pragma("unroll 1") for (int rep_ = 0; rep_ <= DUP_XATTN; ++rep_) { FRESH();
            if (bx & 1) for (int u = bx; u < DB * 4; u += F.G) xattn_unit_sample(F, l, u >> 2, u & 3);
            _Pragma("unroll 1") for (int r2_ = 0; r2_ <= DUP_XP; ++r2_) { FRESH(); for (int u = bx; u < NB * 4 * 8; u += F.G) xattn_unit_prompt(F, l, u >> 5, (u >> 3) & 3, u & 7); }
            if (!(bx & 1)) for (int u = bx; u < DB * 4; u += F.G) xattn_unit_sample(F, l, u >> 2, u & 3);
            _Pragma("unroll 1") for (int r2_ = 0; r2_ < DUP_XS; ++r2_) { FRESH(); for (int u = bx; u < DB * 4; u += F.G) xattn_unit_sample(F, l, u >> 2, u & 3); }
          }
            SEAM(pb + 6);
        }
        if (EN_XO && IN(pb + 7)) { FRESH();
            sample_slice_gemm<DM>(F, (const bf16*)(ws + WS_OX) + (size_t)MP * DM, (const bf16*)(ws + WS_WXO) + (size_t)l * DM * DM, nullptr, (bf16*)(ws + WS_Y), 1.f);
            pg8::Gemm g{(const pg8::bf16_t*)(ws + WS_OX), (const pg8::bf16_t*)(ws + WS_WXO) + (size_t)l * DM * DM, MP, DM, DM};
            pg8::StaticOrder S; S.init(MP, DM, F.G, bx);
            pg8::EpiB16 E{(pg8::bf16_t*)(ws + WS_Y), DM, 1.0f, nullptr};
            pg8::gemm_phase<pg8::EpiB16, pg8::StaticOrder, true, true>(F.lds + RING_OFF, g, S, E, F.wave);
            SEAM(pb + 7);
        }
        if (EN_NORM && IN(pb + 8)) { FRESH(); norm_phase(F, F.in[IN_GQX] + l * DM, nullptr, false); SEAM(pb + 8); }
        if (EN_UP && IN(pb + 9)) { FRESH();
            pg8::Gemm g{(const pg8::bf16_t*)(ws + WS_X), (const pg8::bf16_t*)(ws + WS_WUP) + (size_t)l * UPW * DM, MT, UPW, DM};
            pg8::StaticOrder S; S.init(MT, UPW, F.G, bx);
            pg8::EpiB16 E{(pg8::bf16_t*)(ws + WS_U), UPW, 1.0f, (const float*)(ws + WS_RS)};
            _Pragma("unroll 1") for (int rep_ = 0; rep_ <= DUP_UP; ++rep_) pg8::gemm_phase<pg8::EpiB16, pg8::StaticOrder, true, true>(F.lds + RING_OFF, g, S, E, F.wave);
            SEAM(pb + 9);
        }
        if (EN_CONV && IN(pb + 10)) { FRESH(); _Pragma("unroll 1") for (int rep_ = 0; rep_ <= DUP_CONV; ++rep_) { FRESH(); conv_phase(F, l); } SEAM(pb + 10); }
        if (EN_DOWN && IN(pb + 11)) { FRESH();
            sample_slice_gemm<DFF>(F, (const bf16*)(ws + WS_G) + (size_t)MP * DFF, (const bf16*)(ws + WS_WDN) + (size_t)l * DM * DFF, nullptr, (bf16*)(ws + WS_Y), 1.f);
            pg8::Gemm g{(const pg8::bf16_t*)(ws + WS_G), (const pg8::bf16_t*)(ws + WS_WDN) + (size_t)l * DM * DFF, MP, DM, DFF};
            pg8::StaticOrder S; S.init(MP, DM, F.G, bx);
            pg8::EpiB16 E{(pg8::bf16_t*)(ws + WS_Y), DM, 1.0f, nullptr};
            _Pragma("unroll 1") for (int rep_ = 0; rep_ <= DUP_DOWN; ++rep_) pg8::gemm_phase<pg8::EpiB16, pg8::StaticOrder, true, true>(F.lds + RING_OFF, g, S, E, F.wave);
            SEAM(pb + 11);
        }
        if (EN_NORM && IN(pb + 12)) { FRESH(); norm_phase(F, F.in[IN_GQF] + l * DM, F.in[IN_GPM] + (l + 1 < DEPTH ? l + 1 : 0) * DM, l == DEPTH - 1); SEAM(pb + 12); }
    }
#undef IN
#undef SEAM
}

extern "C" void kernel_launch(void* const* d_in, const int* in_sizes, int n_in, void* d_out, int out_size, void* d_ws, size_t ws_size, hipStream_t stream) {
    static int grid = 0;
    if (grid == 0) {
        if (n_in != 29 || (size_t)out_size != O_END || ws_size < WS_END) { fprintf(stderr, "kernel_launch: unexpected shapes (n_in %d out %d ws %zu need %zu)\n", n_in, out_size, ws_size, (size_t)WS_END); grid = -1; return; }
        int dev = 0, cus = 0, per_cu = 0;
        if (hipGetDevice(&dev) != hipSuccess || hipDeviceGetAttribute(&cus, hipDeviceAttributeMultiprocessorCount, dev) != hipSuccess) { grid = -1; return; }
        if (hipFuncSetAttribute((const void*)mk_fwd, hipFuncAttributeMaxDynamicSharedMemorySize, LDS_BYTES) != hipSuccess) { fprintf(stderr, "kernel_launch: hipFuncSetAttribute failed\n"); grid = -1; return; }
        if (hipOccupancyMaxActiveBlocksPerMultiprocessor(&per_cu, (const void*)mk_fwd, NTHR, LDS_BYTES) != hipSuccess || per_cu < 1) fprintf(stderr, "kernel_launch: occupancy query says %d\n", per_cu);
        (void)hipGetLastError();
        if (cus < GRID) { fprintf(stderr, "kernel_launch: %d CUs; this kernel needs %d (one resident workgroup per CU)\n", cus, GRID); grid = -1; return; }
        grid = GRID;
    }
    if (grid < 0) return;
    if (hipMemsetAsync((char*)d_ws + WS_CTL, 0, CTL_ZERO_BYTES, stream) != hipSuccess) return;
    Args a{};
    for (int i = 0; i < 29; ++i) a.in[i] = (const float*)d_in[i];
    a.out = (float*)d_out; a.ws = (unsigned char*)d_ws;
#if MK_PER_PHASE
    for (int p = 0; p < N_PHASES; ++p) { a.ph_lo = p; a.ph_hi = p + 1; hipLaunchKernelGGL(mk_fwd, dim3(grid), dim3(NTHR), LDS_BYTES, stream, a); }
#else
    a.ph_lo = 0; a.ph_hi = N_PHASES; hipLaunchKernelGGL(mk_fwd, dim3(grid), dim3(NTHR), LDS_BYTES, stream, a);
#endif
}
```

```cpp
#include <hip/hip_runtime.h>
#include <cstdio>
#include <cstdint>
#include <cmath>
namespace pg8 {
#define PG8_LAS __attribute__((address_space(3)))
typedef unsigned short bf16_t;
typedef short bf16x8 __attribute__((ext_vector_type(8)));
typedef float f32x4 __attribute__((ext_vector_type(4)));
typedef unsigned u32x4 __attribute__((ext_vector_type(4)));
constexpr int BM = 256, BK = 64, HALF = 128, HTB = HALF * BK * 2  , STAGE_BYTES = 8 * HTB, NXCD = 8, WGM = 8;

__host__ __device__ __forceinline__ int lds_byte(int r, int c) { const int st = (r >> 4) * 2 + (c >> 5), rr = r & 15, cc = c & 31, ob = rr * 64 + cc * 2; return st * 1024 + (ob ^ (((ob >> 9) & 1) << 5)); }
__host__ __device__ __forceinline__ void stage_rc(int b, int& R, int& C) { const int st = b / 1024, sb = b % 1024, swz = sb ^ (((sb >> 9) & 1) << 5); R = (st >> 1) * 16 + swz / 64; C = (st & 1) * 32 + (swz % 64) / 2; }
__host__ __device__ __forceinline__ int perm32(int rho) { const int n = rho >> 4, i = rho & 15; return 8 * (i >> 2) + 4 * n + (i & 3); }

struct Unit { int pm, pn; };
struct Gemm { const bf16_t* A; const bf16_t* Bt; int M, N, K; };

struct StaticOrder {
    int nM, nN, nwg, G, c;
    __host__ __device__ void init(int M, int N, int G_, int c_) { nM = M / BM; nN = N / BM; nwg = nM * nN; G = G_; c = c_; }
    __host__ __device__ bool next(int i, Unit& u) const {
        const long L = (long)i * G + c; if (L >= nwg) return false;
        int wgid = (int)L; { const int q = nwg / NXCD, r = nwg % NXCD, xcd = wgid % NXCD, off = wgid / NXCD; wgid = (xcd < r ? xcd * (q + 1) : r * (q + 1) + (xcd - r) * q) + off; }
        const int nig = WGM * nN, gid = wgid / nig, fm = gid * WGM, gsz = (nM - fm) < WGM ? (nM - fm) : WGM;
        u.pm = fm + ((wgid % nig) % gsz); u.pn = (wgid % nig) / gsz; return true;
    }
    __device__ __forceinline__ void a_ready(const Unit&) const {}
    __device__ __forceinline__ void done(const Unit&) const {}
};

__device__ __forceinline__ unsigned cvt_pk_bf16(float lo, float hi) { unsigned r; asm volatile("v_cvt_pk_bf16_f32 %0, %1, %2" : "=v"(r) : "v"(lo), "v"(hi)); return r; }
typedef float f32x2 __attribute__((ext_vector_type(2)));
template <class Epi, class Sched, bool ALIGN_EPI = false, bool SP2 = false>
__device__ __forceinline__ void gemm_phase(PG8_LAS unsigned char* lds, const Gemm g, const Sched& S, const Epi& E, int wave_) {
    int tid_ = (int)__builtin_amdgcn_mbcnt_hi(~0u, __builtin_amdgcn_mbcnt_lo(~0u, 0u)) + 64 * wave_; asm volatile("" : "+v"(tid_));
    const int tid = tid_, wid = __builtin_amdgcn_readfirstlane(tid >> 6), lane = tid & 63, wr = wid >> 2, wc = wid & 3, fr = lane & 15, fq = lane >> 4;
    const int K = g.K, nt = K / BK;
    unsigned voffA[2], voffB[2];
#pragma unroll
    for (int i = 0; i < 2; ++i) { int R, C; stage_rc(tid * 16 + i * 8192, R, C); const int Rb = Epi::PERM ? ((R & ~31) + perm32(R & 31)) : R;
        voffA[i] = (unsigned)(R * K + C) * 2u; voffB[i] = (unsigned)(Rb * K + C) * 2u; }
    const size_t kstep = (size_t)(BK * 2);
    const size_t hstep = (size_t)HALF * K * 2;
    const size_t tstep = 2 * hstep;
    const unsigned ldsw = (unsigned)wid * 1024u;
    const int aoff = lds_byte(wr * 64 + fr, fq * 8), boff = lds_byte(wc * 32 + fr, fq * 8);
#define PG8_SA(b, h) (((b) * 2 + (h)) * HTB)
#define PG8_SB(b, h) ((4 + (b) * 2 + (h)) * HTB)
#define PG8_STAGE(bufoff, gbase, voff) do { _Pragma("unroll") for (int _i = 0; _i < 2; ++_i) \
        __builtin_amdgcn_global_load_lds((const unsigned*)((const char*)(gbase) + (voff)[_i]), (PG8_LAS unsigned*)(lds + (bufoff) + ldsw + _i * 8192), 16, 0, 0); } while (0)
#define PG8_LDA(dst, b, h) do { _Pragma("unroll") for (int m = 0; m < 4; ++m) _Pragma("unroll") for (int k = 0; k < 2; ++k) dst[m][k] = *(const PG8_LAS bf16x8*)(lds + PG8_SA(b, h) + aoff + m * 2048 + k * 1024); } while (0)
#define PG8_LDB(dst, b, h) do { _Pragma("unroll") for (int n = 0; n < 2; ++n) _Pragma("unroll") for (int k = 0; k < 2; ++k) dst[n][k] = *(const PG8_LAS bf16x8*)(lds + PG8_SB(b, h) + boff + n * 2048 + k * 1024); } while (0)
#define PG8_MMA(ai, bj, At, Bt) do { __builtin_amdgcn_s_setprio(1); _Pragma("unroll") for (int m = 0; m < 4; ++m) _Pragma("unroll") for (int n = 0; n < 2; ++n) _Pragma("unroll") for (int k = 0; k < 2; ++k) \
        acc[ai][bj][m][n] = __builtin_amdgcn_mfma_f32_16x16x32_bf16(Bt[n][k], At[m][k], acc[ai][bj][m][n], 0, 0, 0); __builtin_amdgcn_s_setprio(0); } while (0)
#define PG8_WAIT_V(n) asm volatile("s_waitcnt vmcnt(" #n ")" ::: "memory")
#define PG8_WAIT_L(n) asm volatile("s_waitcnt lgkmcnt(" #n ")" ::: "memory")
#define PG8_BAR __builtin_amdgcn_s_barrier()
#define PG8_SCHED __builtin_amdgcn_sched_barrier(0)
    Unit cur, nxt; int ui = 0;
    if (!S.next(0, cur)) return;
    f32x4 acc[2][2][4][2];
#pragma unroll
    for (int a = 0; a < 2; ++a)
#pragma unroll
        for (int b = 0; b < 2; ++b)
#pragma unroll
            for (int m = 0; m < 4; ++m)
#pragma unroll
                for (int n = 0; n < 2; ++n) acc[a][b][m][n] = (f32x4){0.f, 0.f, 0.f, 0.f};
    bf16x8 At[4][2], B0[2][2], B1[2][2];
    const char* cA = (const char*)g.A + (size_t)cur.pm * tstep; const char* cB = (const char*)g.Bt + (size_t)cur.pn * tstep;
    S.a_ready(cur);
    if constexpr (SP2) {
        PG8_STAGE(PG8_SB(0, 0), cB, voffB); PG8_STAGE(PG8_SB(0, 1), cB + hstep, voffB); PG8_STAGE(PG8_SA(0, 0), cA, voffA); PG8_STAGE(PG8_SA(0, 1), cA + hstep, voffA);
        if (wr == 1) PG8_BAR;
        PG8_WAIT_V(2); PG8_BAR;
        PG8_STAGE(PG8_SB(1, 0), cB + kstep, voffB); PG8_STAGE(PG8_SA(1, 0), cA + kstep, voffA); PG8_STAGE(PG8_SB(1, 1), cB + hstep + kstep, voffB);
        PG8_WAIT_V(6); PG8_BAR;
    } else {
        PG8_STAGE(PG8_SB(0, 0), cB, voffB); PG8_STAGE(PG8_SA(0, 0), cA, voffA); PG8_STAGE(PG8_SB(0, 1), cB + hstep, voffB); PG8_STAGE(PG8_SA(0, 1), cA + hstep, voffA);
        if (wr == 1) PG8_BAR;
        PG8_WAIT_V(4); PG8_BAR;
        PG8_STAGE(PG8_SB(1, 0), cB + kstep, voffB); PG8_STAGE(PG8_SA(1, 0), cA + kstep, voffA); PG8_STAGE(PG8_SB(1, 1), cB + hstep + kstep, voffB);
        PG8_WAIT_V(6); PG8_BAR;
    }
    for (;;) {
        const bool has_next = S.next(ui + 1, nxt);
        const char* nA = has_next ? (const char*)g.A + (size_t)nxt.pm * tstep : cA; const char* nB = has_next ? (const char*)g.Bt + (size_t)nxt.pn * tstep : cB;
        for (int t = 0; t < nt; t += 2) {
            const bool last = (t == nt - 2);
            const char* a1 = cA + (size_t)(t + 1) * kstep;
            const char* a2 = last ? nA : cA + (size_t)(t + 2) * kstep; const char* b2 = last ? nB : cB + (size_t)(t + 2) * kstep;
            const char* a3 = a2 + kstep; const char* b3 = b2 + kstep;
            if (last && has_next) S.a_ready(nxt);
            if constexpr (SP2) {
            PG8_LDB(B0, 0, 0); PG8_LDB(B1, 0, 1); PG8_SCHED; PG8_LDA(At, 0, 0); PG8_STAGE(PG8_SA(1, 1), a1 + hstep, voffA);
            PG8_WAIT_V(8); PG8_WAIT_L(0); PG8_BAR; PG8_MMA(0, 0, At, B0); PG8_MMA(0, 1, At, B1); PG8_BAR; PG8_SCHED;
            PG8_LDA(At, 0, 1); PG8_STAGE(PG8_SB(0, 0), b2, voffB); PG8_STAGE(PG8_SB(0, 1), b2 + hstep, voffB); PG8_STAGE(PG8_SA(0, 0), a2, voffA);
            PG8_WAIT_V(8); PG8_WAIT_L(0); PG8_BAR; PG8_MMA(1, 0, At, B0); PG8_MMA(1, 1, At, B1); PG8_BAR; PG8_SCHED;
            PG8_LDB(B0, 1, 0); PG8_LDB(B1, 1, 1); PG8_SCHED; PG8_LDA(At, 1, 0); PG8_STAGE(PG8_SA(0, 1), a2 + hstep, voffA);
            PG8_WAIT_V(8); PG8_WAIT_L(0); PG8_BAR; PG8_MMA(0, 0, At, B0); PG8_MMA(0, 1, At, B1); PG8_BAR; PG8_SCHED;
            PG8_LDA(At, 1, 1); PG8_STAGE(PG8_SB(1, 0), b3, voffB); PG8_STAGE(PG8_SB(1, 1), b3 + hstep, voffB); PG8_STAGE(PG8_SA(1, 0), a3, voffA);
            PG8_WAIT_V(8); PG8_WAIT_L(0); PG8_BAR; PG8_MMA(1, 0, At, B0); PG8_MMA(1, 1, At, B1); PG8_BAR; PG8_SCHED;
            } else {
            PG8_LDB(B0, 0, 0); PG8_SCHED; PG8_LDA(At, 0, 0); PG8_STAGE(PG8_SA(1, 1), a1 + hstep, voffA);
            PG8_WAIT_L(8); PG8_BAR; PG8_WAIT_L(0); PG8_MMA(0, 0, At, B0); PG8_BAR; PG8_SCHED;
            PG8_LDB(B1, 0, 1); PG8_STAGE(PG8_SB(0, 0), b2, voffB);
            PG8_BAR; PG8_WAIT_L(0); PG8_MMA(0, 1, At, B1); PG8_BAR;
            PG8_LDA(At, 0, 1); PG8_STAGE(PG8_SA(0, 0), a2, voffA);
            PG8_BAR; PG8_WAIT_L(0); PG8_MMA(1, 0, At, B0); PG8_BAR; PG8_SCHED;
            PG8_STAGE(PG8_SB(0, 1), b2 + hstep, voffB);
            PG8_WAIT_V(6); PG8_BAR; PG8_MMA(1, 1, At, B1); PG8_BAR;
            PG8_LDB(B0, 1, 0); PG8_SCHED; PG8_LDA(At, 1, 0); PG8_STAGE(PG8_SA(0, 1), a2 + hstep, voffA);
            PG8_WAIT_L(8); PG8_BAR; PG8_WAIT_L(0); PG8_MMA(0, 0, At, B0); PG8_BAR; PG8_SCHED;
            PG8_LDB(B1, 1, 1); PG8_STAGE(PG8_SB(1, 0), b3, voffB);
            PG8_BAR; PG8_WAIT_L(0); PG8_MMA(0, 1, At, B1); PG8_BAR;
            PG8_LDA(At, 1, 1); PG8_STAGE(PG8_SA(1, 0), a3, voffA);
            PG8_BAR; PG8_WAIT_L(0); PG8_MMA(1, 0, At, B0); PG8_BAR; PG8_SCHED;
            PG8_STAGE(PG8_SB(1, 1), b3 + hstep, voffB);
            PG8_WAIT_V(6); PG8_BAR; PG8_MMA(1, 1, At, B1); PG8_BAR;
            }
        }
        if constexpr (ALIGN_EPI) { if (wr == 0) PG8_BAR; }
        if constexpr (!Epi::AFTER_DRAIN) { E(acc, cur, wr, wc, fr, fq); S.done(cur); }
        if (!has_next) break;
#pragma unroll
        for (int a = 0; a < 2; ++a)
#pragma unroll
            for (int b = 0; b < 2; ++b)
#pragma unroll
                for (int m = 0; m < 4; ++m)
#pragma unroll
                    for (int n = 0; n < 2; ++n) acc[a][b][m][n] = (f32x4){0.f, 0.f, 0.f, 0.f};
        cur = nxt; cA = nA; cB = nB; ++ui;
        if constexpr (ALIGN_EPI) { if (wr == 1) PG8_BAR; }
    }
    PG8_WAIT_V(0);
    if constexpr (!ALIGN_EPI) { if (wr == 0) PG8_BAR; }
    PG8_BAR;
    if constexpr (Epi::AFTER_DRAIN) { E.fused(acc, cur, wr, wc, fr, fq, lds, wid, lane); S.done(cur); }
#undef PG8_SA
#undef PG8_SB
#undef PG8_STAGE
#undef PG8_LDA
#undef PG8_LDB
#undef PG8_MMA
#undef PG8_WAIT_V
#undef PG8_WAIT_L
#undef PG8_BAR
#undef PG8_SCHED
}
}

#define GAS __attribute__((address_space(1)))
#define LAS __attribute__((address_space(3)))
typedef unsigned short bf16;
typedef unsigned v4u __attribute__((ext_vector_type(4)));
typedef unsigned v2u __attribute__((ext_vector_type(2)));
typedef float f32x4 __attribute__((ext_vector_type(4)));
typedef float f32x2 __attribute__((ext_vector_type(2)));
typedef short bf16x8 __attribute__((ext_vector_type(8)));
typedef float f32x16 __attribute__((ext_vector_type(16)));
#define RLX_AGENT __ATOMIC_RELAXED, __HIP_MEMORY_SCOPE_AGENT
#define LDS_WAIT() asm volatile("s_waitcnt lgkmcnt(0)" ::: "memory")
#define VM_WAIT() asm volatile("s_waitcnt vmcnt(0)" ::: "memory")

constexpr int NWAVES = 8, NTHR = 512, GRID = 256;
constexpr int DM = 1024, NB = 8, SEQ = 2048, DEPTH = 4, DB = 128;
constexpr int MP = NB * SEQ;
constexpr int MS = DB;
constexpr int MR = MP + MS;
constexpr int MT = 16640;
constexpr int PIN = 2816, DFF = 2816, UPW = 5632;
constexpr int C_K = 512, C_V = 640, C_QR = 768, C_FR = 1280, C_IR = 1792, C_GR = 2304;
constexpr int NMEM = 256, XH = 4, XHD = 256;
constexpr int WIN = 128, PAST = 8192;
constexpr float EPS = 1e-6f;

constexpr size_t O_YP = 0;
constexpr size_t O_YS = O_YP + (size_t)MP * DM;
constexpr size_t O_WKP = O_YS + (size_t)MS * DM;
constexpr size_t O_WVP = O_WKP + (size_t)DEPTH * NB * 128 * 128;
constexpr size_t O_WKS = O_WVP + (size_t)DEPTH * NB * 128 * 128;
constexpr size_t O_WVS = O_WKS + (size_t)DEPTH * DB * 128;
constexpr size_t O_MKP = O_WVS + (size_t)DEPTH * DB * 128;
constexpr size_t O_MVP = O_MKP + (size_t)DEPTH * NB * NMEM * DM;
constexpr size_t O_HP = O_MVP + (size_t)DEPTH * NB * NMEM * DM;
constexpr size_t O_HS = O_HP + (size_t)DEPTH * NB * 4 * 128 * 128;
constexpr size_t O_CP = O_HS + (size_t)DEPTH * DB * 4 * 128 * 128;
constexpr size_t O_CS = O_CP + (size_t)DEPTH * NB * 2 * UPW;
constexpr size_t O_END = O_CS + (size_t)DEPTH * DB * 2 * UPW;

constexpr size_t MiB = 1u << 20;
constexpr size_t WS_CTL = 0, CTL_ZERO_BYTES = 1 * MiB;
constexpr size_t WS_TAB = 1 * MiB;
constexpr size_t TAB_COS = 0, TAB_SIN = 2049 * 32 * 4, TAB_LB = 2 * 2049 * 32 * 4;
constexpr size_t WS_WIN = 2 * MiB;
constexpr size_t WS_WO = WS_WIN + (size_t)DEPTH * PIN * DM * 2;
constexpr size_t WS_WXQ = WS_WO + (size_t)DEPTH * DM * DM * 2;
constexpr size_t WS_WXKV = WS_WXQ + (size_t)DEPTH * DM * DM * 2;
constexpr size_t WS_WXO = WS_WXKV + (size_t)DEPTH * 2 * DM * DM * 2;
constexpr size_t WS_WUP = WS_WXO + (size_t)DEPTH * DM * DM * 2;
constexpr size_t WS_WDN = WS_WUP + (size_t)DEPTH * UPW * DM * 2;
constexpr size_t WS_X = WS_WDN + (size_t)DEPTH * DM * DFF * 2;
constexpr size_t WS_XN = WS_X + (size_t)MT * DM * 4;
constexpr size_t WS_PROJ = WS_XN + (size_t)MT * DM * 2;
constexpr size_t WS_LF = WS_PROJ + (size_t)MT * PIN * 2;
constexpr size_t WS_MIX = WS_LF + (size_t)MT * 512 * 4;
constexpr size_t WS_Y = WS_MIX + (size_t)MT * DM * 2;
constexpr size_t WS_QX = WS_Y + (size_t)MT * DM * 4;
constexpr size_t WS_OX = WS_QX + (size_t)MT * DM * 2;
constexpr size_t WS_U = WS_OX + (size_t)MT * DM * 2;
constexpr size_t WS_G = WS_U + (size_t)MT * UPW * 2;
constexpr size_t WS_MEMN = WS_G + (size_t)MT * DFF * 2;
constexpr size_t WS_MK = WS_MEMN + (size_t)DEPTH * 2048 * DM * 2;
constexpr size_t WS_MVT = WS_MK + (size_t)DEPTH * 2048 * DM * 2;
constexpr size_t WS_HQ = WS_MVT + (size_t)DEPTH * 2048 * DM * 2;
constexpr size_t WS_HK = WS_HQ + (size_t)NB * 4 * 128 * SEQ * 2;
constexpr size_t WS_HV = WS_HK + (size_t)NB * 4 * 128 * SEQ * 2;
constexpr size_t WS_HLF = WS_HV + (size_t)NB * 4 * 128 * SEQ * 2;
constexpr size_t WS_HQB = WS_HLF + (size_t)NB * 4 * 128 * SEQ * 4;
constexpr size_t WS_HOP = WS_HQB + (size_t)MP * 512 * 2;
constexpr size_t WS_HSL = WS_HOP + (size_t)MP * 512 * 4;
constexpr size_t WS_HDE = WS_HSL + (size_t)256 * 128 * 128 * 4;
constexpr size_t WS_RS = WS_HDE + (size_t)256 * 128 * 4;
constexpr size_t WS_END = WS_RS + (size_t)MT * 4;
static_assert(WS_HK - WS_HQ == (size_t)NB * 4 * 128 * SEQ * 2 && WS_HV - WS_HK == WS_HK - WS_HQ, "HQ | HK | HV consecutive");

constexpr int CW_TMO = 0, CW_CODE = 1;
constexpr int CW_BAR = 4096;

constexpr int RING_OFF = 0, RING_BYTES = 131072;
constexpr int LDSCTL_OFF = RING_BYTES, MISC_OFF = LDSCTL_OFF + 320;
constexpr int LDS_BYTES = 147456;

__device__ __forceinline__ unsigned f2bf(float f) { unsigned u = __builtin_bit_cast(unsigned, f); return (u + 0x7fffu + ((u >> 16) & 1u)) >> 16; }
__device__ __forceinline__ unsigned pk2(float lo, float hi) { return f2bf(lo) | (f2bf(hi) << 16); }
__device__ __forceinline__ float bf2f(unsigned short b) { return __builtin_bit_cast(float, (unsigned)b << 16); }
__device__ __forceinline__ float bflo(unsigned w) { return __builtin_bit_cast(float, w << 16); }
__device__ __forceinline__ float bfhi(unsigned w) { return __builtin_bit_cast(float, w & 0xffff0000u); }
__device__ __forceinline__ float sigmoidf_(float z) { return 1.0f / (1.0f + __expf(-z)); }
__device__ __forceinline__ float siluf_(float z) { return z * __builtin_amdgcn_rcpf(1.0f + __expf(-z)); }
typedef __bf16 bf16x2_t __attribute__((ext_vector_type(2)));
__device__ __forceinline__ unsigned cvtpk(float lo, float hi) { f32x2 v = {lo, hi}; bf16x2_t b = __builtin_convertvector(v, bf16x2_t); return __builtin_bit_cast(unsigned, b); }
#define MFMA32(a, b, c) __builtin_amdgcn_mfma_f32_32x32x16_bf16((a), (b), (c), 0, 0, 0)
#define LDS_BAR() do { asm volatile("s_waitcnt lgkmcnt(0)" ::: "memory"); __builtin_amdgcn_s_barrier(); asm volatile("" ::: "memory"); } while (0)
__device__ __forceinline__ float wave_sum(float v) {
#pragma unroll
    for (int o = 1; o < 64; o <<= 1) v += __shfl_xor(v, o);
    return v;
}
__device__ __forceinline__ float wave_max(float v) {
#pragma unroll
    for (int o = 1; o < 64; o <<= 1) v = fmaxf(v, __shfl_xor(v, o));
    return v;
}

namespace pg8 {
struct EpiF32 {
    static constexpr bool PERM = false, AFTER_DRAIN = false;
    float* O; int ldc;
    __device__ __forceinline__ void operator()(const f32x4 (&acc)[2][2][4][2], const Unit& u, int wr, int wc, int fr, int fq) const {
        const int row0 = u.pm * BM + wr * 64 + fr, col0 = u.pn * BM + wc * 32 + 4 * fq;
#pragma unroll
        for (int ai = 0; ai < 2; ++ai)
#pragma unroll
            for (int m = 0; m < 4; ++m) { float* rowp = O + (size_t)(row0 + ai * HALF + m * 16) * ldc + col0;
#pragma unroll
                for (int bj = 0; bj < 2; ++bj)
#pragma unroll
                    for (int n = 0; n < 2; ++n) *(f32x4*)(rowp + bj * HALF + n * 16) = acc[ai][bj][m][n]; }
    }
};
struct EpiB16 {
    static constexpr bool PERM = true, AFTER_DRAIN = false;
    bf16_t* O; int ldc; float sc; const float* rs;
    __device__ __forceinline__ void operator()(const f32x4 (&acc)[2][2][4][2], const Unit& u, int wr, int wc, int fr, int fq) const {
        const int row0 = u.pm * BM + wr * 64 + fr, col0 = u.pn * BM + wc * 32 + 8 * fq;
#pragma unroll
        for (int ai = 0; ai < 2; ++ai)
#pragma unroll
            for (int m = 0; m < 4; ++m) { const int row = row0 + ai * HALF + m * 16; bf16_t* rowp = O + (size_t)row * ldc + col0; const float s = rs ? sc * rs[row] : sc;
#pragma unroll
                for (int bj = 0; bj < 2; ++bj) { const f32x4 v0 = acc[ai][bj][m][0] * s, v1 = acc[ai][bj][m][1] * s;
                    u32x4 w; w.x = cvt_pk_bf16(v0[0], v0[1]); w.y = cvt_pk_bf16(v0[2], v0[3]); w.z = cvt_pk_bf16(v1[0], v1[1]); w.w = cvt_pk_bf16(v1[2], v1[3]);
                    *(u32x4*)(rowp + bj * HALF) = w; } }
    }
};
struct EpiProj {
    static constexpr bool PERM = true, AFTER_DRAIN = false;
    bf16_t* P; float* LF; const float* lb;
    bf16_t* HQ; bf16_t* HK; bf16_t* HV; float* HLF;
    __device__ __forceinline__ void operator()(const f32x4 (&acc)[2][2][4][2], const Unit& u, int wr, int wc, int fr, int fq) const {
        const int row0 = u.pm * BM + wr * 64 + fr, col0 = u.pn * BM + wc * 32 + 8 * fq;
        const int pn = u.pn;
        const int mode = (pn == 3 || pn == 4 || pn == 9 || pn == 10) ? 1 : ((pn == 5 || pn == 6) ? 2 : 0);
        if (pn >= 3 && pn <= 8 && u.pm < 64) {
            const int grp = (pn - 3) >> 1;
            bf16_t* T16 = HQ + (size_t)grp * ((size_t)NB * 4 * 128 * SEQ);
#pragma unroll
            for (int bj = 0; bj < 2; ++bj) { const int hd = ((pn - 3) & 1) * 2 + bj, k0 = wc * 32 + 8 * fq; const int c = hd * 128 + k0;
                f32x4 l0 = {0.f, 0.f, 0.f, 0.f}, l1 = l0; if (grp == 1) { l0 = *(const f32x4*)(lb + c); l1 = *(const f32x4*)(lb + c + 4); }
#pragma unroll
                for (int ai = 0; ai < 2; ++ai)
#pragma unroll
                    for (int m = 0; m < 4; ++m) { const int row = row0 + ai * HALF + m * 16; const int b_ = row >> 11, t_ = row & 2047;
                        const unsigned base = ((((unsigned)(b_ * 4 + hd) * 32u + (unsigned)(t_ >> 6)) * 4u + (unsigned)((t_ >> 4) & 3)) * 128u + (unsigned)k0) * 16u + (unsigned)(t_ & 15);
#pragma unroll
                        for (int n = 0; n < 2; ++n)
#pragma unroll
                            for (int e = 0; e < 4; ++e) { float z = acc[ai][bj][m][n][e]; const unsigned a = base + (unsigned)(4 * n + e) * 16u;
                                if (grp == 0) { z = z * __builtin_amdgcn_rcpf(1.f + __expf(-z)); T16[a] = (bf16_t)(cvt_pk_bf16(z, 0.f) & 0xffffu); }
                                else if (grp == 2) { T16[a] = (bf16_t)(cvt_pk_bf16(z, 0.f) & 0xffffu); }
                                else { z = fminf(fmaxf(z, -40.f), 40.f); const float lbv = n ? l1[e] : l0[e]; const float ez = __expf(-z);
                                    const float rz = __builtin_amdgcn_rcpf(1.f + ez); const float f = lbv + (1.f - lbv) * rz, kk = (1.f - lbv) * ez * rz;
                                    HLF[a] = __log2f(f); T16[a] = (bf16_t)(cvt_pk_bf16(kk, 0.f) & 0xffffu); } } } }
        } else if (mode == 2) {
#pragma unroll
            for (int bj = 0; bj < 2; ++bj) { const int c = col0 + bj * HALF - 1280;
                const f32x4 l0 = *(const f32x4*)(lb + c), l1 = *(const f32x4*)(lb + c + 4);
#pragma unroll
                for (int ai = 0; ai < 2; ++ai)
#pragma unroll
                    for (int m = 0; m < 4; ++m) { const size_t row = (size_t)(row0 + ai * HALF + m * 16);
                        f32x4 z0 = acc[ai][bj][m][0], z1 = acc[ai][bj][m][1]; f32x4 f0, f1, k0, k1;
#pragma unroll
                        for (int e = 0; e < 4; ++e) { z0[e] = fminf(fmaxf(z0[e], -40.f), 40.f); z1[e] = fminf(fmaxf(z1[e], -40.f), 40.f); }
#pragma unroll
                        for (int e = 0; e < 4; ++e) { const float ez0 = __expf(-z0[e]), ez1 = __expf(-z1[e]);
                            const float r0_ = __builtin_amdgcn_rcpf(1.f + ez0), r1_ = __builtin_amdgcn_rcpf(1.f + ez1);
                            f0[e] = l0[e] + (1.f - l0[e]) * r0_; k0[e] = (1.f - l0[e]) * ez0 * r0_;
                            f1[e] = l1[e] + (1.f - l1[e]) * r1_; k1[e] = (1.f - l1[e]) * ez1 * r1_; }
#pragma unroll
                        for (int e = 0; e < 4; ++e) { f0[e] = __log2f(f0[e]); f1[e] = __log2f(f1[e]); }
                        *(f32x4*)(LF + row * 512 + c) = f0; *(f32x4*)(LF + row * 512 + c + 4) = f1;
                        u32x4 w; w.x = cvt_pk_bf16(k0[0], k0[1]); w.y = cvt_pk_bf16(k0[2], k0[3]); w.z = cvt_pk_bf16(k1[0], k1[1]); w.w = cvt_pk_bf16(k1[2], k1[3]);
                        *(u32x4*)(P + row * PIN + col0 + bj * HALF) = w; } }
        } else {
#pragma unroll
            for (int ai = 0; ai < 2; ++ai)
#pragma unroll
                for (int m = 0; m < 4; ++m) { bf16_t* rowp = P + (size_t)(row0 + ai * HALF + m * 16) * PIN + col0;
#pragma unroll
                    for (int bj = 0; bj < 2; ++bj) { f32x4 v0 = acc[ai][bj][m][0], v1 = acc[ai][bj][m][1];
                        if (mode == 1) {
#pragma unroll
                            for (int e = 0; e < 4; ++e) { v0[e] = v0[e] * __builtin_amdgcn_rcpf(1.f + __expf(-v0[e])); v1[e] = v1[e] * __builtin_amdgcn_rcpf(1.f + __expf(-v1[e])); } }
                        u32x4 w; w.x = cvt_pk_bf16(v0[0], v0[1]); w.y = cvt_pk_bf16(v0[2], v0[3]); w.z = cvt_pk_bf16(v1[0], v1[1]); w.w = cvt_pk_bf16(v1[2], v1[3]);
                        *(u32x4*)(rowp + bj * HALF) = w; } }
        }
    }
};
struct EpiMemKV {
    static constexpr bool PERM = false, AFTER_DRAIN = false;
    float* OK; float* OV; bf16_t* MK; bf16_t* MVT;
    __device__ __forceinline__ void operator()(const f32x4 (&acc)[2][2][4][2], const Unit& u, int wr, int wc, int fr, int fq) const {
        const int layer = u.pm >> 3, pml = u.pm & 7, pnl = u.pn & 7;
        const int row0 = pml * BM + wr * 64 + fr; const int col0 = (pnl & 3) * BM + wc * 32 + 4 * fq;
        if (pnl < 4) {
            float* O = OK + (size_t)layer * 2048 * 1024; bf16_t* B = MK + (size_t)layer * 2048 * 1024;
#pragma unroll
            for (int ai = 0; ai < 2; ++ai)
#pragma unroll
                for (int m = 0; m < 4; ++m) { const size_t off = (size_t)(row0 + ai * HALF + m * 16) * 1024 + col0;
#pragma unroll
                    for (int bj = 0; bj < 2; ++bj)
#pragma unroll
                        for (int n = 0; n < 2; ++n) { const f32x4 v = acc[ai][bj][m][n]; *(f32x4*)(O + off + bj * HALF + n * 16) = v;
                            v2u w; w.x = cvt_pk_bf16(v[0], v[1]); w.y = cvt_pk_bf16(v[2], v[3]); *(v2u*)(B + off + bj * HALF + n * 16) = w; } }
        } else {
            float* O = OV + (size_t)layer * 2048 * 1024; bf16_t* T = MVT + (size_t)layer * 2048 * 1024;
#pragma unroll
            for (int ai = 0; ai < 2; ++ai)
#pragma unroll
                for (int m = 0; m < 4; ++m) { const int row = row0 + ai * HALF + m * 16; const size_t off = (size_t)row * 1024 + col0; const int b_ = row >> 8, mm = row & 255;
#pragma unroll
                    for (int bj = 0; bj < 2; ++bj)
#pragma unroll
                        for (int n = 0; n < 2; ++n) { const f32x4 v = acc[ai][bj][m][n]; *(f32x4*)(O + off + bj * HALF + n * 16) = v;
                            const int c = col0 + bj * HALF + n * 16; const int hd = c >> 8, d = c & 255;
                            bf16_t* tp = T + ((size_t)(b_ * 4 + hd) * 256 + d) * 256 + mm;
                            const unsigned w0 = cvt_pk_bf16(v[0], v[1]), w1 = cvt_pk_bf16(v[2], v[3]);
                            tp[0] = (bf16_t)(w0 & 0xffffu); tp[256] = (bf16_t)(w0 >> 16); tp[512] = (bf16_t)(w1 & 0xffffu); tp[768] = (bf16_t)(w1 >> 16); } }
        }
    }
};
struct BlockDiagOrder {
    int G, c;
    __device__ __forceinline__ bool next(int i, Unit& u) const { const int L = i * G + c; if (L >= 256) return false; const int layer = L >> 6, r = L & 63; u.pm = layer * 8 + (r & 7); u.pn = layer * 8 + (r >> 3); return true; }
    __device__ __forceinline__ void a_ready(const Unit&) const {}
    __device__ __forceinline__ void done(const Unit&) const {}
};
}
#define XB_TMO      128
#define XB_XCNT(j)  (256  + 64 * (j))
#define XB_XSUB(j)  (1280 + 64 * (j))
#define XB_XGEN(j)  (2304 + 64 * (j))
#define XB_TOP      3328
#define XB_TOPGEN   3392
#define XCD_BAR_WORDS 3456
#define XB_SPIN_CAP (1u << 18)

__device__ __forceinline__ unsigned xb_ld(unsigned* p)              { return __hip_atomic_load(p, __ATOMIC_RELAXED, __HIP_MEMORY_SCOPE_AGENT); }
__device__ __forceinline__ unsigned xb_add(unsigned* p, unsigned v) { return __hip_atomic_fetch_add(p, v, __ATOMIC_RELAXED, __HIP_MEMORY_SCOPE_AGENT); }
__device__ __forceinline__ unsigned xb_xcc_id() { return (unsigned)__builtin_amdgcn_s_getreg((3 << 11) | 20) & 0xFu; }
#define XB_SPIN(cond, bar) do { unsigned _sp = 0; while (cond) { __builtin_amdgcn_s_sleep(1); \
    if ((++_sp & 255u) == 0u) { if (xb_ld(&(bar)[XB_TMO])) break; if (_sp > XB_SPIN_CAP) { atomicAdd(&(bar)[XB_TMO], 1u); break; } } } } while (0)

struct XcdBarrier {
    unsigned* bar; unsigned x;
    volatile LAS unsigned* st;
};

__device__ __forceinline__ XcdBarrier xcd_barrier_post(unsigned* bar, volatile LAS unsigned* st) {
    XcdBarrier b; b.bar = bar; b.x = xb_xcc_id(); b.st = st;
    if (threadIdx.x == 0) (void)xb_add(&bar[XB_XCNT(b.x)], 1u);
    return b;
}
__device__ __forceinline__ void xcd_barrier_complete(unsigned* bar, unsigned x, unsigned& nloc, unsigned& nx) {
    const unsigned G = gridDim.x * gridDim.y * gridDim.z;
    unsigned sum, cnt, mine, sp = 0u;
    for (;;) {
        sum = 0u; cnt = 0u; mine = 0u;
#pragma unroll
        for (unsigned j = 0; j < 16; ++j) { const unsigned c = xb_ld(&bar[XB_XCNT(j)]); sum += c; cnt += (c > 0u) ? 1u : 0u; mine = (j == x) ? c : mine; }
        if (sum == G) break;
        __builtin_amdgcn_s_sleep(1);
        if ((++sp & 255u) == 0u) { if (xb_ld(&bar[XB_TMO])) break; if (sp > XB_SPIN_CAP) { atomicAdd(&bar[XB_TMO], 1u); break; } }
    }
    nloc = mine > 0u ? mine : 1u; nx = cnt > 0u ? cnt : 1u;
}

__device__ __forceinline__ void xcd_barrier(const XcdBarrier& b) {
    asm volatile("s_waitcnt vmcnt(0)" ::: "memory");
    __syncthreads();
    if (threadIdx.x == 0) {
        unsigned* bar = b.bar;
        __builtin_amdgcn_s_waitcnt(0);
        unsigned nloc = b.st[0], nx = b.st[1];
        if (nloc == 0u) { xcd_barrier_complete(bar, b.x, nloc, nx); b.st[0] = nloc; b.st[1] = nx; }
        const unsigned old = xb_add(&bar[XB_XSUB(b.x)], 1u);
        const unsigned gen = old / nloc;
        if (old + 1u == (gen + 1u) * nloc) {
            __builtin_amdgcn_fence(__ATOMIC_RELEASE, "agent");
            asm volatile("s_waitcnt vmcnt(0)" ::: "memory");
            const unsigned og = xb_add(&bar[XB_TOP], 1u);
            const unsigned tg = og / nx;
            if (og + 1u == (tg + 1u) * nx) xb_add(&bar[XB_TOPGEN], 1u);
            else XB_SPIN(xb_ld(&bar[XB_TOPGEN]) == tg, bar);
            __builtin_amdgcn_fence(__ATOMIC_ACQUIRE, "agent");
            xb_add(&bar[XB_XGEN(b.x)], 1u);
            asm volatile("s_waitcnt vmcnt(0)" ::: "memory");
        } else {
            XB_SPIN(xb_ld(&bar[XB_XGEN(b.x)]) == gen, bar);
            __builtin_amdgcn_fence(__ATOMIC_ACQUIRE, "agent");
            asm volatile("s_waitcnt vmcnt(0)" ::: "memory");
        }
    }
    __syncthreads();
}

struct Frame {
    LAS unsigned char* lds;
    volatile LAS unsigned* MISC;
    unsigned* ctl;
    int tid, lane, wave, G, gw, ngw, vcu;
    const float* const* in; float* out; unsigned char* ws;
};
#define IN_XP 0
#define IN_XS 1
#define IN_CWK 2
#define IN_CWV 3
#define IN_CMK 4
#define IN_CMV 5
#define IN_SH 6
#define IN_CFC 7
#define IN_MEM 8
#define IN_WIN 9
#define IN_WO 10
#define IN_SINK 11
#define IN_LBL 12
#define IN_HN 13
#define IN_WXQ 14
#define IN_WXK 15
#define IN_WXV 16
#define IN_WXO 17
#define IN_WUP 18
#define IN_CW 19
#define IN_CB 20
#define IN_WDN 21
#define IN_GPM 22
#define IN_GQM 23
#define IN_GPX 24
#define IN_GQX 25
#define IN_GMEM 26
#define IN_GPF 27
#define IN_GQF 28

__device__ __forceinline__ void p0_transpose_item(const float* W, int K, int N, bf16* WT, int row_off, LAS float* scr, int item, int lane, const float* gk = nullptr, bf16* WTT = nullptr) {
    const int nblk = N / 32, kb = item / nblk, nb = item % nblk, k0 = 64 * kb, n0 = 32 * nb;
#pragma unroll 8
    for (int i = 0; i < 32; ++i) { const int kk = 2 * i + (lane >> 5); scr[kk * 33 + (lane & 31)] = W[(size_t)(k0 + kk) * N + n0 + (lane & 31)]; }
    LDS_WAIT(); asm volatile("" ::: "memory");
    const int c = lane & 7;
    float g8[8];
    if (gk) { const f32x4 a_ = *(const f32x4*)(gk + k0 + 8 * c), b_ = *(const f32x4*)(gk + k0 + 8 * c + 4); g8[0] = a_.x; g8[1] = a_.y; g8[2] = a_.z; g8[3] = a_.w; g8[4] = b_.x; g8[5] = b_.y; g8[6] = b_.z; g8[7] = b_.w; } else {
#pragma unroll
        for (int e = 0; e < 8; ++e) g8[e] = 1.f; }
#pragma unroll
    for (int j = 0; j < 4; ++j) { const int n = (lane >> 3) + 8 * j; const LAS float* s = scr + (8 * c) * 33 + n;
        v4u o; o.x = cvtpk(s[0 * 33] * g8[0], s[1 * 33] * g8[1]); o.y = cvtpk(s[2 * 33] * g8[2], s[3 * 33] * g8[3]); o.z = cvtpk(s[4 * 33] * g8[4], s[5 * 33] * g8[5]); o.w = cvtpk(s[6 * 33] * g8[6], s[7 * 33] * g8[7]);
        *(GAS v4u*)(WT + (size_t)(row_off + n0 + n) * K + k0 + 8 * c) = o;
        if (WTT) { const int nn = n0 + n, kk_ = k0 + 8 * c; *(GAS v4u*)(WTT + ((size_t)((nn >> 4) * (K >> 5) + (kk_ >> 5)) * 64 + ((kk_ & 31) >> 3) * 16 + (nn & 15)) * 8) = o; } }
    LDS_WAIT(); asm volatile("" ::: "memory");
}
__device__ __forceinline__ void row_load(const float* p, int lane, f32x4 (&v)[4]) {
    const GAS f32x4* r = (const GAS f32x4*)p + lane;
#pragma unroll
    for (int j = 0; j < 4; ++j) v[j] = r[64 * j];
}
__device__ __forceinline__ float row_ss(const f32x4 (&v)[4]) {
    float s = 0.f;
#pragma unroll
    for (int j = 0; j < 4; ++j) s += (v[j].x * v[j].x + v[j].y * v[j].y) + (v[j].z * v[j].z + v[j].w * v[j].w);
    return wave_sum(s);
}
__device__ __forceinline__ void row_store_bf16(bf16* p, int lane, const f32x4 (&v)[4]) {
    GAS unsigned long long* o8 = (GAS unsigned long long*)p + lane;
#pragma unroll
    for (int j = 0; j < 4; ++j) o8[64 * j] = (unsigned long long)pk2(v[j].x, v[j].y) | ((unsigned long long)pk2(v[j].z, v[j].w) << 32);
}
__device__ __forceinline__ void row_store_f32(float* p, int lane, const f32x4 (&v)[4]) {
    GAS f32x4* r = (GAS f32x4*)p + lane;
#pragma unroll
    for (int j = 0; j < 4; ++j) r[64 * j] = v[j];
}

__device__ __forceinline__ void p0_prologue(Frame& F) {
    LAS float* scr = (LAS float*)(F.lds + RING_OFF + F.wave * 16384);
    unsigned char* ws = F.ws;
    constexpr int I_IN = 16 * (PIN / 32), I_SQ = 16 * (DM / 32), I_UP = 16 * (UPW / 32), I_DN = (DFF / 64) * (DM / 32);
    constexpr int I_LAYER = I_IN + 5 * I_SQ + I_UP + I_DN;
    for (int it = F.gw; it < DEPTH * I_LAYER; it += F.ngw) {
        const int l = it / I_LAYER; int r = it % I_LAYER;
        if (r < I_IN) { p0_transpose_item(F.in[IN_WIN] + (size_t)l * DM * PIN, DM, PIN, (bf16*)(ws + WS_WIN) + (size_t)l * PIN * DM, 0, scr, r, F.lane); continue; } r -= I_IN;
        if (r < I_SQ) { p0_transpose_item(F.in[IN_WO] + (size_t)l * DM * DM, DM, DM, (bf16*)(ws + WS_WO) + (size_t)l * DM * DM, 0, scr, r, F.lane); continue; } r -= I_SQ;
        if (r < I_SQ) { p0_transpose_item(F.in[IN_WXQ] + (size_t)l * DM * DM, DM, DM, (bf16*)(ws + WS_WXQ) + (size_t)l * DM * DM, 0, scr, r, F.lane, F.in[IN_GPX] + l * DM); continue; } r -= I_SQ;
        if (r < I_SQ) { p0_transpose_item(F.in[IN_WXK] + (size_t)l * DM * DM, DM, DM, (bf16*)(ws + WS_WXKV) + (size_t)l * 2 * DM * DM, 0, scr, r, F.lane); continue; } r -= I_SQ;
        if (r < I_SQ) { p0_transpose_item(F.in[IN_WXV] + (size_t)l * DM * DM, DM, DM, (bf16*)(ws + WS_WXKV) + (size_t)l * 2 * DM * DM, DM, scr, r, F.lane); continue; } r -= I_SQ;
        if (r < I_SQ) { p0_transpose_item(F.in[IN_WXO] + (size_t)l * DM * DM, DM, DM, (bf16*)(ws + WS_WXO) + (size_t)l * DM * DM, 0, scr, r, F.lane); continue; } r -= I_SQ;
        if (r < I_UP) { p0_transpose_item(F.in[IN_WUP] + (size_t)l * DM * UPW, DM, UPW, (bf16*)(ws + WS_WUP) + (size_t)l * UPW * DM, 0, scr, r, F.lane, F.in[IN_GPF] + l * DM); continue; } r -= I_UP;
        p0_transpose_item(F.in[IN_WDN] + (size_t)l * DFF * DM, DFF, DM, (bf16*)(ws + WS_WDN) + (size_t)l * DM * DFF, 0, scr, r, F.lane);
    }
    {
        f32x4 g[4]; row_load(F.in[IN_GPM], F.lane, g);
        for (int m = F.gw; m < MR; m += F.ngw) {
            const float* src = (m < MP) ? F.in[IN_XP] + (size_t)m * DM : F.in[IN_XS] + (size_t)(m - MP) * DM;
            f32x4 v[4]; row_load(src, F.lane, v);
            row_store_bf16((bf16*)(ws + WS_X) + (size_t)m * DM, F.lane, v);
            const float r = rsqrtf(row_ss(v) * (1.f / DM) + EPS);
#pragma unroll
            for (int j = 0; j < 4; ++j) v[j] = v[j] * r * g[j];
            row_store_bf16((bf16*)(ws + WS_XN) + (size_t)m * DM, F.lane, v);
        }
    }
    for (int m = F.gw; m < NB * NMEM; m += F.ngw) {
        f32x4 v[4]; row_load(F.in[IN_MEM] + (size_t)m * DM, F.lane, v);
        const float r = rsqrtf(row_ss(v) * (1.f / DM) + EPS);
        for (int l = 0; l < DEPTH; ++l) { f32x4 g[4], o[4]; row_load(F.in[IN_GMEM] + (size_t)l * DM, F.lane, g);
#pragma unroll
            for (int j = 0; j < 4; ++j) o[j] = v[j] * r * g[j];
            row_store_bf16((bf16*)(ws + WS_MEMN) + ((size_t)l * 2048 + m) * DM, F.lane, o); }
    }
    {
        float* cs = (float*)(ws + WS_TAB + TAB_COS); float* sn = (float*)(ws + WS_TAB + TAB_SIN); float* lbt = (float*)(ws + WS_TAB + TAB_LB);
        const int gt = blockIdx.x * NTHR + F.tid; constexpr int nt = GRID * NTHR;
        for (int i = gt; i < 2049 * 32; i += nt) { const int p = i >> 5, d = i & 31; const double pos = (p == 2048) ? (double)PAST : (double)p;
            const double inv = pow(10000.0, -(double)d / 32.0); const double a = pos * inv; cs[i] = (float)cos(a); sn[i] = (float)sin(a); }
        for (int c = gt; c < 512; c += nt) { float z[DEPTH], mx = -1e30f;
            for (int l = 0; l < DEPTH; ++l) { z[l] = F.in[IN_LBL][l * 512 + c]; mx = fmaxf(mx, z[l]); }
            float s = 0.f; for (int l = 0; l < DEPTH; ++l) { z[l] = expf(z[l] - mx); s += z[l]; }
            float cum = 0.f, c0 = 0.f; for (int l = 0; l < DEPTH; ++l) { cum += z[l] / s; if (l == 0) c0 = cum; lbt[l * 512 + c] = cum - c0; } }
    }
}

__device__ __forceinline__ void row_load_bf16(const bf16* p, int lane, f32x4 (&v)[4]) {
    const GAS v2u* r = (const GAS v2u*)p + lane;
#pragma unroll
    for (int j = 0; j < 4; ++j) { const v2u w = r[64 * j]; v[j] = (f32x4){bflo(w.x), bfhi(w.x), bflo(w.y), bfhi(w.y)}; }
}
__device__ __forceinline__ void norm_row(Frame& F, int m, f32x4 (&y)[4], f32x4 (&x)[4], const f32x4 (&gq)[4], const f32x4 (&gp)[4], bool final_, bool xn_) {
    unsigned char* ws = F.ws;
    const float r = rsqrtf(row_ss(y) * (1.f / DM) + EPS);
#pragma unroll
    for (int j = 0; j < 4; ++j) x[j] = x[j] + y[j] * r * gq[j];
    if (final_) { float* o = (m < MP) ? F.out + O_YP + (size_t)m * DM : F.out + O_YS + (size_t)(m - MP) * DM; row_store_f32(o, F.lane, x); }
    else {
        row_store_bf16((bf16*)(ws + WS_X) + (size_t)m * DM, F.lane, x);
        const float r2 = rsqrtf(row_ss(x) * (1.f / DM) + EPS);
        if (xn_) {
#pragma unroll
            for (int j = 0; j < 4; ++j) x[j] = x[j] * r2 * gp[j];
            row_store_bf16((bf16*)(ws + WS_XN) + (size_t)m * DM, F.lane, x);
        } else if (F.lane == 0) ((float*)(ws + WS_RS))[m] = r2;
    }
}
__device__ __forceinline__ void norm_phase(Frame& F, const float* gpost, const float* gpre, bool final_) {
    unsigned char* ws = F.ws;
    f32x4 gq[4], gp[4]; row_load(gpost, F.lane, gq); row_load(gpre ? gpre : gpost, F.lane, gp);
    const bool xn_ = gpre != nullptr;
    const bf16* Y = (const bf16*)(ws + WS_Y); const bf16* X = (const bf16*)(ws + WS_X);
    const int rbeg = F.vcu * 65, rend = (rbeg + 65 < MR) ? rbeg + 65 : MR;
    for (int m = rbeg + F.wave; m < rend; m += 16) {
        const int m2 = m + 8; const bool two = m2 < rend;
        f32x4 y0[4], x0[4], y1[4], x1[4];
        row_load_bf16(Y + (size_t)m * DM, F.lane, y0); row_load_bf16(X + (size_t)m * DM, F.lane, x0);
        if (two) { row_load_bf16(Y + (size_t)m2 * DM, F.lane, y1); row_load_bf16(X + (size_t)m2 * DM, F.lane, x1); }
        norm_row(F, m, y0, x0, gq, gp, final_, xn_);
        if (two) norm_row(F, m2, y1, x1, gq, gp, final_, xn_);
    }
}

__device__ __forceinline__ void unpack8(const v4u w, float (&f)[8]) {
    f[0] = bflo(w.x); f[1] = bfhi(w.x); f[2] = bflo(w.y); f[3] = bfhi(w.y); f[4] = bflo(w.z); f[5] = bfhi(w.z); f[6] = bflo(w.w); f[7] = bfhi(w.w);
}
__device__ __forceinline__ void load8f(const float* p, float (&f)[8]) { const f32x4 a = *(const f32x4*)p, b = *(const f32x4*)(p + 4); f[0] = a.x; f[1] = a.y; f[2] = a.z; f[3] = a.w; f[4] = b.x; f[5] = b.y; f[6] = b.z; f[7] = b.w; }

__device__ __forceinline__ void conv_phase(Frame& F, int l) {
    unsigned char* ws = F.ws;
    const bf16* U = (const bf16*)(ws + WS_U); bf16* Gb = (bf16*)(ws + WS_G);
    const float* cw = F.in[IN_CW] + (size_t)l * 3 * UPW; const float* cb = F.in[IN_CB] + (size_t)l * UPW;
    const float* cfc = F.in[IN_CFC] + (size_t)l * DB * 2 * UPW;
    const int gt = blockIdx.x * NTHR + F.tid; constexpr int nthr = GRID * NTHR;
    constexpr int NCG = DFF / 8;
    constexpr int RG = 8;
    constexpr int N_P = (MP / RG) * NCG, N_S = MS * NCG;
    constexpr int PER_BLK = (MP / RG / GRID) * NCG;
    for (int j = F.tid; j < PER_BLK + (N_S + GRID - 1) / GRID; j += NTHR) {
        const bool samp = j >= PER_BLK;
        int rg, cg;
        if (!samp) { rg = F.vcu * (MP / RG / GRID) + j / NCG; cg = j % NCG; }
        else { const int is_ = (j - PER_BLK) * GRID + (int)blockIdx.x; if (is_ >= N_S) continue; rg = is_ / NCG; cg = is_ % NCG; }
        const int c0 = cg * 8;
        float wa[3][8], wb[3][8], ba[8], bb[8];
#pragma unroll
        for (int j = 0; j < 3; ++j) { load8f(cw + j * UPW + c0, wa[j]); load8f(cw + j * UPW + DFF + c0, wb[j]); }
        load8f(cb + c0, ba); load8f(cb + DFF + c0, bb);
        if (samp) {
            const int m0 = MP + rg; const float* c = cfc + (size_t)rg * 2 * UPW;
            float a2[8], a1[8], b2[8], b1[8], a0[8], b0[8];
            load8f(c + c0, a2); load8f(c + DFF + c0, b2); load8f(c + UPW + c0, a1); load8f(c + UPW + DFF + c0, b1);
            unpack8(*(const v4u*)(U + (size_t)m0 * UPW + c0), a0); unpack8(*(const v4u*)(U + (size_t)m0 * UPW + DFF + c0), b0);
            float o[8];
#pragma unroll
            for (int e = 0; e < 8; ++e) { const float a = ba[e] + wa[0][e] * a2[e] + wa[1][e] * a1[e] + wa[2][e] * a0[e]; const float b = bb[e] + wb[0][e] * b2[e] + wb[1][e] * b1[e] + wb[2][e] * b0[e]; o[e] = siluf_(a) * b; }
            *(v4u*)(Gb + (size_t)m0 * DFF + c0) = (v4u){cvtpk(o[0], o[1]), cvtpk(o[2], o[3]), cvtpk(o[4], o[5]), cvtpk(o[6], o[7])};
        } else {
            const int m0 = rg * RG; const bool first = (m0 % SEQ) == 0;
            v4u ra[RG + 2], rb[RG + 2];
#pragma unroll
            for (int r = 0; r < RG + 2; ++r) { const int mm = (first && r < 2) ? m0 : m0 + r - 2;
                ra[r] = *(const v4u*)(U + (size_t)mm * UPW + c0); rb[r] = *(const v4u*)(U + (size_t)mm * UPW + DFF + c0); }
            if (first) { ra[0] = (v4u){0u, 0u, 0u, 0u}; ra[1] = ra[0]; rb[0] = ra[0]; rb[1] = ra[0]; }
            float a2[8], a1[8], b2[8], b1[8];
            unpack8(ra[0], a2); unpack8(ra[1], a1); unpack8(rb[0], b2); unpack8(rb[1], b1);
#pragma unroll
            for (int r = 0; r < RG; ++r) {
                float a0[8], b0[8], o[8]; unpack8(ra[r + 2], a0); unpack8(rb[r + 2], b0);
#pragma unroll
                for (int e = 0; e < 8; ++e) { const float a = ba[e] + wa[0][e] * a2[e] + wa[1][e] * a1[e] + wa[2][e] * a0[e]; const float b = bb[e] + wb[0][e] * b2[e] + wb[1][e] * b1[e] + wb[2][e] * b0[e];
                    o[e] = siluf_(a) * b; a2[e] = a1[e]; a1[e] = a0[e]; b2[e] = b1[e]; b1[e] = b0[e]; }
                *(v4u*)(Gb + (size_t)(m0 + r) * DFF + c0) = (v4u){cvtpk(o[0], o[1]), cvtpk(o[2], o[3]), cvtpk(o[4], o[5]), cvtpk(o[6], o[7])};
            }
        }
    }
    float* ocp = F.out + O_CP + (size_t)l * NB * 2 * UPW; float* ocs = F.out + O_CS + (size_t)l * DB * 2 * UPW;
    for (int i = gt; i < NB * 2 * UPW; i += nthr) { const int b = i / (2 * UPW), j = (i / UPW) % 2, c = i % UPW; ocp[i] = bf2f(U[(size_t)(b * SEQ + SEQ - 2 + j) * UPW + c]); }
    for (int i = gt; i < DB * 2 * UPW; i += nthr) { const int s = i / (2 * UPW), j = (i / UPW) % 2, c = i % UPW;
        ocs[i] = (j == 0) ? cfc[(size_t)s * 2 * UPW + UPW + c] : bf2f(U[(size_t)(MP + s) * UPW + c]); }
}

__device__ __forceinline__ void xattn_unit_sample(Frame& F, int l, int s, int h) {
    unsigned char* ws = F.ws; const bf16* QX = (const bf16*)(ws + WS_QX); bf16* OX = (bf16*)(ws + WS_OX);
    const int lane = F.lane, wave = F.wave, m = MP + s;
    LAS float* scl = (LAS float*)(F.lds + RING_OFF); LAS float* part = scl + 256;
    const v2u qw = *(const v2u*)(QX + (size_t)m * DM + h * 256 + 4 * lane);
    const f32x4 q = {bflo(qw.x), bfhi(qw.x), bflo(qw.y), bfhi(qw.y)};
    const GAS f32x4* CK = (const GAS f32x4*)(F.in[IN_CMK] + ((size_t)(l * DB + s) * 256 + 32 * wave) * DM + h * 256) + lane;
    const GAS f32x4* CV = (const GAS f32x4*)(F.in[IN_CMV] + ((size_t)(l * DB + s) * 256 + 32 * wave) * DM + h * 256) + lane;
    LDS_BAR();
    {
        f32x4 k[32];
#pragma unroll
        for (int i = 0; i < 32; ++i) k[i] = CK[(size_t)i * (DM / 4)];
#pragma unroll
        for (int i = 0; i < 32; ++i) { const float d = wave_sum((k[i].x * q.x + k[i].y * q.y) + (k[i].z * q.z + k[i].w * q.w)); if (lane == 0) scl[32 * wave + i] = d; }
    }
    f32x4 v[32];
#pragma unroll
    for (int i = 0; i < 32; ++i) v[i] = CV[(size_t)i * (DM / 4)];
    LDS_BAR();
    float mx, inv;
    { const float s0 = scl[lane], s1 = scl[64 + lane], s2 = scl[128 + lane], s3 = scl[192 + lane];
      mx = wave_max(fmaxf(fmaxf(s0, s1), fmaxf(s2, s3)));
      inv = 1.f / wave_sum((exp2f(s0 - mx) + exp2f(s1 - mx)) + (exp2f(s2 - mx) + exp2f(s3 - mx))); }
    f32x4 o = {0.f, 0.f, 0.f, 0.f};
#pragma unroll
    for (int i = 0; i < 32; ++i) { const float p = exp2f(scl[32 * wave + i] - mx); o = o + v[i] * p; }
    *(LAS f32x4*)(part + wave * 256 + 4 * lane) = o;
    LDS_BAR();
    if (F.tid < 256) { float t = 0.f;
#pragma unroll
        for (int w = 0; w < 8; ++w) t += part[w * 256 + F.tid];
        OX[(size_t)m * DM + h * 256 + F.tid] = (bf16)(cvtpk(t * inv, 0.f) & 0xffffu); }
}

__device__ __forceinline__ void hgrn_unit_sample(Frame& F, int l, int s) {
    unsigned char* ws = F.ws; const bf16* P = (const bf16*)(ws + WS_PROJ); bf16* MIX = (bf16*)(ws + WS_MIX); const float* LFp = (const float*)(ws + WS_LF);
    const int lane = F.lane, wave = F.wave, m = MP + s, hd = wave >> 1, kh = wave & 1, vq = lane & 31, kp = lane >> 5;
    LAS float* wl = (LAS float*)(F.lds + RING_OFF + 102400 + wave * 2048);
    LAS f32x4* red = (LAS f32x4*)(F.lds + RING_OFF + 98304);
    LDS_BAR();
    { const int k = 64 * kh + lane; wl[lane] = exp2f(LFp[(size_t)m * 512 + hd * 128 + k]); wl[64 + lane] = bf2f(P[(size_t)m * PIN + C_FR + hd * 128 + k]); wl[128 + lane] = bf2f(P[(size_t)m * PIN + C_QR + hd * 128 + k]); }
    LDS_WAIT(); asm volatile("" ::: "memory");
    const v2u vw = *(const v2u*)(P + (size_t)m * PIN + C_IR + hd * 128 + 4 * vq);
    const f32x4 vv = {bflo(vw.x), bfhi(vw.x), bflo(vw.y), bfhi(vw.y)};
    const size_t sb = (((size_t)(l * DB + s) * 4 + hd) * 128 + 64 * kh) * 128 + 4 * vq;
    const GAS float* S0 = (const GAS float*)F.in[IN_SH] + sb; GAS float* S1 = (GAS float*)F.out + O_HS + sb;
    f32x4 o = {0.f, 0.f, 0.f, 0.f};
#pragma unroll 1
    for (int g = 0; g < 4; ++g) {
        f32x4 s0[8];
#pragma unroll
        for (int i = 0; i < 8; ++i) s0[i] = *(const GAS f32x4*)(S0 + (size_t)(16 * g + 2 * i + kp) * 128);
#pragma unroll
        for (int i = 0; i < 8; ++i) { const int kr = 16 * g + 2 * i + kp; const float f = wl[kr], kk = wl[64 + kr], q = wl[128 + kr];
            const f32x4 s1 = s0[i] * f + vv * kk; *(GAS f32x4*)(S1 + (size_t)kr * 128) = s1; o = o + s1 * q; }
    }
    o.x += __shfl_xor(o.x, 32); o.y += __shfl_xor(o.y, 32); o.z += __shfl_xor(o.z, 32); o.w += __shfl_xor(o.w, 32);
    if (lane < 32) red[wave * 32 + vq] = o;
    LDS_BAR();
    o = red[(2 * hd) * 32 + vq] + red[(2 * hd + 1) * 32 + vq];
    float ss = (o.x * o.x + o.y * o.y) + (o.z * o.z + o.w * o.w);
    ss += __shfl_xor(ss, 1); ss += __shfl_xor(ss, 2); ss += __shfl_xor(ss, 4); ss += __shfl_xor(ss, 8); ss += __shfl_xor(ss, 16);
    const float r = rsqrtf(ss * (1.f / 128.f) + EPS);
    if (kh == 0 && lane < 32) { const f32x4 g4 = *(const f32x4*)(F.in[IN_HN] + l * 512 + hd * 128 + 4 * vq); const v2u gw = *(const v2u*)(P + (size_t)m * PIN + C_GR + hd * 128 + 4 * vq);
        v2u w; w.x = cvtpk(o.x * r * g4.x * bflo(gw.x), o.y * r * g4.y * bfhi(gw.x)); w.y = cvtpk(o.z * r * g4.z * bflo(gw.y), o.w * r * g4.w * bfhi(gw.y));
        *(v2u*)(MIX + (size_t)m * DM + 512 + hd * 128 + 4 * vq) = w; }
}
__device__ __forceinline__ void swa_unit_sample(Frame& F, int l, int s) {
    unsigned char* ws = F.ws; const bf16* P = (const bf16*)(ws + WS_PROJ); bf16* MIX = (bf16*)(ws + WS_MIX);
    const float* cs = (const float*)(ws + WS_TAB + TAB_COS) + 2048 * 32; const float* sn = (const float*)(ws + WS_TAB + TAB_SIN) + 2048 * 32;
    constexpr int RS = 136;
    LAS unsigned char* KL = F.lds + RING_OFF; LAS unsigned char* VL = KL + 128 * RS * 2;
    const int lane = F.lane, h = F.wave, m = MP + s, kvh = h >> 2;
    LAS float* wl = (LAS float*)(F.lds + RING_OFF + 102400 + h * 2048);
    const GAS float* ck = (const GAS float*)F.in[IN_CWK] + (size_t)(l * DB + s) * 128 * 128; const GAS float* cv = (const GAS float*)F.in[IN_CWV] + (size_t)(l * DB + s) * 128 * 128;
    LDS_BAR();
    { f32x4 kx[8], vx[8];
#pragma unroll
      for (int i = 0; i < 8; ++i) { const int ch = F.tid + 512 * i; kx[i] = *(const GAS f32x4*)(ck + (size_t)(ch >> 5) * 128 + 4 * (ch & 31)); vx[i] = *(const GAS f32x4*)(cv + (size_t)(ch >> 5) * 128 + 4 * (ch & 31)); }
#pragma unroll
      for (int i = 0; i < 8; ++i) { const int ch = F.tid + 512 * i; const int off = ((ch >> 5) * RS + 4 * (ch & 31)) * 2;
          *(LAS v2u*)(KL + off) = (v2u){cvtpk(kx[i].x, kx[i].y), cvtpk(kx[i].z, kx[i].w)}; *(LAS v2u*)(VL + off) = (v2u){cvtpk(vx[i].x, vx[i].y), cvtpk(vx[i].z, vx[i].w)}; } }
    float knew = 0.f;
    { const int d = lane & 31; const float c = cs[d], sv = sn[d];
      const float q1 = bf2f(P[(size_t)m * PIN + h * 64 + d]), q2 = bf2f(P[(size_t)m * PIN + h * 64 + 32 + d]);
      const float k1 = bf2f(P[(size_t)m * PIN + C_K + kvh * 64 + d]), k2 = bf2f(P[(size_t)m * PIN + C_K + kvh * 64 + 32 + d]);
      if (lane < 32) { wl[lane] = (q1 * c - q2 * sv) * 0.125f; knew = k1 * c - k2 * sv; } else { wl[lane] = (q2 * c + q1 * sv) * 0.125f; knew = k2 * c + k1 * sv; } }
    const float vnew = bf2f(P[(size_t)m * PIN + C_V + kvh * 64 + lane]);
    if ((h & 3) == 0) { F.out[O_WKS + ((size_t)(l * DB + s) * 2 + kvh) * 64 + lane] = knew; F.out[O_WVS + ((size_t)(l * DB + s) * 2 + kvh) * 64 + lane] = vnew; }
    LDS_BAR();
    const float snew = wave_sum(wl[lane] * knew);
    float sc[2];
#pragma unroll
    for (int i = 0; i < 2; ++i) { const LAS unsigned char* kr = KL + ((lane + 64 * i) * RS + kvh * 64) * 2; float acc = 0.f;
#pragma unroll
        for (int c8 = 0; c8 < 8; ++c8) { float kf[8]; unpack8(*(const LAS v4u*)(kr + 16 * c8), kf);
#pragma unroll
            for (int e = 0; e < 8; ++e) acc += wl[c8 * 8 + e] * kf[e]; }
        sc[i] = acc; }
    const float sink = F.in[IN_SINK][l * 8 + h];
    const float mx = fmaxf(fmaxf(wave_max(fmaxf(sc[0], sc[1])), snew), sink);
    const float p0 = __expf(sc[0] - mx), p1 = __expf(sc[1] - mx), pn = __expf(snew - mx);
    const float den = wave_sum(p0 + p1) + pn + __expf(sink - mx);
    wl[64 + lane] = p0; wl[128 + lane] = p1;
    LDS_WAIT(); asm volatile("" ::: "memory");
    float o = pn * vnew;
    const LAS bf16* vp = (const LAS bf16*)VL + kvh * 64 + lane;
#pragma unroll 8
    for (int j = 0; j < 128; ++j) o += wl[64 + j] * bf2f(vp[j * RS]);
    MIX[(size_t)m * DM + h * 64 + lane] = (bf16)(cvtpk(o / den, 0.f) & 0xffffu);
}

__device__ __forceinline__ void hgrn_pass1(Frame& F, int l, int b, int h, int seg) {
    unsigned char* ws = F.ws; bf16* QB = (bf16*)(ws + WS_HQB); float* OP = (float*)(ws + WS_HOP);
    constexpr int RSK = 136, RST = 72;
    constexpr int O_QT = 0, O_KT = O_QT + 64 * RSK * 2, O_KTT = O_KT + 64 * RSK * 2, O_VT = O_KTT + 128 * RST * 2, O_SP = O_VT + 128 * RST * 2,
                  O_SEG = O_SP + 128 * RSK * 2, O_EB = O_SEG + 2048, O_EBR = O_EB + 512, O_SSQ = O_EBR + 512, O_ENDL = O_SSQ + 1024;
    static_assert(O_ENDL <= RING_BYTES, "hgrn LDS map");
    LAS unsigned char* L = F.lds + RING_OFF;
    LAS bf16* QT = (LAS bf16*)(L + O_QT); LAS bf16* KT = (LAS bf16*)(L + O_KT);
    LAS float* SEG = (LAS float*)(L + O_SEG); LAS float* EB = (LAS float*)(L + O_EB); LAS float* EBR = (LAS float*)(L + O_EBR);
    const int tid = F.tid, lane = F.lane, wave = F.wave;
    const int vt = wave >> 1, tt = wave & 1;
    int k = tid & 127, sg = tid >> 7, l32 = lane & 31, hh = lane >> 5;
    f32x16 S0, S1;
#pragma unroll
    for (int r = 0; r < 16; ++r) { S0[r] = 0.f; S1[r] = 0.f; }
    float Bseg = 0.f;
    const size_t hb = ((size_t)(b * 4 + h) * 32 * 4 + sg) * 128 * 16 + (size_t)k * 16;
    const bf16* HQp = (const bf16*)(ws + WS_HQ) + hb; const bf16* HKp = (const bf16*)(ws + WS_HK) + hb; const bf16* HVp = (const bf16*)(ws + WS_HV) + hb; const float* HLp = (const float*)(ws + WS_HLF) + hb;
    v4u n_q0, n_q1, n_k0, n_k1, n_v0, n_v1; f32x4 n_l[4];
#define HG_LOAD_L(cn) do { const int o_ = 8192 * (cn); _Pragma("unroll") for (int j_ = 0; j_ < 4; ++j_) n_l[j_] = *(const f32x4*)(HLp + o_ + 4 * j_); } while (0)
#define HG_LOAD_QKV(cn) do { const int o_ = 8192 * (cn); n_q0 = *(const v4u*)(HQp + o_); n_q1 = *(const v4u*)(HQp + o_ + 8); n_k0 = *(const v4u*)(HKp + o_); n_k1 = *(const v4u*)(HKp + o_ + 8); \
        n_v0 = *(const v4u*)(HVp + o_); n_v1 = *(const v4u*)(HVp + o_ + 8); } while (0)
    HG_LOAD_L(4 * seg); HG_LOAD_QKV(4 * seg);
    LDS_BAR();
    for (int c = 4 * seg; c < 4 * seg + 4; ++c) {
        const int mb = b * SEQ + c * 64;
        asm volatile("" : "+v"(k), "+v"(sg), "+v"(l32), "+v"(hh));
        float cl[16], q[16], kk[16];
        { float run = 0.f;
#pragma unroll
          for (int j = 0; j < 4; ++j) { run += n_l[j].x; cl[4 * j] = run; run += n_l[j].y; cl[4 * j + 1] = run; run += n_l[j].z; cl[4 * j + 2] = run; run += n_l[j].w; cl[4 * j + 3] = run; }
          SEG[sg * 128 + k] = run; }
#define HG_UNP(dst, o, V_) do { const v4u u_ = (V_); dst[o] = bflo(u_.x); dst[o + 1] = bfhi(u_.x); dst[o + 2] = bflo(u_.y); dst[o + 3] = bfhi(u_.y); dst[o + 4] = bflo(u_.z); dst[o + 5] = bfhi(u_.z); dst[o + 6] = bflo(u_.w); dst[o + 7] = bfhi(u_.w); } while (0)
        HG_UNP(q, 0, n_q0); HG_UNP(q, 8, n_q1); HG_UNP(kk, 0, n_k0); HG_UNP(kk, 8, n_k1);
#undef HG_UNP
        const v4u vv0 = n_v0, vv1 = n_v1;
        if (c + 1 < 4 * seg + 4) { HG_LOAD_L(c + 1); HG_LOAD_QKV(c + 1); }
        LDS_BAR();
#pragma unroll
        for (int kti = 0; kti < 2; ++kti) { const int kt = 2 * tt + kti;
#pragma unroll
            for (int g = 0; g < 4; ++g) { const int k0 = 32 * kt + 8 * g + 4 * hh;
                const f32x4 r0 = *(const LAS f32x4*)(SEG + k0), r1 = *(const LAS f32x4*)(SEG + 128 + k0);
                const float s0 = kti ? S1[4 * g] : S0[4 * g], s1 = kti ? S1[4 * g + 1] : S0[4 * g + 1], s2 = kti ? S1[4 * g + 2] : S0[4 * g + 2], s3 = kti ? S1[4 * g + 3] : S0[4 * g + 3];
                v2u w; w.x = cvtpk(s0 * __builtin_amdgcn_exp2f(r0.x + r1.x), s1 * __builtin_amdgcn_exp2f(r0.y + r1.y));
                w.y = cvtpk(s2 * __builtin_amdgcn_exp2f(r0.z + r1.z), s3 * __builtin_amdgcn_exp2f(r0.w + r1.w));
                *(LAS v2u*)(L + O_SP + ((32 * vt + l32) * RSK + k0) * 2) = w; } }
        {
            const float t0 = SEG[k], t1 = SEG[128 + k], t2 = SEG[256 + k], t3 = SEG[384 + k];
            const float pre = (sg > 0 ? t0 : 0.f) + (sg > 1 ? t1 : 0.f) + (sg > 2 ? t2 : 0.f);
            const float ref = t0 + t1, blast = ref + t2 + t3;
            unsigned kp[8];
#pragma unroll
            for (int i = 0; i < 16; i += 2) {
                const float b0 = pre + cl[i], b1 = pre + cl[i + 1];
                const float qt0 = q[i] * __builtin_amdgcn_exp2f(b0 - ref), qt1 = q[i + 1] * __builtin_amdgcn_exp2f(b1 - ref);
                const float kt0 = kk[i] * __builtin_amdgcn_exp2f(ref - b0), kt1 = kk[i + 1] * __builtin_amdgcn_exp2f(ref - b1);
                const unsigned wq = cvtpk(qt0, qt1), wk = cvtpk(kt0, kt1), wb = cvtpk(q[i] * __builtin_amdgcn_exp2f(Bseg + b0), q[i + 1] * __builtin_amdgcn_exp2f(Bseg + b1));
                const int t = 16 * sg + i;
                QB[(size_t)(mb + t) * 512 + h * 128 + k] = (bf16)(wb & 0xffffu); QB[(size_t)(mb + t + 1) * 512 + h * 128 + k] = (bf16)(wb >> 16);
                QT[t * RSK + k] = (bf16)(wq & 0xffffu); QT[(t + 1) * RSK + k] = (bf16)(wq >> 16);
                KT[t * RSK + k] = (bf16)(wk & 0xffffu); KT[(t + 1) * RSK + k] = (bf16)(wk >> 16);
                kp[i >> 1] = wk;
            }
            *(LAS v4u*)(L + O_KTT + (k * RST + 16 * sg) * 2) = (v4u){kp[0], kp[1], kp[2], kp[3]};
            *(LAS v4u*)(L + O_KTT + (k * RST + 16 * sg + 8) * 2) = (v4u){kp[4], kp[5], kp[6], kp[7]};
            *(LAS v4u*)(L + O_VT + (k * RST + 16 * sg) * 2) = vv0;
            *(LAS v4u*)(L + O_VT + (k * RST + 16 * sg + 8) * 2) = vv1;
            if (sg == 0) { EB[k] = __builtin_amdgcn_exp2f(blast); EBR[k] = __builtin_amdgcn_exp2f(blast - ref); }
            Bseg += blast;
        }
        LDS_BAR();
        __builtin_amdgcn_sched_barrier(0);
        f32x16 oT;
#pragma unroll
        for (int r = 0; r < 16; ++r) oT[r] = 0.f;
#pragma unroll
        for (int st = 0; st < 2; ++st) {
            if (st <= tt) {
                f32x16 a;
#pragma unroll
                for (int r = 0; r < 16; ++r) a[r] = 0.f;
#pragma unroll
                for (int ks = 0; ks < 8; ++ks) {
                    const bf16x8 A = *(const LAS bf16x8*)(L + O_KT + ((32 * st + l32) * RSK + 16 * ks + 8 * hh) * 2);
                    const bf16x8 B = *(const LAS bf16x8*)(L + O_QT + ((32 * tt + l32) * RSK + 16 * ks + 8 * hh) * 2);
                    a = MFMA32(A, B, a);
                    if (ks & 1) __builtin_amdgcn_sched_barrier(0);
                }
                if (st == tt) {
#pragma unroll
                    for (int r = 0; r < 16; ++r) { const int sl = 8 * (r >> 2) + 4 * hh + (r & 3); if (sl > l32) a[r] = 0.f; }
                }
#pragma unroll
                for (int j = 0; j < 2; ++j) {
                    v4u bp; bp.x = cvtpk(a[8 * j], a[8 * j + 1]); bp.y = cvtpk(a[8 * j + 2], a[8 * j + 3]); bp.z = cvtpk(a[8 * j + 4], a[8 * j + 5]); bp.w = cvtpk(a[8 * j + 6], a[8 * j + 7]);
                    const v2u lo = *(const LAS v2u*)(L + O_VT + ((32 * vt + l32) * RST + 32 * st + 16 * j + 4 * hh) * 2);
                    const v2u hi = *(const LAS v2u*)(L + O_VT + ((32 * vt + l32) * RST + 32 * st + 16 * j + 8 + 4 * hh) * 2);
                    const v4u av = (v4u){lo.x, lo.y, hi.x, hi.y};
                    oT = MFMA32(__builtin_bit_cast(bf16x8, av), __builtin_bit_cast(bf16x8, bp), oT);
                    __builtin_amdgcn_sched_barrier(0);
                }
            }
            __builtin_amdgcn_sched_barrier(0);
        }
#pragma unroll
        for (int ks = 0; ks < 8; ++ks) {
            const bf16x8 A = *(const LAS bf16x8*)(L + O_SP + ((32 * vt + l32) * RSK + 16 * ks + 8 * hh) * 2);
            const bf16x8 B = *(const LAS bf16x8*)(L + O_QT + ((32 * tt + l32) * RSK + 16 * ks + 8 * hh) * 2);
            oT = MFMA32(A, B, oT);
            if (ks & 1) __builtin_amdgcn_sched_barrier(0);
        }
        __builtin_amdgcn_sched_barrier(0);
#pragma unroll
        for (int kti = 0; kti < 2; ++kti) {
            const int kt = 2 * tt + kti;
            f32x16 T;
#pragma unroll
            for (int r = 0; r < 16; ++r) T[r] = 0.f;
#pragma unroll
            for (int ts = 0; ts < 4; ++ts) {
                const bf16x8 A = *(const LAS bf16x8*)(L + O_KTT + ((32 * kt + l32) * RST + 16 * ts + 8 * hh) * 2);
                const bf16x8 B = *(const LAS bf16x8*)(L + O_VT + ((32 * vt + l32) * RST + 16 * ts + 8 * hh) * 2);
                T = MFMA32(A, B, T);
                if (ts & 1) __builtin_amdgcn_sched_barrier(0);
            }
#pragma unroll
            for (int g = 0; g < 4; ++g) {
                const f32x4 eb = *(const LAS f32x4*)(EB + 32 * kt + 8 * g + 4 * hh), ebr = *(const LAS f32x4*)(EBR + 32 * kt + 8 * g + 4 * hh);
#pragma unroll
                for (int e = 0; e < 4; ++e) { if (kti) S1[4 * g + e] = eb[e] * S1[4 * g + e] + ebr[e] * T[4 * g + e]; else S0[4 * g + e] = eb[e] * S0[4 * g + e] + ebr[e] * T[4 * g + e]; }
            }
            __builtin_amdgcn_sched_barrier(0);
        }
        {
            float* op = OP + ((size_t)(((b * 4 + h) * 8 + seg) * 4 + (c & 3)) * 8 + wave) * 1024 + (size_t)lane * 4;
#pragma unroll
            for (int g = 0; g < 4; ++g) *(f32x4*)(op + 256 * g) = (f32x4){oT[4 * g], oT[4 * g + 1], oT[4 * g + 2], oT[4 * g + 3]};
        }
    }
#undef HG_LOAD_L
#undef HG_LOAD_QKV
    asm volatile("" : "+v"(l32), "+v"(hh));
    const int un = (b * 4 + h) * 8 + seg;
    float* So = (float*)(ws + WS_HSL) + (size_t)un * 128 * 128;
    if (sg == 0) ((float*)(ws + WS_HDE))[un * 128 + k] = __builtin_amdgcn_exp2f(Bseg);
#pragma unroll
    for (int kti = 0; kti < 2; ++kti)
#pragma unroll
        for (int g = 0; g < 4; ++g) *(f32x4*)(So + (size_t)(((wave * 2 + kti) * 4 + g) * 64 + lane) * 4) = kti ? (f32x4){S1[4 * g], S1[4 * g + 1], S1[4 * g + 2], S1[4 * g + 3]} : (f32x4){S0[4 * g], S0[4 * g + 1], S0[4 * g + 2], S0[4 * g + 3]};
    LDS_BAR();
}

__device__ __forceinline__ void hgrn_pass2(Frame& F, int l, int b, int h, int seg) {
    unsigned char* ws = F.ws; const bf16* P = (const bf16*)(ws + WS_PROJ); bf16* MIX = (bf16*)(ws + WS_MIX); const bf16* QB = (const bf16*)(ws + WS_HQB); const float* OP = (const float*)(ws + WS_HOP);
    constexpr int RSK = 136;
    constexpr int O_SP = 0, O_QB = 128 * RSK * 2, O_SSQ = O_QB + 256 * RSK * 2, O_ENDL = O_SSQ + 4096;
    static_assert(O_ENDL <= RING_BYTES, "hgrn pass 2 LDS map");
    LAS unsigned char* L = F.lds + RING_OFF; LAS float* SSQ = (LAS float*)(L + O_SSQ);
    const int tid = F.tid, lane = F.lane, wave = F.wave, vt = wave >> 1, tt = wave & 1;
    int l32 = lane & 31, hh = lane >> 5;
    const int u0 = (b * 4 + h) * 8, m0 = b * SEQ + seg * 256;
    const float* SL = (const float*)(ws + WS_HSL); const float* DE = (const float*)(ws + WS_HDE);
    f32x16 S0, S1;
    {
        f32x4 w[8], acc[8];
#pragma unroll
        for (int q = 0; q < 8; ++q) { w[q] = (f32x4){1.f, 1.f, 1.f, 1.f}; acc[q] = (f32x4){0.f, 0.f, 0.f, 0.f}; }
#pragma unroll 1
        for (int j = seg - 1; j >= 0; --j) {
            const float* sl = SL + (size_t)(u0 + j) * 128 * 128 + (size_t)(wave * 8 * 64 + lane) * 4;
            f32x4 x[8];
#pragma unroll
            for (int q = 0; q < 8; ++q) x[q] = *(const f32x4*)(sl + (size_t)q * 256);
#pragma unroll
            for (int q = 0; q < 8; ++q) acc[q] = acc[q] + w[q] * x[q];
            if (j > 0) { const float* de = DE + (u0 + j) * 128;
#pragma unroll
                for (int q = 0; q < 8; ++q) w[q] = w[q] * *(const f32x4*)(de + 32 * (2 * tt + (q >> 2)) + 8 * (q & 3) + 4 * hh); }
        }
#pragma unroll
        for (int g = 0; g < 4; ++g) { S0[4 * g] = acc[g].x; S0[4 * g + 1] = acc[g].y; S0[4 * g + 2] = acc[g].z; S0[4 * g + 3] = acc[g].w;
            S1[4 * g] = acc[4 + g].x; S1[4 * g + 1] = acc[4 + g].y; S1[4 * g + 2] = acc[4 + g].z; S1[4 * g + 3] = acc[4 + g].w; }
    }
    v4u qv[8];
    if (seg > 0) {
#pragma unroll
        for (int i = 0; i < 8; ++i) { const int ch = tid + 512 * i; qv[i] = *(const v4u*)(QB + (size_t)(m0 + (ch >> 4)) * 512 + h * 128 + 8 * (ch & 15)); } }
    LDS_BAR();
#pragma unroll
    for (int kti = 0; kti < 2; ++kti) { const int kt = 2 * tt + kti;
#pragma unroll
        for (int g = 0; g < 4; ++g) { const int k0 = 32 * kt + 8 * g + 4 * hh;
            v2u w; w.x = kti ? cvtpk(S1[4 * g], S1[4 * g + 1]) : cvtpk(S0[4 * g], S0[4 * g + 1]); w.y = kti ? cvtpk(S1[4 * g + 2], S1[4 * g + 3]) : cvtpk(S0[4 * g + 2], S0[4 * g + 3]);
            *(LAS v2u*)(L + O_SP + ((32 * vt + l32) * RSK + k0) * 2) = w; } }
    if (seg > 0) {
#pragma unroll
        for (int i = 0; i < 8; ++i) { const int ch = tid + 512 * i; *(LAS v4u*)(L + O_QB + ((ch >> 4) * RSK + 8 * (ch & 15)) * 2) = qv[i]; } }
    if (seg == 7) {
        const float* sl = SL + (size_t)(u0 + 7) * 128 * 128 + (size_t)(wave * 8 * 64 + lane) * 4; const float* de = DE + (u0 + 7) * 128;
        float* So = F.out + O_HP + ((size_t)(l * NB + b) * 4 + h) * 128 * 128 + 32 * vt + l32;
#pragma unroll
        for (int kti = 0; kti < 2; ++kti) { const int kt = 2 * tt + kti;
#pragma unroll
            for (int g = 0; g < 4; ++g) { const int k0 = 32 * kt + 8 * g + 4 * hh; const f32x4 d4 = *(const f32x4*)(de + k0); const f32x4 x4 = *(const f32x4*)(sl + (size_t)(kti * 4 + g) * 256);
#pragma unroll
                for (int e = 0; e < 4; ++e) So[(size_t)(k0 + e) * 128] = d4[e] * (kti ? S1[4 * g + e] : S0[4 * g + e]) + x4[e]; } }
    }
    LDS_BAR();
    asm volatile("" : "+v"(l32), "+v"(hh));
    f32x16 oT[4];
#pragma unroll
    for (int i = 0; i < 4; ++i) {
        { const float* op = OP + ((size_t)((u0 + seg) * 4 + i) * 8 + wave) * 1024 + (size_t)lane * 4;
#pragma unroll
          for (int g = 0; g < 4; ++g) { const f32x4 x = *(const f32x4*)(op + 256 * g); oT[i][4 * g] = x.x; oT[i][4 * g + 1] = x.y; oT[i][4 * g + 2] = x.z; oT[i][4 * g + 3] = x.w; } }
        if (seg > 0) {
            LAS unsigned char* spb = L + O_SP + ((32 * vt + l32) * RSK + 8 * hh) * 2; asm volatile("" : "+v"(spb));
            LAS unsigned char* qbb = L + O_QB + ((64 * i + 32 * tt + l32) * RSK + 8 * hh) * 2; asm volatile("" : "+v"(qbb));
#pragma unroll
            for (int ks = 0; ks < 8; ++ks) { const bf16x8 A = *(const LAS bf16x8*)(spb + 32 * ks); const bf16x8 B = *(const LAS bf16x8*)(qbb + 32 * ks); oT[i] = MFMA32(A, B, oT[i]);
                if (ks & 1) __builtin_amdgcn_sched_barrier(0); }
        }
        float ss = 0.f;
#pragma unroll
        for (int r = 0; r < 16; ++r) ss += oT[i][r] * oT[i][r];
        ss += __shfl_xor(ss, 32);
        if (hh == 0) SSQ[vt * 256 + 64 * i + 32 * tt + l32] = ss;
    }
    LDS_BAR();
    const float* gn = F.in[IN_HN] + l * 512 + h * 128;
#pragma unroll
    for (int i = 0; i < 4; ++i) {
        const int tl = 64 * i + 32 * tt + l32;
        const float tot = (SSQ[tl] + SSQ[256 + tl]) + (SSQ[512 + tl] + SSQ[768 + tl]);
        const float rinv = rsqrtf(tot * (1.f / 128.f) + EPS);
#pragma unroll
        for (int g = 0; g < 4; ++g) { const int v0 = 32 * vt + 8 * g + 4 * hh; const f32x4 g4 = *(const f32x4*)(gn + v0);
            v2u w; w.x = cvtpk(oT[i][4 * g] * rinv * g4.x, oT[i][4 * g + 1] * rinv * g4.y); w.y = cvtpk(oT[i][4 * g + 2] * rinv * g4.z, oT[i][4 * g + 3] * rinv * g4.w);
            *(LAS v2u*)(L + O_QB + (tl * RSK + v0) * 2) = w; }
    }
    LDS_BAR();
#pragma unroll
    for (int i = 0; i < 8; ++i) { const int ch = tid + 512 * i, row = ch >> 4, c8 = 8 * (ch & 15);
        float o[8], g[8]; unpack8(*(const LAS v4u*)(L + O_QB + (row * RSK + c8) * 2), o); unpack8(*(const v4u*)(P + (size_t)(m0 + row) * PIN + C_GR + h * 128 + c8), g);
        *(v4u*)(MIX + (size_t)(m0 + row) * DM + 512 + h * 128 + c8) = (v4u){cvtpk(o[0] * g[0], o[1] * g[1]), cvtpk(o[2] * g[2], o[3] * g[3]), cvtpk(o[4] * g[4], o[5] * g[5]), cvtpk(o[6] * g[6], o[7] * g[7])}; }
}

__device__ __forceinline__ void swa_unit_prompt(Frame& F, int l, int b, int kvh, int jb) {
    unsigned char* ws = F.ws; const bf16* P = (const bf16*)(ws + WS_PROJ); bf16* MIX = (bf16*)(ws + WS_MIX);
    const float* cs = (const float*)(ws + WS_TAB + TAB_COS); const float* sn = (const float*)(ws + WS_TAB + TAB_SIN);
    constexpr int RK = 72, RV = 264;
    constexpr int O_KR = 0, O_VT = 256 * RK * 2, O_E = O_VT + 64 * RV * 2;
    static_assert(O_E <= 100 * 1024, "swa LDS map");
    LAS unsigned char* L = F.lds + RING_OFF;
    const int tid = F.tid, lane = F.lane, wave = F.wave;
    const int l32 = lane & 31, hh = lane >> 5;
    const int p0 = jb * 128 - 128;
    LDS_BAR();
#pragma unroll
    for (int i = 0; i < 2; ++i) { const int item = tid + 512 * i, ci = item >> 2, c8 = item & 3, kp = p0 + ci;
        v4u w1 = {0u, 0u, 0u, 0u}, w2 = w1;
        if (kp >= 0) { const bf16* kr = P + (size_t)(b * SEQ + kp) * PIN + C_K + kvh * 64 + c8 * 8;
            float k1[8], k2[8], cc[8], ss[8]; unpack8(*(const v4u*)kr, k1); unpack8(*(const v4u*)(kr + 32), k2); load8f(cs + kp * 32 + c8 * 8, cc); load8f(sn + kp * 32 + c8 * 8, ss);
            float r1[8], r2[8];
#pragma unroll
            for (int e = 0; e < 8; ++e) { r1[e] = k1[e] * cc[e] - k2[e] * ss[e]; r2[e] = k2[e] * cc[e] + k1[e] * ss[e]; }
            w1 = (v4u){cvtpk(r1[0], r1[1]), cvtpk(r1[2], r1[3]), cvtpk(r1[4], r1[5]), cvtpk(r1[6], r1[7])};
            w2 = (v4u){cvtpk(r2[0], r2[1]), cvtpk(r2[2], r2[3]), cvtpk(r2[4], r2[5]), cvtpk(r2[6], r2[7])};
            if (jb == SEQ / 128 - 1 && ci >= 128) { float* ok = F.out + O_WKP + (((size_t)(l * NB + b) * 128 + (ci - 128)) * 2 + kvh) * 64 + c8 * 8;
                *(f32x4*)ok = (f32x4){r1[0], r1[1], r1[2], r1[3]}; *(f32x4*)(ok + 4) = (f32x4){r1[4], r1[5], r1[6], r1[7]};
                *(f32x4*)(ok + 32) = (f32x4){r2[0], r2[1], r2[2], r2[3]}; *(f32x4*)(ok + 36) = (f32x4){r2[4], r2[5], r2[6], r2[7]}; } }
        *(LAS v4u*)(L + O_KR + (ci * RK + c8 * 8) * 2) = w1; *(LAS v4u*)(L + O_KR + (ci * RK + 32 + c8 * 8) * 2) = w2; }
    { const int d = tid & 63, kg = tid >> 6;
#pragma unroll
      for (int q4 = 0; q4 < 4; ++q4) { unsigned w[4];
#pragma unroll
          for (int e = 0; e < 4; ++e) { const int ci = 32 * kg + 8 * q4 + 2 * e, kp = p0 + ci; unsigned short a = 0, c = 0;
              if (kp >= 0) { a = P[(size_t)(b * SEQ + kp) * PIN + C_V + kvh * 64 + d]; c = P[(size_t)(b * SEQ + kp + 1) * PIN + C_V + kvh * 64 + d];
                  if (jb == SEQ / 128 - 1 && ci >= 128) { float* ov = F.out + O_WVP + (((size_t)(l * NB + b) * 128 + (ci - 128)) * 2 + kvh) * 64 + d; ov[0] = bf2f(a); ov[128] = bf2f(c); } }
              w[e] = (unsigned)a | ((unsigned)c << 16); }
          *(LAS v4u*)(L + O_VT + (d * RV + 32 * kg + 8 * q4) * 2) = (v4u){w[0], w[1], w[2], w[3]}; } }
    LDS_BAR();
    const int g = wave >> 1, h = kvh * 4 + g;
    const float sink2 = F.in[IN_SINK][l * 8 + h] * 1.4426950408889634f;
#pragma unroll 1
    for (int s = 0; s < 2; ++s) {
        const int r0 = 64 * (wave & 1) + 32 * s;
        const int t = jb * 128 + r0 + l32;
        bf16x8 qf[4];
        { const bf16* qr = P + (size_t)(b * SEQ + t) * PIN + h * 64 + 8 * hh;
          float x[4][8]; unpack8(*(const v4u*)qr, x[0]); unpack8(*(const v4u*)(qr + 16), x[1]); unpack8(*(const v4u*)(qr + 32), x[2]); unpack8(*(const v4u*)(qr + 48), x[3]);
          const float qs = 0.125f * 1.4426950408889634f;
#pragma unroll
          for (int ks = 0; ks < 2; ++ks) { float cc[8], ss[8]; load8f(cs + t * 32 + 16 * ks + 8 * hh, cc); load8f(sn + t * 32 + 16 * ks + 8 * hh, ss); float r1[8], r2[8];
#pragma unroll
              for (int e = 0; e < 8; ++e) { r1[e] = (x[ks][e] * cc[e] - x[ks + 2][e] * ss[e]) * qs; r2[e] = (x[ks + 2][e] * cc[e] + x[ks][e] * ss[e]) * qs; }
              qf[ks] = __builtin_bit_cast(bf16x8, (v4u){cvtpk(r1[0], r1[1]), cvtpk(r1[2], r1[3]), cvtpk(r1[4], r1[5]), cvtpk(r1[6], r1[7])});
              qf[ks + 2] = __builtin_bit_cast(bf16x8, (v4u){cvtpk(r2[0], r2[1]), cvtpk(r2[2], r2[3]), cvtpk(r2[4], r2[5]), cvtpk(r2[6], r2[7])}); } }
        f32x16 sc[5];
#pragma unroll
        for (int kt = 0; kt < 5; ++kt) {
#pragma unroll
            for (int r = 0; r < 16; ++r) sc[kt][r] = 0.f;
#pragma unroll
            for (int ks = 0; ks < 4; ++ks) { const bf16x8 A = *(const LAS bf16x8*)(L + O_KR + ((r0 + 32 * kt + l32) * RK + 16 * ks + 8 * hh) * 2); sc[kt] = MFMA32(A, qf[ks], sc[kt]); }
            __builtin_amdgcn_sched_barrier(0);
        }
        const int kt_lo = (jb == 0) ? 4 - (r0 >> 5) : 0;
        float mx = sink2;
#pragma unroll
        for (int kt = 0; kt < 5; ++kt)
#pragma unroll
            for (int r = 0; r < 16; ++r) { const int kl = 8 * (r >> 2) + 4 * hh + (r & 3);
                bool ok = kt >= kt_lo; if (kt == 0) ok = ok && (kl >= l32); if (kt == 4) ok = ok && (kl <= l32);
                const float v = ok ? sc[kt][r] : -INFINITY; sc[kt][r] = v; mx = fmaxf(mx, v); }
        mx = fmaxf(mx, __shfl_xor(mx, 32));
        float sum = 0.f;
#pragma unroll
        for (int kt = 0; kt < 5; ++kt)
#pragma unroll
            for (int r = 0; r < 16; ++r) { const float p = __builtin_amdgcn_exp2f(sc[kt][r] - mx); sc[kt][r] = p; sum += p; }
        sum += __shfl_xor(sum, 32);
        const float inv = 1.f / (sum + __builtin_amdgcn_exp2f(sink2 - mx));
        f32x16 o[2];
#pragma unroll
        for (int dt = 0; dt < 2; ++dt) {
#pragma unroll
            for (int r = 0; r < 16; ++r) o[dt][r] = 0.f; }
#pragma unroll
        for (int kt = 0; kt < 5; ++kt) {
#pragma unroll
            for (int j = 0; j < 2; ++j) {
                const v4u bp = {cvtpk(sc[kt][8 * j], sc[kt][8 * j + 1]), cvtpk(sc[kt][8 * j + 2], sc[kt][8 * j + 3]), cvtpk(sc[kt][8 * j + 4], sc[kt][8 * j + 5]), cvtpk(sc[kt][8 * j + 6], sc[kt][8 * j + 7])};
#pragma unroll
                for (int dt = 0; dt < 2; ++dt) {
                    const v2u lo = *(const LAS v2u*)(L + O_VT + ((32 * dt + l32) * RV + r0 + 32 * kt + 16 * j + 4 * hh) * 2);
                    const v2u hi = *(const LAS v2u*)(L + O_VT + ((32 * dt + l32) * RV + r0 + 32 * kt + 16 * j + 8 + 4 * hh) * 2);
                    o[dt] = MFMA32(__builtin_bit_cast(bf16x8, (v4u){lo.x, lo.y, hi.x, hi.y}), __builtin_bit_cast(bf16x8, bp), o[dt]);
                }
            }
            __builtin_amdgcn_sched_barrier(0);
        }
        bf16* orow = MIX + (size_t)(b * SEQ + t) * DM + h * 64 + 4 * hh;
#pragma unroll
        for (int dt = 0; dt < 2; ++dt)
#pragma unroll
            for (int g4 = 0; g4 < 4; ++g4) { v2u w; w.x = cvtpk(o[dt][4 * g4] * inv, o[dt][4 * g4 + 1] * inv); w.y = cvtpk(o[dt][4 * g4 + 2] * inv, o[dt][4 * g4 + 3] * inv);
                *(v2u*)(orow + 32 * dt + 8 * g4) = w; }
    }
}

#define MFMA16(a, b, c) __builtin_amdgcn_mfma_f32_16x16x32_bf16((a), (b), (c), 0, 0, 0)
__device__ __forceinline__ void xattn_unit_prompt(Frame& F, int l, int b, int h, int qb) {
    unsigned char* ws = F.ws; const bf16* QX = (const bf16*)(ws + WS_QX); bf16* OX = (bf16*)(ws + WS_OX);
    const bf16* MK = (const bf16*)(ws + WS_MK) + ((size_t)l * 2048 + b * 256) * DM + h * 256;
    const bf16* MVT = (const bf16*)(ws + WS_MVT) + ((size_t)((l * NB + b) * 4 + h) * 256) * 256;
    constexpr int RKX = 264, RVX = 68;
    constexpr int TILE_K = 64 * RKX * 2, TILE_V = 256 * RVX * 2;
    static_assert(2 * TILE_V <= 100 * 1024, "xattn LDS map");
    LAS unsigned char* L = F.lds + RING_OFF;
    const int tid = F.tid, lane = F.lane, wave = F.wave;
    const int l32 = lane & 31, hh = lane >> 5;
    const int row = b * SEQ + qb * 256 + wave * 32 + l32;
    bf16x8 qf[16];
    { const bf16* qr = QX + (size_t)row * DM + h * 256 + 8 * hh;
#pragma unroll
      for (int ks = 0; ks < 16; ++ks) qf[ks] = *(const bf16x8*)(qr + 16 * ks); }
    v4u pre[2];
    bf16x8 pf[16];
    float tmx[4], runM = -INFINITY, runL = 0.f;
    unsigned koff[4];
#pragma unroll
    for (int j_ = 0; j_ < 4; ++j_) { const int ch_ = tid + 512 * j_; koff[j_] = (unsigned)(((ch_ >> 5) * DM + 8 * (ch_ & 31)) * 2); }
#define XK_LOAD(mt, hf) do { const char* kb_ = (const char*)MK + (size_t)(64 * (mt)) * DM * 2; _Pragma("unroll") for (int j_ = 0; j_ < 2; ++j_) pre[j_] = *(const v4u*)(kb_ + koff[2 * (hf) + j_]); } while (0)
#define XK_STORE(buf, hf) do { _Pragma("unroll") for (int j_ = 0; j_ < 2; ++j_) { const int ch_ = tid + 512 * (2 * (hf) + j_); *(LAS v4u*)(L + (buf) * TILE_K + ((ch_ >> 5) * RKX + 8 * (ch_ & 31)) * 2) = pre[j_]; } } while (0)
    LDS_BAR();
    XK_LOAD(0, 0); XK_STORE(0, 0); XK_LOAD(0, 1); XK_STORE(0, 1);
#pragma unroll
    for (int mt = 0; mt < 4; ++mt) {
        LDS_BAR();
        LAS unsigned char* kbp = L + (mt & 1) * TILE_K + (l32 * RKX + 8 * hh) * 2; asm volatile("" : "+v"(kbp));
        f32x16 sc[2];
#pragma unroll
        for (int i = 0; i < 2; ++i) {
            if (mt + 1 < 4) XK_LOAD(mt + 1, i);
#pragma unroll
            for (int r = 0; r < 16; ++r) sc[i][r] = 0.f;
#pragma unroll
            for (int ks = 0; ks < 16; ++ks) { const bf16x8 A = *(const LAS bf16x8*)(kbp + (32 * i * RKX + 16 * ks) * 2); sc[i] = MFMA32(A, qf[ks], sc[i]);
                if ((ks & 3) == 3) __builtin_amdgcn_sched_barrier(0); }
            if (mt + 1 < 4) XK_STORE((mt + 1) & 1, i);
        }
        float m_ = -INFINITY;
#pragma unroll
        for (int i = 0; i < 2; ++i)
#pragma unroll
            for (int r = 0; r < 16; ++r) m_ = fmaxf(m_, sc[i][r]);
        m_ = fmaxf(m_, __shfl_xor(m_, 32));
        float s_ = 0.f;
#pragma unroll
        for (int i = 0; i < 2; ++i) {
#pragma unroll
            for (int r = 0; r < 16; ++r) { const float p = __builtin_amdgcn_exp2f(sc[i][r] - m_); sc[i][r] = p; s_ += p; }
#pragma unroll
            for (int j = 0; j < 2; ++j) pf[4 * mt + 2 * i + j] = __builtin_bit_cast(bf16x8, (v4u){cvtpk(sc[i][8 * j], sc[i][8 * j + 1]), cvtpk(sc[i][8 * j + 2], sc[i][8 * j + 3]), cvtpk(sc[i][8 * j + 4], sc[i][8 * j + 5]), cvtpk(sc[i][8 * j + 6], sc[i][8 * j + 7])});
        }
        tmx[mt] = m_; { const float nM = fmaxf(runM, m_); runL = runL * __builtin_amdgcn_exp2f(runM - nM) + s_ * __builtin_amdgcn_exp2f(m_ - nM); runM = nM; }
    }
#undef XK_LOAD
#undef XK_STORE
    const float mx = runM;
    float sum = runL;
#pragma unroll
    for (int mt = 0; mt < 4; ++mt) { const float scl_ = __builtin_amdgcn_exp2f(tmx[mt] - mx);
#pragma unroll
        for (int f = 0; f < 4; ++f) { const v4u w = __builtin_bit_cast(v4u, pf[4 * mt + f]);
            pf[4 * mt + f] = __builtin_bit_cast(bf16x8, (v4u){cvtpk(bflo(w.x) * scl_, bfhi(w.x) * scl_), cvtpk(bflo(w.y) * scl_, bfhi(w.y) * scl_), cvtpk(bflo(w.z) * scl_, bfhi(w.z) * scl_), cvtpk(bflo(w.w) * scl_, bfhi(w.w) * scl_)}); } }
    sum += __shfl_xor(sum, 32);
    const float inv = 1.f / sum;
    constexpr int TILE_H = 128 * RVX * 2;
    unsigned voff[2];
#pragma unroll
    for (int j_ = 0; j_ < 2; ++j_) { const int ch_ = tid + 512 * j_; voff[j_] = (unsigned)(((ch_ >> 3) * 256 + 8 * (ch_ & 7)) * 2); }
#define XV_LOAD(st) do { const char* vb_ = (const char*)MVT + ((size_t)(128 * ((st) >> 2)) * 256 + 64 * ((st) & 3)) * 2; _Pragma("unroll") for (int j_ = 0; j_ < 2; ++j_) pre[j_] = *(const v4u*)(vb_ + voff[j_]); } while (0)
#define XV_STORE(buf) do { _Pragma("unroll") for (int j_ = 0; j_ < 2; ++j_) { const int ch_ = tid + 512 * j_; LAS unsigned char* d_ = L + (buf) * TILE_H + ((ch_ >> 3) * RVX + 8 * (ch_ & 7)) * 2; *(LAS v2u*)d_ = (v2u){pre[j_].x, pre[j_].y}; *(LAS v2u*)(d_ + 8) = (v2u){pre[j_].z, pre[j_].w}; } } while (0)
    XV_LOAD(0);
    LDS_BAR();
    XV_STORE(0);
    bf16* orow = OX + (size_t)row * DM + h * 256 + 4 * hh;
#pragma unroll
    for (int dh = 0; dh < 2; ++dh) {
        f32x16 o[4];
#pragma unroll
        for (int i = 0; i < 4; ++i)
#pragma unroll
            for (int r = 0; r < 16; ++r) o[i][r] = 0.f;
#pragma unroll
        for (int mt = 0; mt < 4; ++mt) {
            const int st = 4 * dh + mt;
            if (st + 1 < 8) XV_LOAD(st + 1);
            LDS_BAR();
            LAS unsigned char* vbp = L + (st & 1) * TILE_H + (l32 * RVX + 4 * hh) * 2; asm volatile("" : "+v"(vbp));
#pragma unroll
            for (int dt = 0; dt < 4; ++dt) {
#pragma unroll
                for (int k4 = 0; k4 < 4; ++k4) {
                    const v2u lo = *(const LAS v2u*)(vbp + (32 * dt * RVX + 16 * k4) * 2);
                    const v2u hi = *(const LAS v2u*)(vbp + (32 * dt * RVX + 16 * k4 + 8) * 2);
                    o[dt] = MFMA32(__builtin_bit_cast(bf16x8, (v4u){lo.x, lo.y, hi.x, hi.y}), pf[4 * mt + k4], o[dt]);
                }
                __builtin_amdgcn_sched_barrier(0);
            }
            if (st + 1 < 8) XV_STORE((st + 1) & 1);
        }
#pragma unroll
        for (int dt = 0; dt < 4; ++dt)
#pragma unroll
            for (int g = 0; g < 4; ++g) { v2u w; w.x = cvtpk(o[dt][4 * g] * inv, o[dt][4 * g + 1] * inv); w.y = cvtpk(o[dt][4 * g + 2] * inv, o[dt][4 * g + 3] * inv); *(v2u*)(orow + 128 * dh + 32 * dt + 8 * g) = w; }
    }
#undef XV_LOAD
#undef XV_STORE
}

template <int K>
__device__ __forceinline__ void sample_slice_gemm(Frame& F, const bf16* A, const bf16* Wt, float* Yf, bf16* Qb, float sc, const float* rs = nullptr) {
    const int lane = F.lane, l16 = lane & 15, hq = lane >> 4, wave = F.wave;
    const int rg = blockIdx.x & 7, cs = blockIdx.x >> 3;
    constexpr int NKS = (K >> 5) / 8;
    const GAS bf16* ap = (const GAS bf16*)A + (size_t)(16 * rg + l16) * K + 8 * hq + 32 * NKS * wave;
    const GAS bf16* wp = (const GAS bf16*)Wt + (size_t)(32 * cs + l16) * K + 8 * hq + 32 * NKS * wave;
    f32x4 acc0 = {0.f, 0.f, 0.f, 0.f}, acc1 = acc0;
    bf16x8 a[NKS], b0[NKS], b1[NKS];
#pragma unroll
    for (int i = 0; i < NKS; ++i) { a[i] = *(const GAS bf16x8*)(ap + 32 * i); b0[i] = *(const GAS bf16x8*)(wp + 32 * i); b1[i] = *(const GAS bf16x8*)(wp + (size_t)16 * K + 32 * i); }
#pragma unroll
    for (int i = 0; i < NKS; ++i) { acc0 = MFMA16(a[i], b0[i], acc0); acc1 = MFMA16(a[i], b1[i], acc1); }
    LAS f32x4* red = (LAS f32x4*)(F.lds + RING_OFF);
    LDS_BAR();
    red[(wave * 2 + 0) * 64 + lane] = acc0; red[(wave * 2 + 1) * 64 + lane] = acc1;
    LDS_BAR();
    if (wave < 2) {
        f32x4 s = {0.f, 0.f, 0.f, 0.f};
#pragma unroll
        for (int w = 0; w < 8; ++w) s = s + red[(w * 2 + wave) * 64 + lane];
        const int n = 32 * cs + 16 * wave + l16;
#pragma unroll
        for (int e = 0; e < 4; ++e) { const size_t off = (size_t)(MP + 16 * rg + 4 * hq + e) * DM + n;
            const float rv = rs ? rs[16 * rg + 4 * hq + e] : 1.f;
            if (Yf) Yf[off] = s[e] * rv; else Qb[off] = (bf16)(cvtpk(s[e] * sc * rv, 0.f) & 0xffffu); }
    }
    LDS_BAR();
}

#ifndef MK_PER_PHASE
#define MK_PER_PHASE 0
#endif
#ifndef EN_CONV
#define EN_CONV 1
#endif
#ifndef EN_DOWN
#define EN_DOWN 1
#endif
#ifndef EN_INPROJ
#define EN_INPROJ 1
#endif
#ifndef EN_MEMKV
#define EN_MEMKV 1
#endif
#ifndef EN_MIX
#define EN_MIX 1
#endif
#ifndef EN_NORM
#define EN_NORM 1
#endif
#ifndef EN_PROLOG
#define EN_PROLOG 1
#endif
#ifndef EN_UP
#define EN_UP 1
#endif
#ifndef EN_WO
#define EN_WO 1
#endif
#ifndef EN_XATTN
#define EN_XATTN 1
#endif
#ifndef EN_XO
#define EN_XO 1
#endif
#ifndef EN_XQ
#define EN_XQ 1
#endif
#ifndef HGRN_NAIVE
#define HGRN_NAIVE 0
#endif
#ifndef DUP_PROLOG
#define DUP_PROLOG 0
#endif
#ifndef DUP_UP
#define DUP_UP 0
#endif
#ifndef DUP_WO
#define DUP_WO 0
#endif
#ifndef DUP_DOWN
#define DUP_DOWN 0
#endif
#ifndef DUP_P1
#define DUP_P1 0
#endif
#ifndef DUP_SWA
#define DUP_SWA 0
#endif
#ifndef DUP_SMP
#define DUP_SMP 0
#endif
#ifndef DUP_XP
#define DUP_XP 0
#endif
#ifndef DUP_XS
#define DUP_XS 0
#endif
#ifndef DUP_MIXB
#define DUP_MIXB 0
#endif
#ifndef DUP_MIX
#define DUP_MIX 0
#endif
#ifndef DUP_XATTN
#define DUP_XATTN 0
#endif
#ifndef DUP_CONV
#define DUP_CONV 0
#endif
#ifndef DUP_INPROJ
#define DUP_INPROJ 0
#endif
constexpr int N_PHASES = 2 + 13 * DEPTH;

struct Args { const float* in[29]; float* out; unsigned char* ws; int ph_lo, ph_hi; };

__global__ void __launch_bounds__(NTHR, 2) mk_fwd(Args args) {
    extern __shared__ __attribute__((aligned(16))) unsigned char lds[];
    Frame F;
    F.lds = (LAS unsigned char*)lds;
    F.MISC = (volatile LAS unsigned*)(F.lds + MISC_OFF);
    F.tid = threadIdx.x; F.lane = F.tid & 63; F.wave = __builtin_amdgcn_readfirstlane(F.tid >> 6);
    F.G = gridDim.x; F.gw = blockIdx.x * NWAVES + F.wave; F.ngw = F.G * NWAVES;
    F.ws = args.ws; F.out = args.out; F.ctl = (unsigned*)(args.ws + WS_CTL);
    F.in = args.in;
    for (int u = F.tid; u < (LDS_BYTES - LDSCTL_OFF) / 4; u += NTHR) ((LAS unsigned*)(F.lds + LDSCTL_OFF))[u] = 0u;
    __syncthreads();
    XcdBarrier bar = xcd_barrier_post(F.ctl + CW_BAR, F.MISC + 8);
    const int lo = args.ph_lo, hi = args.ph_hi;
    unsigned char* ws = args.ws; int bx = blockIdx.x;
#define FRESH() do { bx = blockIdx.x; F.vcu = (bx & 7) * (GRID / 8) + (bx >> 3); F.lane = (int)__builtin_amdgcn_mbcnt_hi(~0u, __builtin_amdgcn_mbcnt_lo(~0u, 0u)); F.tid = F.wave * 64 + F.lane; asm volatile("" : "+s"(ws), "+v"(F.tid), "+v"(F.lane), "+s"(F.wave), "+s"(F.gw), "+s"(bx), "+s"(F.vcu)); F.ws = ws; } while (0)
#define IN(k) (lo <= (k) && (k) < hi)
#define SEAM(k) do { if (IN((k) + 1)) xcd_barrier(bar); } while (0)
    LAS float* wl = (LAS float*)(F.lds + RING_OFF + 102400 + F.wave * 2048);

    if (EN_PROLOG && IN(0)) { _Pragma("unroll 1") for (int rep_ = 0; rep_ <= DUP_PROLOG; ++rep_) { FRESH(); p0_prologue(F); } SEAM(0); }
    if (EN_MEMKV && IN(1)) { FRESH();
        pg8::Gemm g{(const pg8::bf16_t*)(ws + WS_MEMN), (const pg8::bf16_t*)(ws + WS_WXKV), DEPTH * 2048, DEPTH * 2048, DM};
        pg8::BlockDiagOrder S{F.G, bx};
        pg8::EpiMemKV E{F.out + O_MKP, F.out + O_MVP, (pg8::bf16_t*)(ws + WS_MK), (pg8::bf16_t*)(ws + WS_MVT)};
        pg8::gemm_phase<pg8::EpiMemKV, pg8::BlockDiagOrder, true, true>(F.lds + RING_OFF, g, S, E, F.wave);
        SEAM(1);
    }
    for (int l = 0; l < DEPTH; ++l) {
        const int pb = 2 + 13 * l;
        if (EN_INPROJ && IN(pb + 0)) { FRESH();
            pg8::Gemm g{(const pg8::bf16_t*)(ws + WS_XN), (const pg8::bf16_t*)(ws + WS_WIN) + (size_t)l * PIN * DM, MT, PIN, DM};
            pg8::StaticOrder S; S.init(MT, PIN, F.G, bx);
            pg8::EpiProj E{(pg8::bf16_t*)(ws + WS_PROJ), (float*)(ws + WS_LF), (const float*)(ws + WS_TAB + TAB_LB) + l * 512, (pg8::bf16_t*)(ws + WS_HQ), (pg8::bf16_t*)(ws + WS_HK), (pg8::bf16_t*)(ws + WS_HV), (float*)(ws + WS_HLF)};
            _Pragma("unroll 1") for (int rep_ = 0; rep_ <= DUP_INPROJ; ++rep_) pg8::gemm_phase<pg8::EpiProj, pg8::StaticOrder, true, true>(F.lds + RING_OFF, g, S, E, F.wave);
            SEAM(pb + 0);
        }
        if (EN_MIX && IN(pb + 1)) { FRESH();
          _Pragma("unroll 1") for (int rep_ = 0; rep_ <= DUP_MIX; ++rep_) { FRESH();
            _Pragma("unroll 1") for (int r2_ = 0; r2_ <= DUP_P1; ++r2_) { FRESH(); for (int u = F.vcu; u < NB * 4 * 8; u += F.G) hgrn_pass1(F, l, u >> 5, (u >> 3) & 3, u & 7); }
            _Pragma("unroll 1") for (int r2_ = 0; r2_ <= DUP_SWA; ++r2_) { FRESH(); for (int u = F.vcu; u < NB * 2 * 16; u += F.G) swa_unit_prompt(F, l, u >> 5, (u >> 4) & 1, u & 15); }
            _Pragma("unroll 1") for (int r2_ = 0; r2_ <= DUP_SMP; ++r2_) { FRESH(); if (bx < DB) hgrn_unit_sample(F, l, bx); else if (bx < 2 * DB) swa_unit_sample(F, l, bx - DB); }
          }
            SEAM(pb + 1);
        }
        if (EN_MIX && IN(pb + 2)) { FRESH();
            _Pragma("unroll 1") for (int rep_ = 0; rep_ <= DUP_MIXB; ++rep_) { FRESH(); for (int u = F.vcu; u < NB * 4 * 8; u += F.G) hgrn_pass2(F, l, u >> 5, (u >> 3) & 3, u & 7); }
            SEAM(pb + 2);
        }
        if (EN_WO && IN(pb + 3)) { FRESH();
            sample_slice_gemm<DM>(F, (const bf16*)(ws + WS_MIX) + (size_t)MP * DM, (const bf16*)(ws + WS_WO) + (size_t)l * DM * DM, nullptr, (bf16*)(ws + WS_Y), 1.f);
            pg8::Gemm g{(const pg8::bf16_t*)(ws + WS_MIX), (const pg8::bf16_t*)(ws + WS_WO) + (size_t)l * DM * DM, MP, DM, DM};
            pg8::StaticOrder S; S.init(MP, DM, F.G, bx);
            pg8::EpiB16 E{(pg8::bf16_t*)(ws + WS_Y), DM, 1.0f, nullptr};
            _Pragma("unroll 1") for (int rep_ = 0; rep_ <= DUP_WO; ++rep_) pg8::gemm_phase<pg8::EpiB16, pg8::StaticOrder, true, true>(F.lds + RING_OFF, g, S, E, F.wave);
            SEAM(pb + 3);
        }
        if (EN_NORM && IN(pb + 4)) { FRESH(); norm_phase(F, F.in[IN_GQM] + l * DM, nullptr, false); SEAM(pb + 4); }
        if (EN_XQ && IN(pb + 5)) { FRESH();
            sample_slice_gemm<DM>(F, (const bf16*)(ws + WS_X) + (size_t)MP * DM, (const bf16*)(ws + WS_WXQ) + (size_t)l * DM * DM, nullptr, (bf16*)(ws + WS_QX), 0.0625f * 1.4426950408889634f, (const float*)(ws + WS_RS) + MP);
            pg8::Gemm g{(const pg8::bf16_t*)(ws + WS_X), (const pg8::bf16_t*)(ws + WS_WXQ) + (size_t)l * DM * DM, MP, DM, DM};
            pg8::StaticOrder S; S.init(MP, DM, F.G, bx);
            pg8::EpiB16 E{(pg8::bf16_t*)(ws + WS_QX), DM, 0.0625f * 1.4426950408889634f, (const float*)(ws + WS_RS)};
            pg8::gemm_phase<pg8::EpiB16, pg8::StaticOrder, true, true>(F.lds + RING_OFF, g, S, E, F.wave);
            SEAM(pb + 5);
        }
        if (EN_XATTN && IN(pb + 6)) { FRESH();
          _Pragma("unroll 1") for (int rep_ = 0; rep_ <= DUP_XATTN; ++rep_) { FRESH();
            if ((bx >> 3) & 1) for (int u = bx; u < DB * 4; u += F.G) xattn_unit_sample(F, l, u >> 2, u & 3);
            _Pragma("unroll 1") for (int r2_ = 0; r2_ <= DUP_XP; ++r2_) { FRESH(); for (int u = F.vcu; u < NB * 4 * 8; u += F.G) xattn_unit_prompt(F, l, u >> 5, (u >> 3) & 3, u & 7); }
            if (!((bx >> 3) & 1)) for (int u = bx; u < DB * 4; u += F.G) xattn_unit_sample(F, l, u >> 2, u & 3);
            _Pragma("unroll 1") for (int r2_ = 0; r2_ < DUP_XS; ++r2_) { FRESH(); for (int u = bx; u < DB * 4; u += F.G) xattn_unit_sample(F, l, u >> 2, u & 3); }
          }
            SEAM(pb + 6);
        }
        if (EN_XO && IN(pb + 7)) { FRESH();
            sample_slice_gemm<DM>(F, (const bf16*)(ws + WS_OX) + (size_t)MP * DM, (const bf16*)(ws + WS_WXO) + (size_t)l * DM * DM, nullptr, (bf16*)(ws + WS_Y), 1.f);
            pg8::Gemm g{(const pg8::bf16_t*)(ws + WS_OX), (const pg8::bf16_t*)(ws + WS_WXO) + (size_t)l * DM * DM, MP, DM, DM};
            pg8::StaticOrder S; S.init(MP, DM, F.G, bx);
            pg8::EpiB16 E{(pg8::bf16_t*)(ws + WS_Y), DM, 1.0f, nullptr};
            pg8::gemm_phase<pg8::EpiB16, pg8::StaticOrder, true, true>(F.lds + RING_OFF, g, S, E, F.wave);
            SEAM(pb + 7);
        }
        if (EN_NORM && IN(pb + 8)) { FRESH(); norm_phase(F, F.in[IN_GQX] + l * DM, nullptr, false); SEAM(pb + 8); }
        if (EN_UP && IN(pb + 9)) { FRESH();
            pg8::Gemm g{(const pg8::bf16_t*)(ws + WS_X), (const pg8::bf16_t*)(ws + WS_WUP) + (size_t)l * UPW * DM, MT, UPW, DM};
            pg8::StaticOrder S; S.init(MT, UPW, F.G, bx);
            pg8::EpiB16 E{(pg8::bf16_t*)(ws + WS_U), UPW, 1.0f, (const float*)(ws + WS_RS)};
            _Pragma("unroll 1") for (int rep_ = 0; rep_ <= DUP_UP; ++rep_) pg8::gemm_phase<pg8::EpiB16, pg8::StaticOrder, true, true>(F.lds + RING_OFF, g, S, E, F.wave);
            SEAM(pb + 9);
        }
        if (EN_CONV && IN(pb + 10)) { FRESH(); _Pragma("unroll 1") for (int rep_ = 0; rep_ <= DUP_CONV; ++rep_) { FRESH(); conv_phase(F, l); } SEAM(pb + 10); }
        if (EN_DOWN && IN(pb + 11)) { FRESH();
            sample_slice_gemm<DFF>(F, (const bf16*)(ws + WS_G) + (size_t)MP * DFF, (const bf16*)(ws + WS_WDN) + (size_t)l * DM * DFF, nullptr, (bf16*)(ws + WS_Y), 1.f);
            pg8::Gemm g{(const pg8::bf16_t*)(ws + WS_G), (const pg8::bf16_t*)(ws + WS_WDN) + (size_t)l * DM * DFF, MP, DM, DFF};
            pg8::StaticOrder S; S.init(MP, DM, F.G, bx);
            pg8::EpiB16 E{(pg8::bf16_t*)(ws + WS_Y), DM, 1.0f, nullptr};
            _Pragma("unroll 1") for (int rep_ = 0; rep_ <= DUP_DOWN; ++rep_) pg8::gemm_phase<pg8::EpiB16, pg8::StaticOrder, true, true>(F.lds + RING_OFF, g, S, E, F.wave);
            SEAM(pb + 11);
        }
        if (EN_NORM && IN(pb + 12)) { FRESH(); norm_phase(F, F.in[IN_GQF] + l * DM, F.in[IN_GPM] + (l + 1 < DEPTH ? l + 1 : 0) * DM, l == DEPTH - 1); SEAM(pb + 12); }
    }
#undef IN
#undef SEAM
}

extern "C" void kernel_launch(void* const* d_in, const int* in_sizes, int n_in, void* d_out, int out_size, void* d_ws, size_t ws_size, hipStream_t stream) {
    static int grid = 0;
    if (grid == 0) {
        if (n_in != 29 || (size_t)out_size != O_END || ws_size < WS_END) { fprintf(stderr, "kernel_launch: unexpected shapes (n_in %d out %d ws %zu need %zu)\n", n_in, out_size, ws_size, (size_t)WS_END); grid = -1; return; }
        int dev = 0, cus = 0, per_cu = 0;
        if (hipGetDevice(&dev) != hipSuccess || hipDeviceGetAttribute(&cus, hipDeviceAttributeMultiprocessorCount, dev) != hipSuccess) { grid = -1; return; }
        if (hipFuncSetAttribute((const void*)mk_fwd, hipFuncAttributeMaxDynamicSharedMemorySize, LDS_BYTES) != hipSuccess) { fprintf(stderr, "kernel_launch: hipFuncSetAttribute failed\n"); grid = -1; return; }
        if (hipOccupancyMaxActiveBlocksPerMultiprocessor(&per_cu, (const void*)mk_fwd, NTHR, LDS_BYTES) != hipSuccess || per_cu < 1) fprintf(stderr, "kernel_launch: occupancy query says %d\n", per_cu);
        (void)hipGetLastError();
        if (cus < GRID) { fprintf(stderr, "kernel_launch: %d CUs; this kernel needs %d (one resident workgroup per CU)\n", cus, GRID); grid = -1; return; }
        grid = GRID;
    }
    if (grid < 0) return;
    if (hipMemsetAsync((char*)d_ws + WS_CTL, 0, CTL_ZERO_BYTES, stream) != hipSuccess) return;
    Args a{};
    for (int i = 0; i < 29; ++i) a.in[i] = (const float*)d_in[i];
    a.out = (float*)d_out; a.ws = (unsigned char*)d_ws;
#if MK_PER_PHASE
    for (int p = 0; p < N_PHASES; ++p) { a.ph_lo = p; a.ph_hi = p + 1; hipLaunchKernelGGL(mk_fwd, dim3(grid), dim3(NTHR), LDS_BYTES, stream, a); }
#else
    a.ph_lo = 0; a.ph_hi = N_PHASES; hipLaunchKernelGGL(mk_fwd, dim3(grid), dim3(NTHR), LDS_BYTES, stream, a);
#endif
}
```

```cpp
#include <hip/hip_runtime.h>
#include <cstdio>
#include <cstdint>
#include <cmath>
namespace pg8 {
#define PG8_LAS __attribute__((address_space(3)))
typedef unsigned short bf16_t;
typedef short bf16x8 __attribute__((ext_vector_type(8)));
typedef float f32x4 __attribute__((ext_vector_type(4)));
typedef unsigned u32x4 __attribute__((ext_vector_type(4)));
constexpr int BM = 256, BK = 64, HALF = 128, HTB = HALF * BK * 2  , STAGE_BYTES = 8 * HTB, NXCD = 8, WGM = 8;

__host__ __device__ __forceinline__ int lds_byte(int r, int c) { const int st = (r >> 4) * 2 + (c >> 5), rr = r & 15, cc = c & 31, ob = rr * 64 + cc * 2; return st * 1024 + (ob ^ (((ob >> 9) & 1) << 5)); }
__host__ __device__ __forceinline__ void stage_rc(int b, int& R, int& C) { const int st = b / 1024, sb = b % 1024, swz = sb ^ (((sb >> 9) & 1) << 5); R = (st >> 1) * 16 + swz / 64; C = (st & 1) * 32 + (swz % 64) / 2; }
__host__ __device__ __forceinline__ int perm32(int rho) { const int n = rho >> 4, i = rho & 15; return 8 * (i >> 2) + 4 * n + (i & 3); }

struct Unit { int pm, pn; };
struct Gemm { const bf16_t* A; const bf16_t* Bt; int M, N, K; };

struct StaticOrder {
    int nM, nN, nwg, G, c;
    __host__ __device__ void init(int M, int N, int G_, int c_) { nM = M / BM; nN = N / BM; nwg = nM * nN; G = G_; c = c_; }
    __host__ __device__ bool next(int i, Unit& u) const {
        const long L = (long)i * G + c; if (L >= nwg) return false;
        int wgid = (int)L; { const int q = nwg / NXCD, r = nwg % NXCD, xcd = wgid % NXCD, off = wgid / NXCD; wgid = (xcd < r ? xcd * (q + 1) : r * (q + 1) + (xcd - r) * q) + off; }
        const int nig = WGM * nN, gid = wgid / nig, fm = gid * WGM, gsz = (nM - fm) < WGM ? (nM - fm) : WGM;
        u.pm = fm + ((wgid % nig) % gsz); u.pn = (wgid % nig) / gsz; return true;
    }
    __device__ __forceinline__ void a_ready(const Unit&) const {}
    __device__ __forceinline__ void done(const Unit&) const {}
};

__device__ __forceinline__ unsigned cvt_pk_bf16(float lo, float hi) { unsigned r; asm volatile("v_cvt_pk_bf16_f32 %0, %1, %2" : "=v"(r) : "v"(lo), "v"(hi)); return r; }
typedef float f32x2 __attribute__((ext_vector_type(2)));
template <class Epi, class Sched, bool ALIGN_EPI = false, bool SP2 = false>
__device__ __forceinline__ void gemm_phase(PG8_LAS unsigned char* lds, const Gemm g, const Sched& S, const Epi& E, int wave_) {
    int tid_ = (int)__builtin_amdgcn_mbcnt_hi(~0u, __builtin_amdgcn_mbcnt_lo(~0u, 0u)) + 64 * wave_; asm volatile("" : "+v"(tid_));
    const int tid = tid_, wid = __builtin_amdgcn_readfirstlane(tid >> 6), lane = tid & 63, wr = wid >> 2, wc = wid & 3, fr = lane & 15, fq = lane >> 4;
    const int K = g.K, nt = K / BK;
    unsigned voffA[2], voffB[2];
#pragma unroll
    for (int i = 0; i < 2; ++i) { int R, C; stage_rc(tid * 16 + i * 8192, R, C); const int Rb = Epi::PERM ? ((R & ~31) + perm32(R & 31)) : R;
        voffA[i] = (unsigned)(R * K + C) * 2u; voffB[i] = (unsigned)(Rb * K + C) * 2u; }
    const size_t kstep = (size_t)(BK * 2);
    const size_t hstep = (size_t)HALF * K * 2;
    const size_t tstep = 2 * hstep;
    const unsigned ldsw = (unsigned)wid * 1024u;
    const int aoff = lds_byte(wr * 64 + fr, fq * 8), boff = lds_byte(wc * 32 + fr, fq * 8);
#define PG8_SA(b, h) (((b) * 2 + (h)) * HTB)
#define PG8_SB(b, h) ((4 + (b) * 2 + (h)) * HTB)
#define PG8_STAGE(bufoff, gbase, voff) do { _Pragma("unroll") for (int _i = 0; _i < 2; ++_i) \
        __builtin_amdgcn_global_load_lds((const unsigned*)((const char*)(gbase) + (voff)[_i]), (PG8_LAS unsigned*)(lds + (bufoff) + ldsw + _i * 8192), 16, 0, 0); } while (0)
#define PG8_LDA(dst, b, h) do { _Pragma("unroll") for (int m = 0; m < 4; ++m) _Pragma("unroll") for (int k = 0; k < 2; ++k) dst[m][k] = *(const PG8_LAS bf16x8*)(lds + PG8_SA(b, h) + aoff + m * 2048 + k * 1024); } while (0)
#define PG8_LDB(dst, b, h) do { _Pragma("unroll") for (int n = 0; n < 2; ++n) _Pragma("unroll") for (int k = 0; k < 2; ++k) dst[n][k] = *(const PG8_LAS bf16x8*)(lds + PG8_SB(b, h) + boff + n * 2048 + k * 1024); } while (0)
#define PG8_MMA(ai, bj, At, Bt) do { __builtin_amdgcn_s_setprio(1); _Pragma("unroll") for (int m = 0; m < 4; ++m) _Pragma("unroll") for (int n = 0; n < 2; ++n) _Pragma("unroll") for (int k = 0; k < 2; ++k) \
        acc[ai][bj][m][n] = __builtin_amdgcn_mfma_f32_16x16x32_bf16(Bt[n][k], At[m][k], acc[ai][bj][m][n], 0, 0, 0); __builtin_amdgcn_s_setprio(0); } while (0)
#define PG8_WAIT_V(n) asm volatile("s_waitcnt vmcnt(" #n ")" ::: "memory")
#define PG8_WAIT_L(n) asm volatile("s_waitcnt lgkmcnt(" #n ")" ::: "memory")
#define PG8_BAR __builtin_amdgcn_s_barrier()
#define PG8_SCHED __builtin_amdgcn_sched_barrier(0)
    Unit cur, nxt; int ui = 0;
    if (!S.next(0, cur)) return;
    f32x4 acc[2][2][4][2];
#pragma unroll
    for (int a = 0; a < 2; ++a)
#pragma unroll
        for (int b = 0; b < 2; ++b)
#pragma unroll
            for (int m = 0; m < 4; ++m)
#pragma unroll
                for (int n = 0; n < 2; ++n) acc[a][b][m][n] = (f32x4){0.f, 0.f, 0.f, 0.f};
    bf16x8 At[4][2], B0[2][2], B1[2][2];
    const char* cA = (const char*)g.A + (size_t)cur.pm * tstep; const char* cB = (const char*)g.Bt + (size_t)cur.pn * tstep;
    S.a_ready(cur);
    if constexpr (SP2) {
        PG8_STAGE(PG8_SB(0, 0), cB, voffB); PG8_STAGE(PG8_SB(0, 1), cB + hstep, voffB); PG8_STAGE(PG8_SA(0, 0), cA, voffA); PG8_STAGE(PG8_SA(0, 1), cA + hstep, voffA);
        if (wr == 1) PG8_BAR;
        PG8_WAIT_V(2); PG8_BAR;
        PG8_STAGE(PG8_SB(1, 0), cB + kstep, voffB); PG8_STAGE(PG8_SA(1, 0), cA + kstep, voffA); PG8_STAGE(PG8_SB(1, 1), cB + hstep + kstep, voffB);
        PG8_WAIT_V(6); PG8_BAR;
    } else {
        PG8_STAGE(PG8_SB(0, 0), cB, voffB); PG8_STAGE(PG8_SA(0, 0), cA, voffA); PG8_STAGE(PG8_SB(0, 1), cB + hstep, voffB); PG8_STAGE(PG8_SA(0, 1), cA + hstep, voffA);
        if (wr == 1) PG8_BAR;
        PG8_WAIT_V(4); PG8_BAR;
        PG8_STAGE(PG8_SB(1, 0), cB + kstep, voffB); PG8_STAGE(PG8_SA(1, 0), cA + kstep, voffA); PG8_STAGE(PG8_SB(1, 1), cB + hstep + kstep, voffB);
        PG8_WAIT_V(6); PG8_BAR;
    }
    for (;;) {
        const bool has_next = S.next(ui + 1, nxt);
        const char* nA = has_next ? (const char*)g.A + (size_t)nxt.pm * tstep : cA; const char* nB = has_next ? (const char*)g.Bt + (size_t)nxt.pn * tstep : cB;
        for (int t = 0; t < nt; t += 2) {
            const bool last = (t == nt - 2);
            const char* a1 = cA + (size_t)(t + 1) * kstep;
            const char* a2 = last ? nA : cA + (size_t)(t + 2) * kstep; const char* b2 = last ? nB : cB + (size_t)(t + 2) * kstep;
            const char* a3 = a2 + kstep; const char* b3 = b2 + kstep;
            if (last && has_next) S.a_ready(nxt);
            if constexpr (SP2) {
            PG8_LDB(B0, 0, 0); PG8_LDB(B1, 0, 1); PG8_SCHED; PG8_LDA(At, 0, 0); PG8_STAGE(PG8_SA(1, 1), a1 + hstep, voffA);
            PG8_WAIT_V(8); PG8_WAIT_L(0); PG8_BAR; PG8_MMA(0, 0, At, B0); PG8_MMA(0, 1, At, B1); PG8_BAR; PG8_SCHED;
            PG8_LDA(At, 0, 1); PG8_STAGE(PG8_SB(0, 0), b2, voffB); PG8_STAGE(PG8_SB(0, 1), b2 + hstep, voffB); PG8_STAGE(PG8_SA(0, 0), a2, voffA);
            PG8_WAIT_V(8); PG8_WAIT_L(0); PG8_BAR; PG8_MMA(1, 0, At, B0); PG8_MMA(1, 1, At, B1); PG8_BAR; PG8_SCHED;
            PG8_LDB(B0, 1, 0); PG8_LDB(B1, 1, 1); PG8_SCHED; PG8_LDA(At, 1, 0); PG8_STAGE(PG8_SA(0, 1), a2 + hstep, voffA);
            PG8_WAIT_V(8); PG8_WAIT_L(0); PG8_BAR; PG8_MMA(0, 0, At, B0); PG8_MMA(0, 1, At, B1); PG8_BAR; PG8_SCHED;
            PG8_LDA(At, 1, 1); PG8_STAGE(PG8_SB(1, 0), b3, voffB); PG8_STAGE(PG8_SB(1, 1), b3 + hstep, voffB); PG8_STAGE(PG8_SA(1, 0), a3, voffA);
            PG8_WAIT_V(8); PG8_WAIT_L(0); PG8_BAR; PG8_MMA(1, 0, At, B0); PG8_MMA(1, 1, At, B1); PG8_BAR; PG8_SCHED;
            } else {
            PG8_LDB(B0, 0, 0); PG8_SCHED; PG8_LDA(At, 0, 0); PG8_STAGE(PG8_SA(1, 1), a1 + hstep, voffA);
            PG8_WAIT_L(8); PG8_BAR; PG8_WAIT_L(0); PG8_MMA(0, 0, At, B0); PG8_BAR; PG8_SCHED;
            PG8_LDB(B1, 0, 1); PG8_STAGE(PG8_SB(0, 0), b2, voffB);
            PG8_BAR; PG8_WAIT_L(0); PG8_MMA(0, 1, At, B1); PG8_BAR;
            PG8_LDA(At, 0, 1); PG8_STAGE(PG8_SA(0, 0), a2, voffA);
            PG8_BAR; PG8_WAIT_L(0); PG8_MMA(1, 0, At, B0); PG8_BAR; PG8_SCHED;
            PG8_STAGE(PG8_SB(0, 1), b2 + hstep, voffB);
            PG8_WAIT_V(6); PG8_BAR; PG8_MMA(1, 1, At, B1); PG8_BAR;
            PG8_LDB(B0, 1, 0); PG8_SCHED; PG8_LDA(At, 1, 0); PG8_STAGE(PG8_SA(0, 1), a2 + hstep, voffA);
            PG8_WAIT_L(8); PG8_BAR; PG8_WAIT_L(0); PG8_MMA(0, 0, At, B0); PG8_BAR; PG8_SCHED;
            PG8_LDB(B1, 1, 1); PG8_STAGE(PG8_SB(1, 0), b3, voffB);
            PG8_BAR; PG8_WAIT_L(0); PG8_MMA(0, 1, At, B1); PG8_BAR;
            PG8_LDA(At, 1, 1); PG8_STAGE(PG8_SA(1, 0), a3, voffA);
            PG8_BAR; PG8_WAIT_L(0); PG8_MMA(1, 0, At, B0); PG8_BAR; PG8_SCHED;
            PG8_STAGE(PG8_SB(1, 1), b3 + hstep, voffB);
            PG8_WAIT_V(6); PG8_BAR; PG8_MMA(1, 1, At, B1); PG8_BAR;
            }
        }
        if constexpr (ALIGN_EPI) { if (wr == 0) PG8_BAR; }
        if constexpr (!Epi::AFTER_DRAIN) { E(acc, cur, wr, wc, fr, fq); S.done(cur); }
        if (!has_next) break;
#pragma unroll
        for (int a = 0; a < 2; ++a)
#pragma unroll
            for (int b = 0; b < 2; ++b)
#pragma unroll
                for (int m = 0; m < 4; ++m)
#pragma unroll
                    for (int n = 0; n < 2; ++n) acc[a][b][m][n] = (f32x4){0.f, 0.f, 0.f, 0.f};
        cur = nxt; cA = nA; cB = nB; ++ui;
        if constexpr (ALIGN_EPI) { if (wr == 1) PG8_BAR; }
    }
    PG8_WAIT_V(0);
    if constexpr (!ALIGN_EPI) { if (wr == 0) PG8_BAR; }
    PG8_BAR;
    if constexpr (Epi::AFTER_DRAIN) { E.fused(acc, cur, wr, wc, fr, fq, lds, wid, lane); S.done(cur); }
#undef PG8_SA
#undef PG8_SB
#undef PG8_STAGE
#undef PG8_LDA
#undef PG8_LDB
#undef PG8_MMA
#undef PG8_WAIT_V
#undef PG8_WAIT_L
#undef PG8_BAR
#undef PG8_SCHED
}
}

#define GAS __attribute__((address_space(1)))
#define LAS __attribute__((address_space(3)))
typedef unsigned short bf16;
typedef unsigned v4u __attribute__((ext_vector_type(4)));
typedef unsigned v2u __attribute__((ext_vector_type(2)));
typedef float f32x4 __attribute__((ext_vector_type(4)));
typedef float f32x2 __attribute__((ext_vector_type(2)));
typedef short bf16x8 __attribute__((ext_vector_type(8)));
typedef float f32x16 __attribute__((ext_vector_type(16)));
#define RLX_AGENT __ATOMIC_RELAXED, __HIP_MEMORY_SCOPE_AGENT
#define LDS_WAIT() asm volatile("s_waitcnt lgkmcnt(0)" ::: "memory")
#define VM_WAIT() asm volatile("s_waitcnt vmcnt(0)" ::: "memory")

constexpr int NWAVES = 8, NTHR = 512, GRID = 256;
constexpr int DM = 1024, NB = 8, SEQ = 2048, DEPTH = 4, DB = 128;
constexpr int MP = NB * SEQ;
constexpr int MS = DB;
constexpr int MR = MP + MS;
constexpr int MT = 16640;
constexpr int PIN = 2816, DFF = 2816, UPW = 5632;
constexpr int C_K = 512, C_V = 640, C_QR = 768, C_FR = 1280, C_IR = 1792, C_GR = 2304;
constexpr int NMEM = 256, XH = 4, XHD = 256;
constexpr int WIN = 128, PAST = 8192;
constexpr float EPS = 1e-6f;

constexpr size_t O_YP = 0;
constexpr size_t O_YS = O_YP + (size_t)MP * DM;
constexpr size_t O_WKP = O_YS + (size_t)MS * DM;
constexpr size_t O_WVP = O_WKP + (size_t)DEPTH * NB * 128 * 128;
constexpr size_t O_WKS = O_WVP + (size_t)DEPTH * NB * 128 * 128;
constexpr size_t O_WVS = O_WKS + (size_t)DEPTH * DB * 128;
constexpr size_t O_MKP = O_WVS + (size_t)DEPTH * DB * 128;
constexpr size_t O_MVP = O_MKP + (size_t)DEPTH * NB * NMEM * DM;
constexpr size_t O_HP = O_MVP + (size_t)DEPTH * NB * NMEM * DM;
constexpr size_t O_HS = O_HP + (size_t)DEPTH * NB * 4 * 128 * 128;
constexpr size_t O_CP = O_HS + (size_t)DEPTH * DB * 4 * 128 * 128;
constexpr size_t O_CS = O_CP + (size_t)DEPTH * NB * 2 * UPW;
constexpr size_t O_END = O_CS + (size_t)DEPTH * DB * 2 * UPW;

constexpr size_t MiB = 1u << 20;
constexpr size_t WS_CTL = 0, CTL_ZERO_BYTES = 1 * MiB;
constexpr size_t WS_TAB = 1 * MiB;
constexpr size_t TAB_COS = 0, TAB_SIN = 2049 * 32 * 4, TAB_LB = 2 * 2049 * 32 * 4;
constexpr size_t WS_WIN = 2 * MiB;
constexpr size_t WS_WO = WS_WIN + (size_t)DEPTH * PIN * DM * 2;
constexpr size_t WS_WXQ = WS_WO + (size_t)DEPTH * DM * DM * 2;
constexpr size_t WS_WXKV = WS_WXQ + (size_t)DEPTH * DM * DM * 2;
constexpr size_t WS_WXO = WS_WXKV + (size_t)DEPTH * 2 * DM * DM * 2;
constexpr size_t WS_WUP = WS_WXO + (size_t)DEPTH * DM * DM * 2;
constexpr size_t WS_WDN = WS_WUP + (size_t)DEPTH * UPW * DM * 2;
constexpr size_t WS_X = WS_WDN + (size_t)DEPTH * DM * DFF * 2;
constexpr size_t WS_XN = WS_X + (size_t)MT * DM * 4;
constexpr size_t WS_PROJ = WS_XN + (size_t)MT * DM * 2;
constexpr size_t WS_LF = WS_PROJ + (size_t)MT * PIN * 2;
constexpr size_t WS_MIX = WS_LF + (size_t)MT * 512 * 4;
constexpr size_t WS_Y = WS_MIX + (size_t)MT * DM * 2;
constexpr size_t WS_QX = WS_Y + (size_t)MT * DM * 4;
constexpr size_t WS_OX = WS_QX + (size_t)MT * DM * 2;
constexpr size_t WS_U = WS_OX + (size_t)MT * DM * 2;
constexpr size_t WS_G = WS_U + (size_t)MT * UPW * 2;
constexpr size_t WS_MEMN = WS_G + (size_t)MT * DFF * 2;
constexpr size_t WS_MK = WS_MEMN + (size_t)DEPTH * 2048 * DM * 2;
constexpr size_t WS_MVT = WS_MK + (size_t)DEPTH * 2048 * DM * 2;
constexpr size_t WS_HQ = WS_MVT + (size_t)DEPTH * 2048 * DM * 2;
constexpr size_t WS_HK = WS_HQ + (size_t)NB * 4 * 128 * SEQ * 2;
constexpr size_t WS_HV = WS_HK + (size_t)NB * 4 * 128 * SEQ * 2;
constexpr size_t WS_HLF = WS_HV + (size_t)NB * 4 * 128 * SEQ * 2;
constexpr size_t WS_HQB = WS_HLF + (size_t)NB * 4 * 128 * SEQ * 4;
constexpr size_t WS_HOP = WS_HQB + (size_t)MP * 512 * 2;
constexpr size_t WS_HSL = WS_HOP + (size_t)MP * 512 * 4;
constexpr size_t WS_HDE = WS_HSL + (size_t)256 * 128 * 128 * 4;
constexpr size_t WS_RS = WS_HDE + (size_t)256 * 128 * 4;
constexpr size_t WS_END = WS_RS + (size_t)MT * 4;
static_assert(WS_HK - WS_HQ == (size_t)NB * 4 * 128 * SEQ * 2 && WS_HV - WS_HK == WS_HK - WS_HQ, "HQ | HK | HV consecutive");

constexpr int CW_TMO = 0, CW_CODE = 1;
constexpr int CW_BAR = 4096;

constexpr int RING_OFF = 0, RING_BYTES = 131072;
constexpr int LDSCTL_OFF = RING_BYTES, MISC_OFF = LDSCTL_OFF + 320;
constexpr int LDS_BYTES = 147456;

__device__ __forceinline__ unsigned f2bf(float f) { unsigned u = __builtin_bit_cast(unsigned, f); return (u + 0x7fffu + ((u >> 16) & 1u)) >> 16; }
__device__ __forceinline__ unsigned pk2(float lo, float hi) { return f2bf(lo) | (f2bf(hi) << 16); }
__device__ __forceinline__ float bf2f(unsigned short b) { return __builtin_bit_cast(float, (unsigned)b << 16); }
__device__ __forceinline__ float bflo(unsigned w) { return __builtin_bit_cast(float, w << 16); }
__device__ __forceinline__ float bfhi(unsigned w) { return __builtin_bit_cast(float, w & 0xffff0000u); }
__device__ __forceinline__ float sigmoidf_(float z) { return 1.0f / (1.0f + __expf(-z)); }
__device__ __forceinline__ float siluf_(float z) { return z * __builtin_amdgcn_rcpf(1.0f + __expf(-z)); }
typedef __bf16 bf16x2_t __attribute__((ext_vector_type(2)));
__device__ __forceinline__ unsigned cvtpk(float lo, float hi) { f32x2 v = {lo, hi}; bf16x2_t b = __builtin_convertvector(v, bf16x2_t); return __builtin_bit_cast(unsigned, b); }
#define MFMA32(a, b, c) __builtin_amdgcn_mfma_f32_32x32x16_bf16((a), (b), (c), 0, 0, 0)
#define LDS_BAR() do { asm volatile("s_waitcnt lgkmcnt(0)" ::: "memory"); __builtin_amdgcn_s_barrier(); asm volatile("" ::: "memory"); } while (0)
__device__ __forceinline__ float wave_sum(float v) {
#pragma unroll
    for (int o = 1; o < 64; o <<= 1) v += __shfl_xor(v, o);
    return v;
}
__device__ __forceinline__ float wave_max(float v) {
#pragma unroll
    for (int o = 1; o < 64; o <<= 1) v = fmaxf(v, __shfl_xor(v, o));
    return v;
}

namespace pg8 {
struct EpiF32 {
    static constexpr bool PERM = false, AFTER_DRAIN = false;
    float* O; int ldc;
    __device__ __forceinline__ void operator()(const f32x4 (&acc)[2][2][4][2], const Unit& u, int wr, int wc, int fr, int fq) const {
        const int row0 = u.pm * BM + wr * 64 + fr, col0 = u.pn * BM + wc * 32 + 4 * fq;
#pragma unroll
        for (int ai = 0; ai < 2; ++ai)
#pragma unroll
            for (int m = 0; m < 4; ++m) { float* rowp = O + (size_t)(row0 + ai * HALF + m * 16) * ldc + col0;
#pragma unroll
                for (int bj = 0; bj < 2; ++bj)
#pragma unroll
                    for (int n = 0; n < 2; ++n) *(f32x4*)(rowp + bj * HALF + n * 16) = acc[ai][bj][m][n]; }
    }
};
struct EpiB16 {
    static constexpr bool PERM = true, AFTER_DRAIN = false;
    bf16_t* O; int ldc; float sc; const float* rs;
    __device__ __forceinline__ void operator()(const f32x4 (&acc)[2][2][4][2], const Unit& u, int wr, int wc, int fr, int fq) const {
        const int row0 = u.pm * BM + wr * 64 + fr, col0 = u.pn * BM + wc * 32 + 8 * fq;
#pragma unroll
        for (int ai = 0; ai < 2; ++ai)
#pragma unroll
            for (int m = 0; m < 4; ++m) { const int row = row0 + ai * HALF + m * 16; bf16_t* rowp = O + (size_t)row * ldc + col0; const float s = rs ? sc * rs[row] : sc;
#pragma unroll
                for (int bj = 0; bj < 2; ++bj) { const f32x4 v0 = acc[ai][bj][m][0] * s, v1 = acc[ai][bj][m][1] * s;
                    u32x4 w; w.x = cvt_pk_bf16(v0[0], v0[1]); w.y = cvt_pk_bf16(v0[2], v0[3]); w.z = cvt_pk_bf16(v1[0], v1[1]); w.w = cvt_pk_bf16(v1[2], v1[3]);
                    *(u32x4*)(rowp + bj * HALF) = w; } }
    }
};
struct EpiProj {
    static constexpr bool PERM = true, AFTER_DRAIN = false;
    bf16_t* P; float* LF; const float* lb;
    bf16_t* HQ; bf16_t* HK; bf16_t* HV; float* HLF;
    __device__ __forceinline__ void operator()(const f32x4 (&acc)[2][2][4][2], const Unit& u, int wr, int wc, int fr, int fq) const {
        const int row0 = u.pm * BM + wr * 64 + fr, col0 = u.pn * BM + wc * 32 + 8 * fq;
        const int pn = u.pn;
        const int mode = (pn == 3 || pn == 4 || pn == 9 || pn == 10) ? 1 : ((pn == 5 || pn == 6) ? 2 : 0);
        if (pn >= 3 && pn <= 8 && u.pm < 64) {
            const int grp = (pn - 3) >> 1;
            bf16_t* T16 = HQ + (size_t)grp * ((size_t)NB * 4 * 128 * SEQ);
#pragma unroll
            for (int bj = 0; bj < 2; ++bj) { const int hd = ((pn - 3) & 1) * 2 + bj, k0 = wc * 32 + 8 * fq; const int c = hd * 128 + k0;
                f32x4 l0 = {0.f, 0.f, 0.f, 0.f}, l1 = l0; if (grp == 1) { l0 = *(const f32x4*)(lb + c); l1 = *(const f32x4*)(lb + c + 4); }
#pragma unroll
                for (int ai = 0; ai < 2; ++ai)
#pragma unroll
                    for (int m = 0; m < 4; ++m) { const int row = row0 + ai * HALF + m * 16; const int b_ = row >> 11, t_ = row & 2047;
                        const unsigned base = ((((unsigned)(b_ * 4 + hd) * 32u + (unsigned)(t_ >> 6)) * 4u + (unsigned)((t_ >> 4) & 3)) * 128u + (unsigned)k0) * 16u + (unsigned)(t_ & 15);
#pragma unroll
                        for (int n = 0; n < 2; ++n)
#pragma unroll
                            for (int e = 0; e < 4; ++e) { float z = acc[ai][bj][m][n][e]; const unsigned a = base + (unsigned)(4 * n + e) * 16u;
                                if (grp == 0) { z = z * __builtin_amdgcn_rcpf(1.f + __expf(-z)); T16[a] = (bf16_t)(cvt_pk_bf16(z, 0.f) & 0xffffu); }
                                else if (grp == 2) { T16[a] = (bf16_t)(cvt_pk_bf16(z, 0.f) & 0xffffu); }
                                else { z = fminf(fmaxf(z, -40.f), 40.f); const float lbv = n ? l1[e] : l0[e]; const float ez = __expf(-z);
                                    const float rz = __builtin_amdgcn_rcpf(1.f + ez); const float f = lbv + (1.f - lbv) * rz, kk = (1.f - lbv) * ez * rz;
                                    (void)kk; T16[a] = __builtin_bit_cast(unsigned short, (_Float16)__log2f(f)); } } } }
        } else if (mode == 2) {
#pragma unroll
            for (int bj = 0; bj < 2; ++bj) { const int c = col0 + bj * HALF - 1280;
                const f32x4 l0 = *(const f32x4*)(lb + c), l1 = *(const f32x4*)(lb + c + 4);
#pragma unroll
                for (int ai = 0; ai < 2; ++ai)
#pragma unroll
                    for (int m = 0; m < 4; ++m) { const size_t row = (size_t)(row0 + ai * HALF + m * 16);
                        f32x4 z0 = acc[ai][bj][m][0], z1 = acc[ai][bj][m][1]; f32x4 f0, f1, k0, k1;
#pragma unroll
                        for (int e = 0; e < 4; ++e) { z0[e] = fminf(fmaxf(z0[e], -40.f), 40.f); z1[e] = fminf(fmaxf(z1[e], -40.f), 40.f); }
#pragma unroll
                        for (int e = 0; e < 4; ++e) { const float ez0 = __expf(-z0[e]), ez1 = __expf(-z1[e]);
                            const float r0_ = __builtin_amdgcn_rcpf(1.f + ez0), r1_ = __builtin_amdgcn_rcpf(1.f + ez1);
                            f0[e] = l0[e] + (1.f - l0[e]) * r0_; k0[e] = (1.f - l0[e]) * ez0 * r0_;
                            f1[e] = l1[e] + (1.f - l1[e]) * r1_; k1[e] = (1.f - l1[e]) * ez1 * r1_; }
#pragma unroll
                        for (int e = 0; e < 4; ++e) { f0[e] = __log2f(f0[e]); f1[e] = __log2f(f1[e]); }
                        *(f32x4*)(LF + row * 512 + c) = f0; *(f32x4*)(LF + row * 512 + c + 4) = f1;
                        u32x4 w; w.x = cvt_pk_bf16(k0[0], k0[1]); w.y = cvt_pk_bf16(k0[2], k0[3]); w.z = cvt_pk_bf16(k1[0], k1[1]); w.w = cvt_pk_bf16(k1[2], k1[3]);
                        *(u32x4*)(P + row * PIN + col0 + bj * HALF) = w; } }
        } else {
#pragma unroll
            for (int ai = 0; ai < 2; ++ai)
#pragma unroll
                for (int m = 0; m < 4; ++m) { bf16_t* rowp = P + (size_t)(row0 + ai * HALF + m * 16) * PIN + col0;
#pragma unroll
                    for (int bj = 0; bj < 2; ++bj) { f32x4 v0 = acc[ai][bj][m][0], v1 = acc[ai][bj][m][1];
                        if (mode == 1) {
#pragma unroll
                            for (int e = 0; e < 4; ++e) { v0[e] = v0[e] * __builtin_amdgcn_rcpf(1.f + __expf(-v0[e])); v1[e] = v1[e] * __builtin_amdgcn_rcpf(1.f + __expf(-v1[e])); } }
                        u32x4 w; w.x = cvt_pk_bf16(v0[0], v0[1]); w.y = cvt_pk_bf16(v0[2], v0[3]); w.z = cvt_pk_bf16(v1[0], v1[1]); w.w = cvt_pk_bf16(v1[2], v1[3]);
                        *(u32x4*)(rowp + bj * HALF) = w; } }
        }
    }
};
struct EpiMemKV {
    static constexpr bool PERM = false, AFTER_DRAIN = false;
    float* OK; float* OV; bf16_t* MK; bf16_t* MVT;
    __device__ __forceinline__ void operator()(const f32x4 (&acc)[2][2][4][2], const Unit& u, int wr, int wc, int fr, int fq) const {
        const int layer = u.pm >> 3, pml = u.pm & 7, pnl = u.pn & 7;
        const int row0 = pml * BM + wr * 64 + fr; const int col0 = (pnl & 3) * BM + wc * 32 + 4 * fq;
        if (pnl < 4) {
            float* O = OK + (size_t)layer * 2048 * 1024; bf16_t* B = MK + (size_t)layer * 2048 * 1024;
#pragma unroll
            for (int ai = 0; ai < 2; ++ai)
#pragma unroll
                for (int m = 0; m < 4; ++m) { const size_t off = (size_t)(row0 + ai * HALF + m * 16) * 1024 + col0;
#pragma unroll
                    for (int bj = 0; bj < 2; ++bj)
#pragma unroll
                        for (int n = 0; n < 2; ++n) { const f32x4 v = acc[ai][bj][m][n]; *(f32x4*)(O + off + bj * HALF + n * 16) = v;
                            v2u w; w.x = cvt_pk_bf16(v[0], v[1]); w.y = cvt_pk_bf16(v[2], v[3]); *(v2u*)(B + off + bj * HALF + n * 16) = w; } }
        } else {
            float* O = OV + (size_t)layer * 2048 * 1024; bf16_t* T = MVT + (size_t)layer * 2048 * 1024;
#pragma unroll
            for (int ai = 0; ai < 2; ++ai)
#pragma unroll
                for (int m = 0; m < 4; ++m) { const int row = row0 + ai * HALF + m * 16; const size_t off = (size_t)row * 1024 + col0; const int b_ = row >> 8, mm = row & 255;
#pragma unroll
                    for (int bj = 0; bj < 2; ++bj)
#pragma unroll
                        for (int n = 0; n < 2; ++n) { const f32x4 v = acc[ai][bj][m][n]; *(f32x4*)(O + off + bj * HALF + n * 16) = v;
                            const int c = col0 + bj * HALF + n * 16; const int hd = c >> 8, d = c & 255;
                            bf16_t* tp = T + ((size_t)(b_ * 4 + hd) * 256 + d) * 256 + mm;
                            const unsigned w0 = cvt_pk_bf16(v[0], v[1]), w1 = cvt_pk_bf16(v[2], v[3]);
                            tp[0] = (bf16_t)(w0 & 0xffffu); tp[256] = (bf16_t)(w0 >> 16); tp[512] = (bf16_t)(w1 & 0xffffu); tp[768] = (bf16_t)(w1 >> 16); } }
        }
    }
};
struct BlockDiagOrder {
    int G, c;
    __device__ __forceinline__ bool next(int i, Unit& u) const { const int L = i * G + c; if (L >= 256) return false; const int layer = L >> 6, r = L & 63; u.pm = layer * 8 + (r & 7); u.pn = layer * 8 + (r >> 3); return true; }
    __device__ __forceinline__ void a_ready(const Unit&) const {}
    __device__ __forceinline__ void done(const Unit&) const {}
};
}
#define XB_TMO      128
#define XB_XCNT(j)  (256  + 64 * (j))
#define XB_XSUB(j)  (1280 + 64 * (j))
#define XB_XGEN(j)  (2304 + 64 * (j))
#define XB_TOP      3328
#define XB_TOPGEN   3392
#define XCD_BAR_WORDS 3456
#define XB_SPIN_CAP (1u << 18)

__device__ __forceinline__ unsigned xb_ld(unsigned* p)              { return __hip_atomic_load(p, __ATOMIC_RELAXED, __HIP_MEMORY_SCOPE_AGENT); }
__device__ __forceinline__ unsigned xb_add(unsigned* p, unsigned v) { return __hip_atomic_fetch_add(p, v, __ATOMIC_RELAXED, __HIP_MEMORY_SCOPE_AGENT); }
__device__ __forceinline__ unsigned xb_xcc_id() { return (unsigned)__builtin_amdgcn_s_getreg((3 << 11) | 20) & 0xFu; }
#define XB_SPIN(cond, bar) do { unsigned _sp = 0; while (cond) { __builtin_amdgcn_s_sleep(1); \
    if ((++_sp & 255u) == 0u) { if (xb_ld(&(bar)[XB_TMO])) break; if (_sp > XB_SPIN_CAP) { atomicAdd(&(bar)[XB_TMO], 1u); break; } } } } while (0)

struct XcdBarrier {
    unsigned* bar; unsigned x;
    volatile LAS unsigned* st;
};

__device__ __forceinline__ XcdBarrier xcd_barrier_post(unsigned* bar, volatile LAS unsigned* st) {
    XcdBarrier b; b.bar = bar; b.x = xb_xcc_id(); b.st = st;
    if (threadIdx.x == 0) (void)xb_add(&bar[XB_XCNT(b.x)], 1u);
    return b;
}
__device__ __forceinline__ void xcd_barrier_complete(unsigned* bar, unsigned x, unsigned& nloc, unsigned& nx) {
    const unsigned G = gridDim.x * gridDim.y * gridDim.z;
    unsigned sum, cnt, mine, sp = 0u;
    for (;;) {
        sum = 0u; cnt = 0u; mine = 0u;
#pragma unroll
        for (unsigned j = 0; j < 16; ++j) { const unsigned c = xb_ld(&bar[XB_XCNT(j)]); sum += c; cnt += (c > 0u) ? 1u : 0u; mine = (j == x) ? c : mine; }
        if (sum == G) break;
        __builtin_amdgcn_s_sleep(1);
        if ((++sp & 255u) == 0u) { if (xb_ld(&bar[XB_TMO])) break; if (sp > XB_SPIN_CAP) { atomicAdd(&bar[XB_TMO], 1u); break; } }
    }
    nloc = mine > 0u ? mine : 1u; nx = cnt > 0u ? cnt : 1u;
}

__device__ __forceinline__ void xcd_barrier(const XcdBarrier& b) {
    asm volatile("s_waitcnt vmcnt(0)" ::: "memory");
    __syncthreads();
    if (threadIdx.x == 0) {
        unsigned* bar = b.bar;
        __builtin_amdgcn_s_waitcnt(0);
        unsigned nloc = b.st[0], nx = b.st[1];
        if (nloc == 0u) { xcd_barrier_complete(bar, b.x, nloc, nx); b.st[0] = nloc; b.st[1] = nx; }
        const unsigned old = xb_add(&bar[XB_XSUB(b.x)], 1u);
        const unsigned gen = old / nloc;
        if (old + 1u == (gen + 1u) * nloc) {
            __builtin_amdgcn_fence(__ATOMIC_RELEASE, "agent");
            asm volatile("s_waitcnt vmcnt(0)" ::: "memory");
            const unsigned og = xb_add(&bar[XB_TOP], 1u);
            const unsigned tg = og / nx;
            if (og + 1u == (tg + 1u) * nx) xb_add(&bar[XB_TOPGEN], 1u);
            else XB_SPIN(xb_ld(&bar[XB_TOPGEN]) == tg, bar);
            __builtin_amdgcn_fence(__ATOMIC_ACQUIRE, "agent");
            xb_add(&bar[XB_XGEN(b.x)], 1u);
            asm volatile("s_waitcnt vmcnt(0)" ::: "memory");
        } else {
            XB_SPIN(xb_ld(&bar[XB_XGEN(b.x)]) == gen, bar);
            __builtin_amdgcn_fence(__ATOMIC_ACQUIRE, "agent");
            asm volatile("s_waitcnt vmcnt(0)" ::: "memory");
        }
    }
    __syncthreads();
}

struct Frame {
    LAS unsigned char* lds;
    volatile LAS unsigned* MISC;
    unsigned* ctl;
    int tid, lane, wave, G, gw, ngw, vcu;
    const float* const* in; float* out; unsigned char* ws;
};
#define IN_XP 0
#define IN_XS 1
#define IN_CWK 2
#define IN_CWV 3
#define IN_CMK 4
#define IN_CMV 5
#define IN_SH 6
#define IN_CFC 7
#define IN_MEM 8
#define IN_WIN 9
#define IN_WO 10
#define IN_SINK 11
#define IN_LBL 12
#define IN_HN 13
#define IN_WXQ 14
#define IN_WXK 15
#define IN_WXV 16
#define IN_WXO 17
#define IN_WUP 18
#define IN_CW 19
#define IN_CB 20
#define IN_WDN 21
#define IN_GPM 22
#define IN_GQM 23
#define IN_GPX 24
#define IN_GQX 25
#define IN_GMEM 26
#define IN_GPF 27
#define IN_GQF 28

__device__ __forceinline__ void p0_transpose_item(const float* W, int K, int N, bf16* WT, int row_off, LAS float* scr, int item, int lane, const float* gk = nullptr, bf16* WTT = nullptr) {
    const int nblk = N / 32, kb = item / nblk, nb = item % nblk, k0 = 64 * kb, n0 = 32 * nb;
#pragma unroll 8
    for (int i = 0; i < 32; ++i) { const int kk = 2 * i + (lane >> 5); scr[kk * 33 + (lane & 31)] = W[(size_t)(k0 + kk) * N + n0 + (lane & 31)]; }
    LDS_WAIT(); asm volatile("" ::: "memory");
    const int c = lane & 7;
    float g8[8];
    if (gk) { const f32x4 a_ = *(const f32x4*)(gk + k0 + 8 * c), b_ = *(const f32x4*)(gk + k0 + 8 * c + 4); g8[0] = a_.x; g8[1] = a_.y; g8[2] = a_.z; g8[3] = a_.w; g8[4] = b_.x; g8[5] = b_.y; g8[6] = b_.z; g8[7] = b_.w; } else {
#pragma unroll
        for (int e = 0; e < 8; ++e) g8[e] = 1.f; }
#pragma unroll
    for (int j = 0; j < 4; ++j) { const int n = (lane >> 3) + 8 * j; const LAS float* s = scr + (8 * c) * 33 + n;
        v4u o; o.x = cvtpk(s[0 * 33] * g8[0], s[1 * 33] * g8[1]); o.y = cvtpk(s[2 * 33] * g8[2], s[3 * 33] * g8[3]); o.z = cvtpk(s[4 * 33] * g8[4], s[5 * 33] * g8[5]); o.w = cvtpk(s[6 * 33] * g8[6], s[7 * 33] * g8[7]);
        *(GAS v4u*)(WT + (size_t)(row_off + n0 + n) * K + k0 + 8 * c) = o;
        if (WTT) { const int nn = n0 + n, kk_ = k0 + 8 * c; *(GAS v4u*)(WTT + ((size_t)((nn >> 4) * (K >> 5) + (kk_ >> 5)) * 64 + ((kk_ & 31) >> 3) * 16 + (nn & 15)) * 8) = o; } }
    LDS_WAIT(); asm volatile("" ::: "memory");
}
__device__ __forceinline__ void row_load(const float* p, int lane, f32x4 (&v)[4]) {
    const GAS f32x4* r = (const GAS f32x4*)p + lane;
#pragma unroll
    for (int j = 0; j < 4; ++j) v[j] = r[64 * j];
}
__device__ __forceinline__ float row_ss(const f32x4 (&v)[4]) {
    float s = 0.f;
#pragma unroll
    for (int j = 0; j < 4; ++j) s += (v[j].x * v[j].x + v[j].y * v[j].y) + (v[j].z * v[j].z + v[j].w * v[j].w);
    return wave_sum(s);
}
__device__ __forceinline__ void row_store_bf16(bf16* p, int lane, const f32x4 (&v)[4]) {
    GAS unsigned long long* o8 = (GAS unsigned long long*)p + lane;
#pragma unroll
    for (int j = 0; j < 4; ++j) o8[64 * j] = (unsigned long long)pk2(v[j].x, v[j].y) | ((unsigned long long)pk2(v[j].z, v[j].w) << 32);
}
__device__ __forceinline__ void row_store_f32(float* p, int lane, const f32x4 (&v)[4]) {
    GAS f32x4* r = (GAS f32x4*)p + lane;
#pragma unroll
    for (int j = 0; j < 4; ++j) r[64 * j] = v[j];
}

__device__ __forceinline__ void p0_prologue(Frame& F) {
    LAS float* scr = (LAS float*)(F.lds + RING_OFF + F.wave * 16384);
    unsigned char* ws = F.ws;
    constexpr int I_IN = 16 * (PIN / 32), I_SQ = 16 * (DM / 32), I_UP = 16 * (UPW / 32), I_DN = (DFF / 64) * (DM / 32);
    constexpr int I_LAYER = I_IN + 5 * I_SQ + I_UP + I_DN;
    for (int it = F.gw; it < DEPTH * I_LAYER; it += F.ngw) {
        const int l = it / I_LAYER; int r = it % I_LAYER;
        if (r < I_IN) { p0_transpose_item(F.in[IN_WIN] + (size_t)l * DM * PIN, DM, PIN, (bf16*)(ws + WS_WIN) + (size_t)l * PIN * DM, 0, scr, r, F.lane); continue; } r -= I_IN;
        if (r < I_SQ) { p0_transpose_item(F.in[IN_WO] + (size_t)l * DM * DM, DM, DM, (bf16*)(ws + WS_WO) + (size_t)l * DM * DM, 0, scr, r, F.lane); continue; } r -= I_SQ;
        if (r < I_SQ) { p0_transpose_item(F.in[IN_WXQ] + (size_t)l * DM * DM, DM, DM, (bf16*)(ws + WS_WXQ) + (size_t)l * DM * DM, 0, scr, r, F.lane, F.in[IN_GPX] + l * DM); continue; } r -= I_SQ;
        if (r < I_SQ) { p0_transpose_item(F.in[IN_WXK] + (size_t)l * DM * DM, DM, DM, (bf16*)(ws + WS_WXKV) + (size_t)l * 2 * DM * DM, 0, scr, r, F.lane); continue; } r -= I_SQ;
        if (r < I_SQ) { p0_transpose_item(F.in[IN_WXV] + (size_t)l * DM * DM, DM, DM, (bf16*)(ws + WS_WXKV) + (size_t)l * 2 * DM * DM, DM, scr, r, F.lane); continue; } r -= I_SQ;
        if (r < I_SQ) { p0_transpose_item(F.in[IN_WXO] + (size_t)l * DM * DM, DM, DM, (bf16*)(ws + WS_WXO) + (size_t)l * DM * DM, 0, scr, r, F.lane); continue; } r -= I_SQ;
        if (r < I_UP) { p0_transpose_item(F.in[IN_WUP] + (size_t)l * DM * UPW, DM, UPW, (bf16*)(ws + WS_WUP) + (size_t)l * UPW * DM, 0, scr, r, F.lane, F.in[IN_GPF] + l * DM); continue; } r -= I_UP;
        p0_transpose_item(F.in[IN_WDN] + (size_t)l * DFF * DM, DFF, DM, (bf16*)(ws + WS_WDN) + (size_t)l * DM * DFF, 0, scr, r, F.lane);
    }
    {
        f32x4 g[4]; row_load(F.in[IN_GPM], F.lane, g);
        for (int m = F.gw; m < MR; m += F.ngw) {
            const float* src = (m < MP) ? F.in[IN_XP] + (size_t)m * DM : F.in[IN_XS] + (size_t)(m - MP) * DM;
            f32x4 v[4]; row_load(src, F.lane, v);
            row_store_bf16((bf16*)(ws + WS_X) + (size_t)m * DM, F.lane, v);
            const float r = rsqrtf(row_ss(v) * (1.f / DM) + EPS);
#pragma unroll
            for (int j = 0; j < 4; ++j) v[j] = v[j] * r * g[j];
            row_store_bf16((bf16*)(ws + WS_XN) + (size_t)m * DM, F.lane, v);
        }
    }
    for (int m = F.gw; m < NB * NMEM; m += F.ngw) {
        f32x4 v[4]; row_load(F.in[IN_MEM] + (size_t)m * DM, F.lane, v);
        const float r = rsqrtf(row_ss(v) * (1.f / DM) + EPS);
        for (int l = 0; l < DEPTH; ++l) { f32x4 g[4], o[4]; row_load(F.in[IN_GMEM] + (size_t)l * DM, F.lane, g);
#pragma unroll
            for (int j = 0; j < 4; ++j) o[j] = v[j] * r * g[j];
            row_store_bf16((bf16*)(ws + WS_MEMN) + ((size_t)l * 2048 + m) * DM, F.lane, o); }
    }
    {
        float* cs = (float*)(ws + WS_TAB + TAB_COS); float* sn = (float*)(ws + WS_TAB + TAB_SIN); float* lbt = (float*)(ws + WS_TAB + TAB_LB);
        const int gt = blockIdx.x * NTHR + F.tid; constexpr int nt = GRID * NTHR;
        for (int i = gt; i < 2049 * 32; i += nt) { const int p = i >> 5, d = i & 31; const double pos = (p == 2048) ? (double)PAST : (double)p;
            const double inv = pow(10000.0, -(double)d / 32.0); const double a = pos * inv; cs[i] = (float)cos(a); sn[i] = (float)sin(a); }
        for (int c = gt; c < 512; c += nt) { float z[DEPTH], mx = -1e30f;
            for (int l = 0; l < DEPTH; ++l) { z[l] = F.in[IN_LBL][l * 512 + c]; mx = fmaxf(mx, z[l]); }
            float s = 0.f; for (int l = 0; l < DEPTH; ++l) { z[l] = expf(z[l] - mx); s += z[l]; }
            float cum = 0.f, c0 = 0.f; for (int l = 0; l < DEPTH; ++l) { cum += z[l] / s; if (l == 0) c0 = cum; lbt[l * 512 + c] = cum - c0; } }
    }
}

__device__ __forceinline__ void row_load_bf16(const bf16* p, int lane, f32x4 (&v)[4]) {
    const GAS v2u* r = (const GAS v2u*)p + lane;
#pragma unroll
    for (int j = 0; j < 4; ++j) { const v2u w = r[64 * j]; v[j] = (f32x4){bflo(w.x), bfhi(w.x), bflo(w.y), bfhi(w.y)}; }
}
__device__ __forceinline__ void norm_row(Frame& F, int m, f32x4 (&y)[4], f32x4 (&x)[4], const f32x4 (&gq)[4], const f32x4 (&gp)[4], bool final_, bool xn_) {
    unsigned char* ws = F.ws;
    const float r = rsqrtf(row_ss(y) * (1.f / DM) + EPS);
#pragma unroll
    for (int j = 0; j < 4; ++j) x[j] = x[j] + y[j] * r * gq[j];
    if (final_) { float* o = (m < MP) ? F.out + O_YP + (size_t)m * DM : F.out + O_YS + (size_t)(m - MP) * DM; row_store_f32(o, F.lane, x); }
    else {
        row_store_bf16((bf16*)(ws + WS_X) + (size_t)m * DM, F.lane, x);
        const float r2 = rsqrtf(row_ss(x) * (1.f / DM) + EPS);
        if (xn_) {
#pragma unroll
            for (int j = 0; j < 4; ++j) x[j] = x[j] * r2 * gp[j];
            row_store_bf16((bf16*)(ws + WS_XN) + (size_t)m * DM, F.lane, x);
        } else if (F.lane == 0) ((float*)(ws + WS_RS))[m] = r2;
    }
}
__device__ __forceinline__ void norm_phase(Frame& F, const float* gpost, const float* gpre, bool final_) {
    unsigned char* ws = F.ws;
    f32x4 gq[4], gp[4]; row_load(gpost, F.lane, gq); row_load(gpre ? gpre : gpost, F.lane, gp);
    const bool xn_ = gpre != nullptr;
    const bf16* Y = (const bf16*)(ws + WS_Y); const bf16* X = (const bf16*)(ws + WS_X);
    const int rbeg = F.vcu * 65, rend = (rbeg + 65 < MR) ? rbeg + 65 : MR;
    for (int m = rbeg + F.wave; m < rend; m += 16) {
        const int m2 = m + 8; const bool two = m2 < rend;
        f32x4 y0[4], x0[4], y1[4], x1[4];
        row_load_bf16(Y + (size_t)m * DM, F.lane, y0); row_load_bf16(X + (size_t)m * DM, F.lane, x0);
        if (two) { row_load_bf16(Y + (size_t)m2 * DM, F.lane, y1); row_load_bf16(X + (size_t)m2 * DM, F.lane, x1); }
        norm_row(F, m, y0, x0, gq, gp, final_, xn_);
        if (two) norm_row(F, m2, y1, x1, gq, gp, final_, xn_);
    }
}

__device__ __forceinline__ void unpack8(const v4u w, float (&f)[8]) {
    f[0] = bflo(w.x); f[1] = bfhi(w.x); f[2] = bflo(w.y); f[3] = bfhi(w.y); f[4] = bflo(w.z); f[5] = bfhi(w.z); f[6] = bflo(w.w); f[7] = bfhi(w.w);
}
__device__ __forceinline__ void load8f(const float* p, float (&f)[8]) { const f32x4 a = *(const f32x4*)p, b = *(const f32x4*)(p + 4); f[0] = a.x; f[1] = a.y; f[2] = a.z; f[3] = a.w; f[4] = b.x; f[5] = b.y; f[6] = b.z; f[7] = b.w; }

__device__ __forceinline__ void conv_phase(Frame& F, int l) {
    unsigned char* ws = F.ws;
    const bf16* U = (const bf16*)(ws + WS_U); bf16* Gb = (bf16*)(ws + WS_G);
    const float* cw = F.in[IN_CW] + (size_t)l * 3 * UPW; const float* cb = F.in[IN_CB] + (size_t)l * UPW;
    const float* cfc = F.in[IN_CFC] + (size_t)l * DB * 2 * UPW;
    const int gt = blockIdx.x * NTHR + F.tid; constexpr int nthr = GRID * NTHR;
    constexpr int NCG = DFF / 8;
    constexpr int RG = 8;
    constexpr int N_P = (MP / RG) * NCG, N_S = MS * NCG;
    constexpr int PER_BLK = (MP / RG / GRID) * NCG;
    for (int j = F.tid; j < PER_BLK + (N_S + GRID - 1) / GRID; j += NTHR) {
        const bool samp = j >= PER_BLK;
        int rg, cg;
        if (!samp) { rg = F.vcu * (MP / RG / GRID) + j / NCG; cg = j % NCG; }
        else { const int is_ = (j - PER_BLK) * GRID + (int)blockIdx.x; if (is_ >= N_S) continue; rg = is_ / NCG; cg = is_ % NCG; }
        const int c0 = cg * 8;
        float wa[3][8], wb[3][8], ba[8], bb[8];
#pragma unroll
        for (int j = 0; j < 3; ++j) { load8f(cw + j * UPW + c0, wa[j]); load8f(cw + j * UPW + DFF + c0, wb[j]); }
        load8f(cb + c0, ba); load8f(cb + DFF + c0, bb);
        if (samp) {
            const int m0 = MP + rg; const float* c = cfc + (size_t)rg * 2 * UPW;
            float a2[8], a1[8], b2[8], b1[8], a0[8], b0[8];
            load8f(c + c0, a2); load8f(c + DFF + c0, b2); load8f(c + UPW + c0, a1); load8f(c + UPW + DFF + c0, b1);
            unpack8(*(const v4u*)(U + (size_t)m0 * UPW + c0), a0); unpack8(*(const v4u*)(U + (size_t)m0 * UPW + DFF + c0), b0);
            float o[8];
#pragma unroll
            for (int e = 0; e < 8; ++e) { const float a = ba[e] + wa[0][e] * a2[e] + wa[1][e] * a1[e] + wa[2][e] * a0[e]; const float b = bb[e] + wb[0][e] * b2[e] + wb[1][e] * b1[e] + wb[2][e] * b0[e]; o[e] = siluf_(a) * b; }
            *(v4u*)(Gb + (size_t)m0 * DFF + c0) = (v4u){cvtpk(o[0], o[1]), cvtpk(o[2], o[3]), cvtpk(o[4], o[5]), cvtpk(o[6], o[7])};
        } else {
            const int m0 = rg * RG; const bool first = (m0 % SEQ) == 0;
            v4u ra[RG + 2], rb[RG + 2];
#pragma unroll
            for (int r = 0; r < RG + 2; ++r) { const int mm = (first && r < 2) ? m0 : m0 + r - 2;
                ra[r] = *(const v4u*)(U + (size_t)mm * UPW + c0); rb[r] = *(const v4u*)(U + (size_t)mm * UPW + DFF + c0); }
            if (first) { ra[0] = (v4u){0u, 0u, 0u, 0u}; ra[1] = ra[0]; rb[0] = ra[0]; rb[1] = ra[0]; }
            float a2[8], a1[8], b2[8], b1[8];
            unpack8(ra[0], a2); unpack8(ra[1], a1); unpack8(rb[0], b2); unpack8(rb[1], b1);
#pragma unroll
            for (int r = 0; r < RG; ++r) {
                float a0[8], b0[8], o[8]; unpack8(ra[r + 2], a0); unpack8(rb[r + 2], b0);
#pragma unroll
                for (int e = 0; e < 8; ++e) { const float a = ba[e] + wa[0][e] * a2[e] + wa[1][e] * a1[e] + wa[2][e] * a0[e]; const float b = bb[e] + wb[0][e] * b2[e] + wb[1][e] * b1[e] + wb[2][e] * b0[e];
                    o[e] = siluf_(a) * b; a2[e] = a1[e]; a1[e] = a0[e]; b2[e] = b1[e]; b1[e] = b0[e]; }
                *(v4u*)(Gb + (size_t)(m0 + r) * DFF + c0) = (v4u){cvtpk(o[0], o[1]), cvtpk(o[2], o[3]), cvtpk(o[4], o[5]), cvtpk(o[6], o[7])};
            }
        }
    }
    float* ocp = F.out + O_CP + (size_t)l * NB * 2 * UPW; float* ocs = F.out + O_CS + (size_t)l * DB * 2 * UPW;
    for (int i = gt; i < NB * 2 * UPW; i += nthr) { const int b = i / (2 * UPW), j = (i / UPW) % 2, c = i % UPW; ocp[i] = bf2f(U[(size_t)(b * SEQ + SEQ - 2 + j) * UPW + c]); }
    for (int i = gt; i < DB * 2 * UPW; i += nthr) { const int s = i / (2 * UPW), j = (i / UPW) % 2, c = i % UPW;
        ocs[i] = (j == 0) ? cfc[(size_t)s * 2 * UPW + UPW + c] : bf2f(U[(size_t)(MP + s) * UPW + c]); }
}

__device__ __forceinline__ void xattn_unit_sample(Frame& F, int l, int s, int h) {
    unsigned char* ws = F.ws; const bf16* QX = (const bf16*)(ws + WS_QX); bf16* OX = (bf16*)(ws + WS_OX);
    const int lane = F.lane, wave = F.wave, m = MP + s;
    LAS float* scl = (LAS float*)(F.lds + RING_OFF); LAS float* part = scl + 256;
    const v2u qw = *(const v2u*)(QX + (size_t)m * DM + h * 256 + 4 * lane);
    const f32x4 q = {bflo(qw.x), bfhi(qw.x), bflo(qw.y), bfhi(qw.y)};
    const GAS f32x4* CK = (const GAS f32x4*)(F.in[IN_CMK] + ((size_t)(l * DB + s) * 256 + 32 * wave) * DM + h * 256) + lane;
    const GAS f32x4* CV = (const GAS f32x4*)(F.in[IN_CMV] + ((size_t)(l * DB + s) * 256 + 32 * wave) * DM + h * 256) + lane;
    LDS_BAR();
    {
        f32x4 k[32];
#pragma unroll
        for (int i = 0; i < 32; ++i) k[i] = CK[(size_t)i * (DM / 4)];
#pragma unroll
        for (int i = 0; i < 32; ++i) { const float d = wave_sum((k[i].x * q.x + k[i].y * q.y) + (k[i].z * q.z + k[i].w * q.w)); if (lane == 0) scl[32 * wave + i] = d; }
    }
    f32x4 v[32];
#pragma unroll
    for (int i = 0; i < 32; ++i) v[i] = CV[(size_t)i * (DM / 4)];
    LDS_BAR();
    float mx, inv;
    { const float s0 = scl[lane], s1 = scl[64 + lane], s2 = scl[128 + lane], s3 = scl[192 + lane];
      mx = wave_max(fmaxf(fmaxf(s0, s1), fmaxf(s2, s3)));
      inv = 1.f / wave_sum((exp2f(s0 - mx) + exp2f(s1 - mx)) + (exp2f(s2 - mx) + exp2f(s3 - mx))); }
    f32x4 o = {0.f, 0.f, 0.f, 0.f};
#pragma unroll
    for (int i = 0; i < 32; ++i) { const float p = exp2f(scl[32 * wave + i] - mx); o = o + v[i] * p; }
    *(LAS f32x4*)(part + wave * 256 + 4 * lane) = o;
    LDS_BAR();
    if (F.tid < 256) { float t = 0.f;
#pragma unroll
        for (int w = 0; w < 8; ++w) t += part[w * 256 + F.tid];
        OX[(size_t)m * DM + h * 256 + F.tid] = (bf16)(cvtpk(t * inv, 0.f) & 0xffffu); }
}

__device__ __forceinline__ void hgrn_unit_sample(Frame& F, int l, int s) {
    unsigned char* ws = F.ws; const bf16* P = (const bf16*)(ws + WS_PROJ); bf16* MIX = (bf16*)(ws + WS_MIX); const float* LFp = (const float*)(ws + WS_LF);
    const int lane = F.lane, wave = F.wave, m = MP + s, hd = wave >> 1, kh = wave & 1, vq = lane & 31, kp = lane >> 5;
    LAS float* wl = (LAS float*)(F.lds + RING_OFF + 102400 + wave * 2048);
    LAS f32x4* red = (LAS f32x4*)(F.lds + RING_OFF + 98304);
    LDS_BAR();
    { const int k = 64 * kh + lane; wl[lane] = exp2f(LFp[(size_t)m * 512 + hd * 128 + k]); wl[64 + lane] = bf2f(P[(size_t)m * PIN + C_FR + hd * 128 + k]); wl[128 + lane] = bf2f(P[(size_t)m * PIN + C_QR + hd * 128 + k]); }
    LDS_WAIT(); asm volatile("" ::: "memory");
    const v2u vw = *(const v2u*)(P + (size_t)m * PIN + C_IR + hd * 128 + 4 * vq);
    const f32x4 vv = {bflo(vw.x), bfhi(vw.x), bflo(vw.y), bfhi(vw.y)};
    const size_t sb = (((size_t)(l * DB + s) * 4 + hd) * 128 + 64 * kh) * 128 + 4 * vq;
    const GAS float* S0 = (const GAS float*)F.in[IN_SH] + sb; GAS float* S1 = (GAS float*)F.out + O_HS + sb;
    f32x4 o = {0.f, 0.f, 0.f, 0.f};
#pragma unroll 1
    for (int g = 0; g < 4; ++g) {
        f32x4 s0[8];
#pragma unroll
        for (int i = 0; i < 8; ++i) s0[i] = *(const GAS f32x4*)(S0 + (size_t)(16 * g + 2 * i + kp) * 128);
#pragma unroll
        for (int i = 0; i < 8; ++i) { const int kr = 16 * g + 2 * i + kp; const float f = wl[kr], kk = wl[64 + kr], q = wl[128 + kr];
            const f32x4 s1 = s0[i] * f + vv * kk; *(GAS f32x4*)(S1 + (size_t)kr * 128) = s1; o = o + s1 * q; }
    }
    o.x += __shfl_xor(o.x, 32); o.y += __shfl_xor(o.y, 32); o.z += __shfl_xor(o.z, 32); o.w += __shfl_xor(o.w, 32);
    if (lane < 32) red[wave * 32 + vq] = o;
    LDS_BAR();
    o = red[(2 * hd) * 32 + vq] + red[(2 * hd + 1) * 32 + vq];
    float ss = (o.x * o.x + o.y * o.y) + (o.z * o.z + o.w * o.w);
    ss += __shfl_xor(ss, 1); ss += __shfl_xor(ss, 2); ss += __shfl_xor(ss, 4); ss += __shfl_xor(ss, 8); ss += __shfl_xor(ss, 16);
    const float r = rsqrtf(ss * (1.f / 128.f) + EPS);
    if (kh == 0 && lane < 32) { const f32x4 g4 = *(const f32x4*)(F.in[IN_HN] + l * 512 + hd * 128 + 4 * vq); const v2u gw = *(const v2u*)(P + (size_t)m * PIN + C_GR + hd * 128 + 4 * vq);
        v2u w; w.x = cvtpk(o.x * r * g4.x * bflo(gw.x), o.y * r * g4.y * bfhi(gw.x)); w.y = cvtpk(o.z * r * g4.z * bflo(gw.y), o.w * r * g4.w * bfhi(gw.y));
        *(v2u*)(MIX + (size_t)m * DM + 512 + hd * 128 + 4 * vq) = w; }
}
__device__ __forceinline__ void swa_unit_sample(Frame& F, int l, int s) {
    unsigned char* ws = F.ws; const bf16* P = (const bf16*)(ws + WS_PROJ); bf16* MIX = (bf16*)(ws + WS_MIX);
    const float* cs = (const float*)(ws + WS_TAB + TAB_COS) + 2048 * 32; const float* sn = (const float*)(ws + WS_TAB + TAB_SIN) + 2048 * 32;
    constexpr int RS = 136;
    LAS unsigned char* KL = F.lds + RING_OFF; LAS unsigned char* VL = KL + 128 * RS * 2;
    const int lane = F.lane, h = F.wave, m = MP + s, kvh = h >> 2;
    LAS float* wl = (LAS float*)(F.lds + RING_OFF + 102400 + h * 2048);
    const GAS float* ck = (const GAS float*)F.in[IN_CWK] + (size_t)(l * DB + s) * 128 * 128; const GAS float* cv = (const GAS float*)F.in[IN_CWV] + (size_t)(l * DB + s) * 128 * 128;
    LDS_BAR();
    { f32x4 kx[8], vx[8];
#pragma unroll
      for (int i = 0; i < 8; ++i) { const int ch = F.tid + 512 * i; kx[i] = *(const GAS f32x4*)(ck + (size_t)(ch >> 5) * 128 + 4 * (ch & 31)); vx[i] = *(const GAS f32x4*)(cv + (size_t)(ch >> 5) * 128 + 4 * (ch & 31)); }
#pragma unroll
      for (int i = 0; i < 8; ++i) { const int ch = F.tid + 512 * i; const int off = ((ch >> 5) * RS + 4 * (ch & 31)) * 2;
          *(LAS v2u*)(KL + off) = (v2u){cvtpk(kx[i].x, kx[i].y), cvtpk(kx[i].z, kx[i].w)}; *(LAS v2u*)(VL + off) = (v2u){cvtpk(vx[i].x, vx[i].y), cvtpk(vx[i].z, vx[i].w)}; } }
    float knew = 0.f;
    { const int d = lane & 31; const float c = cs[d], sv = sn[d];
      const float q1 = bf2f(P[(size_t)m * PIN + h * 64 + d]), q2 = bf2f(P[(size_t)m * PIN + h * 64 + 32 + d]);
      const float k1 = bf2f(P[(size_t)m * PIN + C_K + kvh * 64 + d]), k2 = bf2f(P[(size_t)m * PIN + C_K + kvh * 64 + 32 + d]);
      if (lane < 32) { wl[lane] = (q1 * c - q2 * sv) * 0.125f; knew = k1 * c - k2 * sv; } else { wl[lane] = (q2 * c + q1 * sv) * 0.125f; knew = k2 * c + k1 * sv; } }
    const float vnew = bf2f(P[(size_t)m * PIN + C_V + kvh * 64 + lane]);
    if ((h & 3) == 0) { F.out[O_WKS + ((size_t)(l * DB + s) * 2 + kvh) * 64 + lane] = knew; F.out[O_WVS + ((size_t)(l * DB + s) * 2 + kvh) * 64 + lane] = vnew; }
    LDS_BAR();
    const float snew = wave_sum(wl[lane] * knew);
    float sc[2];
#pragma unroll
    for (int i = 0; i < 2; ++i) { const LAS unsigned char* kr = KL + ((lane + 64 * i) * RS + kvh * 64) * 2; float acc = 0.f;
#pragma unroll
        for (int c8 = 0; c8 < 8; ++c8) { float kf[8]; unpack8(*(const LAS v4u*)(kr + 16 * c8), kf);
#pragma unroll
            for (int e = 0; e < 8; ++e) acc += wl[c8 * 8 + e] * kf[e]; }
        sc[i] = acc; }
    const float sink = F.in[IN_SINK][l * 8 + h];
    const float mx = fmaxf(fmaxf(wave_max(fmaxf(sc[0], sc[1])), snew), sink);
    const float p0 = __expf(sc[0] - mx), p1 = __expf(sc[1] - mx), pn = __expf(snew - mx);
    const float den = wave_sum(p0 + p1) + pn + __expf(sink - mx);
    wl[64 + lane] = p0; wl[128 + lane] = p1;
    LDS_WAIT(); asm volatile("" ::: "memory");
    float o = pn * vnew;
    const LAS bf16* vp = (const LAS bf16*)VL + kvh * 64 + lane;
#pragma unroll 8
    for (int j = 0; j < 128; ++j) o += wl[64 + j] * bf2f(vp[j * RS]);
    MIX[(size_t)m * DM + h * 64 + lane] = (bf16)(cvtpk(o / den, 0.f) & 0xffffu);
}

__device__ __forceinline__ void hgrn_pass1(Frame& F, int l, int b, int h, int seg) {
    unsigned char* ws = F.ws; bf16* QB = (bf16*)(ws + WS_HQB); bf16* OP = (bf16*)(ws + WS_HOP);
    constexpr int RSK = 136, RST = 72;
    constexpr int O_QT = 0, O_KT = O_QT + 64 * RSK * 2, O_KTT = O_KT + 64 * RSK * 2, O_VT = O_KTT + 128 * RST * 2, O_SP = O_VT + 128 * RST * 2,
                  O_SEG = O_SP + 128 * RSK * 2, O_EB = O_SEG + 2048, O_EBR = O_EB + 512, O_SSQ = O_EBR + 512, O_ENDL = O_SSQ + 1024;
    static_assert(O_ENDL <= RING_BYTES, "hgrn LDS map");
    LAS unsigned char* L = F.lds + RING_OFF;
    LAS bf16* QT = (LAS bf16*)(L + O_QT); LAS bf16* KT = (LAS bf16*)(L + O_KT);
    LAS float* SEG = (LAS float*)(L + O_SEG); LAS float* EB = (LAS float*)(L + O_EB); LAS float* EBR = (LAS float*)(L + O_EBR);
    const int tid = F.tid, lane = F.lane, wave = F.wave;
    const int vt = wave >> 1, tt = wave & 1;
    int k = tid & 127, sg = tid >> 7, l32 = lane & 31, hh = lane >> 5;
    f32x16 S0, S1;
#pragma unroll
    for (int r = 0; r < 16; ++r) { S0[r] = 0.f; S1[r] = 0.f; }
    float Bseg = 0.f;
    const size_t hb = ((size_t)(b * 4 + h) * 32 * 4 + sg) * 128 * 16 + (size_t)k * 16;
    const bf16* HQp = (const bf16*)(ws + WS_HQ) + hb; const bf16* HKp = (const bf16*)(ws + WS_HK) + hb; const bf16* HVp = (const bf16*)(ws + WS_HV) + hb; const float* HLp = (const float*)(ws + WS_HLF) + hb;
    v4u n_q0, n_q1, n_k0, n_k1, n_v0, n_v1;
#define HG_LOAD_L(cn) do { } while (0)
#define HG_LOAD_QKV(cn) do { const int o_ = 8192 * (cn); n_q0 = *(const v4u*)(HQp + o_); n_q1 = *(const v4u*)(HQp + o_ + 8); n_k0 = *(const v4u*)(HKp + o_); n_k1 = *(const v4u*)(HKp + o_ + 8); \
        n_v0 = *(const v4u*)(HVp + o_); n_v1 = *(const v4u*)(HVp + o_ + 8); } while (0)
    HG_LOAD_L(4 * seg); HG_LOAD_QKV(4 * seg);
    LDS_BAR();
    for (int c = 4 * seg; c < 4 * seg + 4; ++c) {
        const int mb = b * SEQ + c * 64;
        asm volatile("" : "+v"(k), "+v"(sg), "+v"(l32), "+v"(hh));
        float cl[16], q[16], kk[16];
        { float run = 0.f;
#pragma unroll
          for (int j = 0; j < 8; ++j) { const unsigned w_ = j < 4 ? n_k0[j] : n_k1[j - 4];
              const float l0_ = (float)__builtin_bit_cast(_Float16, (unsigned short)(w_ & 0xffffu)), l1_ = (float)__builtin_bit_cast(_Float16, (unsigned short)(w_ >> 16));
              run += l0_; cl[2 * j] = run; kk[2 * j] = 1.f - __builtin_amdgcn_exp2f(l0_); run += l1_; cl[2 * j + 1] = run; kk[2 * j + 1] = 1.f - __builtin_amdgcn_exp2f(l1_); }
          SEG[sg * 128 + k] = run; }
#define HG_UNP(dst, o, V_) do { const v4u u_ = (V_); dst[o] = bflo(u_.x); dst[o + 1] = bfhi(u_.x); dst[o + 2] = bflo(u_.y); dst[o + 3] = bfhi(u_.y); dst[o + 4] = bflo(u_.z); dst[o + 5] = bfhi(u_.z); dst[o + 6] = bflo(u_.w); dst[o + 7] = bfhi(u_.w); } while (0)
        HG_UNP(q, 0, n_q0); HG_UNP(q, 8, n_q1);
#undef HG_UNP
        const v4u vv0 = n_v0, vv1 = n_v1;
        if (c + 1 < 4 * seg + 4) { HG_LOAD_L(c + 1); HG_LOAD_QKV(c + 1); }
        LDS_BAR();
#pragma unroll
        for (int kti = 0; kti < 2; ++kti) { const int kt = 2 * tt + kti;
#pragma unroll
            for (int g = 0; g < 4; ++g) { const int k0 = 32 * kt + 8 * g + 4 * hh;
                const f32x4 r0 = *(const LAS f32x4*)(SEG + k0), r1 = *(const LAS f32x4*)(SEG + 128 + k0);
                const float s0 = kti ? S1[4 * g] : S0[4 * g], s1 = kti ? S1[4 * g + 1] : S0[4 * g + 1], s2 = kti ? S1[4 * g + 2] : S0[4 * g + 2], s3 = kti ? S1[4 * g + 3] : S0[4 * g + 3];
                v2u w; w.x = cvtpk(s0 * __builtin_amdgcn_exp2f(r0.x + r1.x), s1 * __builtin_amdgcn_exp2f(r0.y + r1.y));
                w.y = cvtpk(s2 * __builtin_amdgcn_exp2f(r0.z + r1.z), s3 * __builtin_amdgcn_exp2f(r0.w + r1.w));
                *(LAS v2u*)(L + O_SP + ((32 * vt + l32) * RSK + k0) * 2) = w; } }
        {
            const float t0 = SEG[k], t1 = SEG[128 + k], t2 = SEG[256 + k], t3 = SEG[384 + k];
            const float pre = (sg > 0 ? t0 : 0.f) + (sg > 1 ? t1 : 0.f) + (sg > 2 ? t2 : 0.f);
            const float ref = t0 + t1, blast = ref + t2 + t3;
            unsigned kp[8];
#pragma unroll
            for (int i = 0; i < 16; i += 2) {
                const float b0 = pre + cl[i], b1 = pre + cl[i + 1];
                const float qt0 = q[i] * __builtin_amdgcn_exp2f(b0 - ref), qt1 = q[i + 1] * __builtin_amdgcn_exp2f(b1 - ref);
                const float kt0 = kk[i] * __builtin_amdgcn_exp2f(ref - b0), kt1 = kk[i + 1] * __builtin_amdgcn_exp2f(ref - b1);
                const unsigned wq = cvtpk(qt0, qt1), wk = cvtpk(kt0, kt1), wb = cvtpk(q[i] * __builtin_amdgcn_exp2f(Bseg + b0), q[i + 1] * __builtin_amdgcn_exp2f(Bseg + b1));
                const int t = 16 * sg + i;
                QB[(size_t)(mb + t) * 512 + h * 128 + k] = (bf16)(wb & 0xffffu); QB[(size_t)(mb + t + 1) * 512 + h * 128 + k] = (bf16)(wb >> 16);
                QT[t * RSK + k] = (bf16)(wq & 0xffffu); QT[(t + 1) * RSK + k] = (bf16)(wq >> 16);
                KT[t * RSK + k] = (bf16)(wk & 0xffffu); KT[(t + 1) * RSK + k] = (bf16)(wk >> 16);
                kp[i >> 1] = wk;
            }
            *(LAS v4u*)(L + O_KTT + (k * RST + 16 * sg) * 2) = (v4u){kp[0], kp[1], kp[2], kp[3]};
            *(LAS v4u*)(L + O_KTT + (k * RST + 16 * sg + 8) * 2) = (v4u){kp[4], kp[5], kp[6], kp[7]};
            *(LAS v4u*)(L + O_VT + (k * RST + 16 * sg) * 2) = vv0;
            *(LAS v4u*)(L + O_VT + (k * RST + 16 * sg + 8) * 2) = vv1;
            if (sg == 0) { EB[k] = __builtin_amdgcn_exp2f(blast); EBR[k] = __builtin_amdgcn_exp2f(blast - ref); }
            Bseg += blast;
        }
        LDS_BAR();
        __builtin_amdgcn_sched_barrier(0);
        f32x16 oT;
#pragma unroll
        for (int r = 0; r < 16; ++r) oT[r] = 0.f;
#pragma unroll
        for (int st = 0; st < 2; ++st) {
            if (st <= tt) {
                f32x16 a;
#pragma unroll
                for (int r = 0; r < 16; ++r) a[r] = 0.f;
#pragma unroll
                for (int ks = 0; ks < 8; ++ks) {
                    const bf16x8 A = *(const LAS bf16x8*)(L + O_KT + ((32 * st + l32) * RSK + 16 * ks + 8 * hh) * 2);
                    const bf16x8 B = *(const LAS bf16x8*)(L + O_QT + ((32 * tt + l32) * RSK + 16 * ks + 8 * hh) * 2);
                    a = MFMA32(A, B, a);
                    if (ks & 1) __builtin_amdgcn_sched_barrier(0);
                }
                if (st == tt) {
#pragma unroll
                    for (int r = 0; r < 16; ++r) { const int sl = 8 * (r >> 2) + 4 * hh + (r & 3); if (sl > l32) a[r] = 0.f; }
                }
#pragma unroll
                for (int j = 0; j < 2; ++j) {
                    v4u bp; bp.x = cvtpk(a[8 * j], a[8 * j + 1]); bp.y = cvtpk(a[8 * j + 2], a[8 * j + 3]); bp.z = cvtpk(a[8 * j + 4], a[8 * j + 5]); bp.w = cvtpk(a[8 * j + 6], a[8 * j + 7]);
                    const v2u lo = *(const LAS v2u*)(L + O_VT + ((32 * vt + l32) * RST + 32 * st + 16 * j + 4 * hh) * 2);
                    const v2u hi = *(const LAS v2u*)(L + O_VT + ((32 * vt + l32) * RST + 32 * st + 16 * j + 8 + 4 * hh) * 2);
                    const v4u av = (v4u){lo.x, lo.y, hi.x, hi.y};
                    oT = MFMA32(__builtin_bit_cast(bf16x8, av), __builtin_bit_cast(bf16x8, bp), oT);
                    __builtin_amdgcn_sched_barrier(0);
                }
            }
            __builtin_amdgcn_sched_barrier(0);
        }
#pragma unroll
        for (int ks = 0; ks < 8; ++ks) {
            const bf16x8 A = *(const LAS bf16x8*)(L + O_SP + ((32 * vt + l32) * RSK + 16 * ks + 8 * hh) * 2);
            const bf16x8 B = *(const LAS bf16x8*)(L + O_QT + ((32 * tt + l32) * RSK + 16 * ks + 8 * hh) * 2);
            oT = MFMA32(A, B, oT);
            if (ks & 1) __builtin_amdgcn_sched_barrier(0);
        }
        __builtin_amdgcn_sched_barrier(0);
#pragma unroll
        for (int kti = 0; kti < 2; ++kti) {
            const int kt = 2 * tt + kti;
            f32x16 T;
#pragma unroll
            for (int r = 0; r < 16; ++r) T[r] = 0.f;
#pragma unroll
            for (int ts = 0; ts < 4; ++ts) {
                const bf16x8 A = *(const LAS bf16x8*)(L + O_KTT + ((32 * kt + l32) * RST + 16 * ts + 8 * hh) * 2);
                const bf16x8 B = *(const LAS bf16x8*)(L + O_VT + ((32 * vt + l32) * RST + 16 * ts + 8 * hh) * 2);
                T = MFMA32(A, B, T);
                if (ts & 1) __builtin_amdgcn_sched_barrier(0);
            }
#pragma unroll
            for (int g = 0; g < 4; ++g) {
                const f32x4 eb = *(const LAS f32x4*)(EB + 32 * kt + 8 * g + 4 * hh), ebr = *(const LAS f32x4*)(EBR + 32 * kt + 8 * g + 4 * hh);
#pragma unroll
                for (int e = 0; e < 4; ++e) { if (kti) S1[4 * g + e] = eb[e] * S1[4 * g + e] + ebr[e] * T[4 * g + e]; else S0[4 * g + e] = eb[e] * S0[4 * g + e] + ebr[e] * T[4 * g + e]; }
            }
            __builtin_amdgcn_sched_barrier(0);
        }
        {
            bf16* op = OP + ((size_t)(((b * 4 + h) * 8 + seg) * 4 + (c & 3)) * 8 + wave) * 1024 + (size_t)lane * 4;
#pragma unroll
            for (int g = 0; g < 4; ++g) *(v2u*)(op + 256 * g) = (v2u){cvtpk(oT[4 * g], oT[4 * g + 1]), cvtpk(oT[4 * g + 2], oT[4 * g + 3])};
        }
    }
#undef HG_LOAD_L
#undef HG_LOAD_QKV
    asm volatile("" : "+v"(l32), "+v"(hh));
    const int un = (b * 4 + h) * 8 + seg;
    float* So = (float*)(ws + WS_HSL) + (size_t)un * 128 * 128;
    if (sg == 0) ((float*)(ws + WS_HDE))[un * 128 + k] = __builtin_amdgcn_exp2f(Bseg);
#pragma unroll
    for (int kti = 0; kti < 2; ++kti)
#pragma unroll
        for (int g = 0; g < 4; ++g) *(f32x4*)(So + (size_t)(((wave * 2 + kti) * 4 + g) * 64 + lane) * 4) = kti ? (f32x4){S1[4 * g], S1[4 * g + 1], S1[4 * g + 2], S1[4 * g + 3]} : (f32x4){S0[4 * g], S0[4 * g + 1], S0[4 * g + 2], S0[4 * g + 3]};
    LDS_BAR();
}

__device__ __forceinline__ void hgrn_pass2(Frame& F, int l, int b, int h, int seg) {
    unsigned char* ws = F.ws; const bf16* P = (const bf16*)(ws + WS_PROJ); bf16* MIX = (bf16*)(ws + WS_MIX); const bf16* QB = (const bf16*)(ws + WS_HQB); const bf16* OP = (const bf16*)(ws + WS_HOP);
    constexpr int RSK = 136;
    constexpr int O_SP = 0, O_QB = 128 * RSK * 2, O_SSQ = O_QB + 256 * RSK * 2, O_ENDL = O_SSQ + 4096;
    static_assert(O_ENDL <= RING_BYTES, "hgrn pass 2 LDS map");
    LAS unsigned char* L = F.lds + RING_OFF; LAS float* SSQ = (LAS float*)(L + O_SSQ);
    const int tid = F.tid, lane = F.lane, wave = F.wave, vt = wave >> 1, tt = wave & 1;
    int l32 = lane & 31, hh = lane >> 5;
    const int u0 = (b * 4 + h) * 8, m0 = b * SEQ + seg * 256;
    const float* SL = (const float*)(ws + WS_HSL); const float* DE = (const float*)(ws + WS_HDE);
    f32x16 S0, S1;
    {
        f32x4 w[8], acc[8];
#pragma unroll
        for (int q = 0; q < 8; ++q) { w[q] = (f32x4){1.f, 1.f, 1.f, 1.f}; acc[q] = (f32x4){0.f, 0.f, 0.f, 0.f}; }
#pragma unroll 1
        for (int j = seg - 1; j >= 0; --j) {
            const float* sl = SL + (size_t)(u0 + j) * 128 * 128 + (size_t)(wave * 8 * 64 + lane) * 4;
            f32x4 x[8];
#pragma unroll
            for (int q = 0; q < 8; ++q) x[q] = *(const f32x4*)(sl + (size_t)q * 256);
#pragma unroll
            for (int q = 0; q < 8; ++q) acc[q] = acc[q] + w[q] * x[q];
            if (j > 0) { const float* de = DE + (u0 + j) * 128;
#pragma unroll
                for (int q = 0; q < 8; ++q) w[q] = w[q] * *(const f32x4*)(de + 32 * (2 * tt + (q >> 2)) + 8 * (q & 3) + 4 * hh); }
        }
#pragma unroll
        for (int g = 0; g < 4; ++g) { S0[4 * g] = acc[g].x; S0[4 * g + 1] = acc[g].y; S0[4 * g + 2] = acc[g].z; S0[4 * g + 3] = acc[g].w;
            S1[4 * g] = acc[4 + g].x; S1[4 * g + 1] = acc[4 + g].y; S1[4 * g + 2] = acc[4 + g].z; S1[4 * g + 3] = acc[4 + g].w; }
    }
    v4u qv[8];
    if (seg > 0) {
#pragma unroll
        for (int i = 0; i < 8; ++i) { const int ch = tid + 512 * i; qv[i] = *(const v4u*)(QB + (size_t)(m0 + (ch >> 4)) * 512 + h * 128 + 8 * (ch & 15)); } }
    LDS_BAR();
#pragma unroll
    for (int kti = 0; kti < 2; ++kti) { const int kt = 2 * tt + kti;
#pragma unroll
        for (int g = 0; g < 4; ++g) { const int k0 = 32 * kt + 8 * g + 4 * hh;
            v2u w; w.x = kti ? cvtpk(S1[4 * g], S1[4 * g + 1]) : cvtpk(S0[4 * g], S0[4 * g + 1]); w.y = kti ? cvtpk(S1[4 * g + 2], S1[4 * g + 3]) : cvtpk(S0[4 * g + 2], S0[4 * g + 3]);
            *(LAS v2u*)(L + O_SP + ((32 * vt + l32) * RSK + k0) * 2) = w; } }
    if (seg > 0) {
#pragma unroll
        for (int i = 0; i < 8; ++i) { const int ch = tid + 512 * i; *(LAS v4u*)(L + O_QB + ((ch >> 4) * RSK + 8 * (ch & 15)) * 2) = qv[i]; } }
    if (seg == 7) {
        const float* sl = SL + (size_t)(u0 + 7) * 128 * 128 + (size_t)(wave * 8 * 64 + lane) * 4; const float* de = DE + (u0 + 7) * 128;
        float* So = F.out + O_HP + ((size_t)(l * NB + b) * 4 + h) * 128 * 128 + 32 * vt + l32;
#pragma unroll
        for (int kti = 0; kti < 2; ++kti) { const int kt = 2 * tt + kti;
#pragma unroll
            for (int g = 0; g < 4; ++g) { const int k0 = 32 * kt + 8 * g + 4 * hh; const f32x4 d4 = *(const f32x4*)(de + k0); const f32x4 x4 = *(const f32x4*)(sl + (size_t)(kti * 4 + g) * 256);
#pragma unroll
                for (int e = 0; e < 4; ++e) So[(size_t)(k0 + e) * 128] = d4[e] * (kti ? S1[4 * g + e] : S0[4 * g + e]) + x4[e]; } }
    }
    LDS_BAR();
    asm volatile("" : "+v"(l32), "+v"(hh));
    f32x16 oT[4];
#pragma unroll
    for (int i = 0; i < 4; ++i) {
        { const bf16* op = OP + ((size_t)((u0 + seg) * 4 + i) * 8 + wave) * 1024 + (size_t)lane * 4;
#pragma unroll
          for (int g = 0; g < 4; ++g) { const v2u x = *(const v2u*)(op + 256 * g); oT[i][4 * g] = bflo(x.x); oT[i][4 * g + 1] = bfhi(x.x); oT[i][4 * g + 2] = bflo(x.y); oT[i][4 * g + 3] = bfhi(x.y); } }
        if (seg > 0) {
            LAS unsigned char* spb = L + O_SP + ((32 * vt + l32) * RSK + 8 * hh) * 2; asm volatile("" : "+v"(spb));
            LAS unsigned char* qbb = L + O_QB + ((64 * i + 32 * tt + l32) * RSK + 8 * hh) * 2; asm volatile("" : "+v"(qbb));
#pragma unroll
            for (int ks = 0; ks < 8; ++ks) { const bf16x8 A = *(const LAS bf16x8*)(spb + 32 * ks); const bf16x8 B = *(const LAS bf16x8*)(qbb + 32 * ks); oT[i] = MFMA32(A, B, oT[i]);
                if (ks & 1) __builtin_amdgcn_sched_barrier(0); }
        }
        float ss = 0.f;
#pragma unroll
        for (int r = 0; r < 16; ++r) ss += oT[i][r] * oT[i][r];
        ss += __shfl_xor(ss, 32);
        if (hh == 0) SSQ[vt * 256 + 64 * i + 32 * tt + l32] = ss;
    }
    LDS_BAR();
    const float* gn = F.in[IN_HN] + l * 512 + h * 128;
#pragma unroll
    for (int i = 0; i < 4; ++i) {
        const int tl = 64 * i + 32 * tt + l32;
        const float tot = (SSQ[tl] + SSQ[256 + tl]) + (SSQ[512 + tl] + SSQ[768 + tl]);
        const float rinv = rsqrtf(tot * (1.f / 128.f) + EPS);
#pragma unroll
        for (int g = 0; g < 4; ++g) { const int v0 = 32 * vt + 8 * g + 4 * hh; const f32x4 g4 = *(const f32x4*)(gn + v0);
            v2u w; w.x = cvtpk(oT[i][4 * g] * rinv * g4.x, oT[i][4 * g + 1] * rinv * g4.y); w.y = cvtpk(oT[i][4 * g + 2] * rinv * g4.z, oT[i][4 * g + 3] * rinv * g4.w);
            *(LAS v2u*)(L + O_QB + (tl * RSK + v0) * 2) = w; }
    }
    LDS_BAR();
#pragma unroll
    for (int i = 0; i < 8; ++i) { const int ch = tid + 512 * i, row = ch >> 4, c8 = 8 * (ch & 15);
        float o[8], g[8]; unpack8(*(const LAS v4u*)(L + O_QB + (row * RSK + c8) * 2), o); unpack8(*(const v4u*)(P + (size_t)(m0 + row) * PIN + C_GR + h * 128 + c8), g);
        *(v4u*)(MIX + (size_t)(m0 + row) * DM + 512 + h * 128 + c8) = (v4u){cvtpk(o[0] * g[0], o[1] * g[1]), cvtpk(o[2] * g[2], o[3] * g[3]), cvtpk(o[4] * g[4], o[5] * g[5]), cvtpk(o[6] * g[6], o[7] * g[7])}; }
}

__device__ __forceinline__ void swa_unit_prompt(Frame& F, int l, int b, int kvh, int jb) {
    unsigned char* ws = F.ws; const bf16* P = (const bf16*)(ws + WS_PROJ); bf16* MIX = (bf16*)(ws + WS_MIX);
    const float* cs = (const float*)(ws + WS_TAB + TAB_COS); const float* sn = (const float*)(ws + WS_TAB + TAB_SIN);
    constexpr int RK = 72, RV = 264;
    constexpr int O_KR = 0, O_VT = 256 * RK * 2, O_E = O_VT + 64 * RV * 2;
    static_assert(O_E <= 100 * 1024, "swa LDS map");
    LAS unsigned char* L = F.lds + RING_OFF;
    const int tid = F.tid, lane = F.lane, wave = F.wave;
    const int l32 = lane & 31, hh = lane >> 5;
    const int p0 = jb * 128 - 128;
    LDS_BAR();
#pragma unroll
    for (int i = 0; i < 2; ++i) { const int item = tid + 512 * i, ci = item >> 2, c8 = item & 3, kp = p0 + ci;
        v4u w1 = {0u, 0u, 0u, 0u}, w2 = w1;
        if (kp >= 0) { const bf16* kr = P + (size_t)(b * SEQ + kp) * PIN + C_K + kvh * 64 + c8 * 8;
            float k1[8], k2[8], cc[8], ss[8]; unpack8(*(const v4u*)kr, k1); unpack8(*(const v4u*)(kr + 32), k2); load8f(cs + kp * 32 + c8 * 8, cc); load8f(sn + kp * 32 + c8 * 8, ss);
            float r1[8], r2[8];
#pragma unroll
            for (int e = 0; e < 8; ++e) { r1[e] = k1[e] * cc[e] - k2[e] * ss[e]; r2[e] = k2[e] * cc[e] + k1[e] * ss[e]; }
            w1 = (v4u){cvtpk(r1[0], r1[1]), cvtpk(r1[2], r1[3]), cvtpk(r1[4], r1[5]), cvtpk(r1[6], r1[7])};
            w2 = (v4u){cvtpk(r2[0], r2[1]), cvtpk(r2[2], r2[3]), cvtpk(r2[4], r2[5]), cvtpk(r2[6], r2[7])};
            if (jb == SEQ / 128 - 1 && ci >= 128) { float* ok = F.out + O_WKP + (((size_t)(l * NB + b) * 128 + (ci - 128)) * 2 + kvh) * 64 + c8 * 8;
                *(f32x4*)ok = (f32x4){r1[0], r1[1], r1[2], r1[3]}; *(f32x4*)(ok + 4) = (f32x4){r1[4], r1[5], r1[6], r1[7]};
                *(f32x4*)(ok + 32) = (f32x4){r2[0], r2[1], r2[2], r2[3]}; *(f32x4*)(ok + 36) = (f32x4){r2[4], r2[5], r2[6], r2[7]}; } }
        *(LAS v4u*)(L + O_KR + (ci * RK + c8 * 8) * 2) = w1; *(LAS v4u*)(L + O_KR + (ci * RK + 32 + c8 * 8) * 2) = w2; }
    { const int d = tid & 63, kg = tid >> 6;
#pragma unroll
      for (int q4 = 0; q4 < 4; ++q4) { unsigned w[4];
#pragma unroll
          for (int e = 0; e < 4; ++e) { const int ci = 32 * kg + 8 * q4 + 2 * e, kp = p0 + ci; unsigned short a = 0, c = 0;
              if (kp >= 0) { a = P[(size_t)(b * SEQ + kp) * PIN + C_V + kvh * 64 + d]; c = P[(size_t)(b * SEQ + kp + 1) * PIN + C_V + kvh * 64 + d];
                  if (jb == SEQ / 128 - 1 && ci >= 128) { float* ov = F.out + O_WVP + (((size_t)(l * NB + b) * 128 + (ci - 128)) * 2 + kvh) * 64 + d; ov[0] = bf2f(a); ov[128] = bf2f(c); } }
              w[e] = (unsigned)a | ((unsigned)c << 16); }
          *(LAS v4u*)(L + O_VT + (d * RV + 32 * kg + 8 * q4) * 2) = (v4u){w[0], w[1], w[2], w[3]}; } }
    LDS_BAR();
    const int g = wave >> 1, h = kvh * 4 + g;
    const float sink2 = F.in[IN_SINK][l * 8 + h] * 1.4426950408889634f;
#pragma unroll 1
    for (int s = 0; s < 2; ++s) {
        const int r0 = 64 * (wave & 1) + 32 * s;
        const int t = jb * 128 + r0 + l32;
        bf16x8 qf[4];
        { const bf16* qr = P + (size_t)(b * SEQ + t) * PIN + h * 64 + 8 * hh;
          float x[4][8]; unpack8(*(const v4u*)qr, x[0]); unpack8(*(const v4u*)(qr + 16), x[1]); unpack8(*(const v4u*)(qr + 32), x[2]); unpack8(*(const v4u*)(qr + 48), x[3]);
          const float qs = 0.125f * 1.4426950408889634f;
#pragma unroll
          for (int ks = 0; ks < 2; ++ks) { float cc[8], ss[8]; load8f(cs + t * 32 + 16 * ks + 8 * hh, cc); load8f(sn + t * 32 + 16 * ks + 8 * hh, ss); float r1[8], r2[8];
#pragma unroll
              for (int e = 0; e < 8; ++e) { r1[e] = (x[ks][e] * cc[e] - x[ks + 2][e] * ss[e]) * qs; r2[e] = (x[ks + 2][e] * cc[e] + x[ks][e] * ss[e]) * qs; }
              qf[ks] = __builtin_bit_cast(bf16x8, (v4u){cvtpk(r1[0], r1[1]), cvtpk(r1[2], r1[3]), cvtpk(r1[4], r1[5]), cvtpk(r1[6], r1[7])});
              qf[ks + 2] = __builtin_bit_cast(bf16x8, (v4u){cvtpk(r2[0], r2[1]), cvtpk(r2[2], r2[3]), cvtpk(r2[4], r2[5]), cvtpk(r2[6], r2[7])}); } }
        f32x16 sc[5];
#pragma unroll
        for (int kt = 0; kt < 5; ++kt) {
#pragma unroll
            for (int r = 0; r < 16; ++r) sc[kt][r] = 0.f;
#pragma unroll
            for (int ks = 0; ks < 4; ++ks) { const bf16x8 A = *(const LAS bf16x8*)(L + O_KR + ((r0 + 32 * kt + l32) * RK + 16 * ks + 8 * hh) * 2); sc[kt] = MFMA32(A, qf[ks], sc[kt]); }
            __builtin_amdgcn_sched_barrier(0);
        }
        const int kt_lo = (jb == 0) ? 4 - (r0 >> 5) : 0;
        float mx = sink2;
#pragma unroll
        for (int kt = 0; kt < 5; ++kt)
#pragma unroll
            for (int r = 0; r < 16; ++r) { const int kl = 8 * (r >> 2) + 4 * hh + (r & 3);
                bool ok = kt >= kt_lo; if (kt == 0) ok = ok && (kl >= l32); if (kt == 4) ok = ok && (kl <= l32);
                const float v = ok ? sc[kt][r] : -INFINITY; sc[kt][r] = v; mx = fmaxf(mx, v); }
        mx = fmaxf(mx, __shfl_xor(mx, 32));
        float sum = 0.f;
#pragma unroll
        for (int kt = 0; kt < 5; ++kt)
#pragma unroll
            for (int r = 0; r < 16; ++r) { const float p = __builtin_amdgcn_exp2f(sc[kt][r] - mx); sc[kt][r] = p; sum += p; }
        sum += __shfl_xor(sum, 32);
        const float inv = 1.f / (sum + __builtin_amdgcn_exp2f(sink2 - mx));
        f32x16 o[2];
#pragma unroll
        for (int dt = 0; dt < 2; ++dt) {
#pragma unroll
            for (int r = 0; r < 16; ++r) o[dt][r] = 0.f; }
#pragma unroll
        for (int kt = 0; kt < 5; ++kt) {
#pragma unroll
            for (int j = 0; j < 2; ++j) {
                const v4u bp = {cvtpk(sc[kt][8 * j], sc[kt][8 * j + 1]), cvtpk(sc[kt][8 * j + 2], sc[kt][8 * j + 3]), cvtpk(sc[kt][8 * j + 4], sc[kt][8 * j + 5]), cvtpk(sc[kt][8 * j + 6], sc[kt][8 * j + 7])};
#pragma unroll
                for (int dt = 0; dt < 2; ++dt) {
                    const v2u lo = *(const LAS v2u*)(L + O_VT + ((32 * dt + l32) * RV + r0 + 32 * kt + 16 * j + 4 * hh) * 2);
                    const v2u hi = *(const LAS v2u*)(L + O_VT + ((32 * dt + l32) * RV + r0 + 32 * kt + 16 * j + 8 + 4 * hh) * 2);
                    o[dt] = MFMA32(__builtin_bit_cast(bf16x8, (v4u){lo.x, lo.y, hi.x, hi.y}), __builtin_bit_cast(bf16x8, bp), o[dt]);
                }
            }
            __builtin_amdgcn_sched_barrier(0);
        }
        bf16* orow = MIX + (size_t)(b * SEQ + t) * DM + h * 64 + 4 * hh;
#pragma unroll
        for (int dt = 0; dt < 2; ++dt)
#pragma unroll
            for (int g4 = 0; g4 < 4; ++g4) { v2u w; w.x = cvtpk(o[dt][4 * g4] * inv, o[dt][4 * g4 + 1] * inv); w.y = cvtpk(o[dt][4 * g4 + 2] * inv, o[dt][4 * g4 + 3] * inv);
                *(v2u*)(orow + 32 * dt + 8 * g4) = w; }
    }
}

#define MFMA16(a, b, c) __builtin_amdgcn_mfma_f32_16x16x32_bf16((a), (b), (c), 0, 0, 0)
__device__ __forceinline__ void xattn_unit_prompt(Frame& F, int l, int b, int h, int qb) {
    unsigned char* ws = F.ws; const bf16* QX = (const bf16*)(ws + WS_QX); bf16* OX = (bf16*)(ws + WS_OX);
    const bf16* MK = (const bf16*)(ws + WS_MK) + ((size_t)l * 2048 + b * 256) * DM + h * 256;
    const bf16* MVT = (const bf16*)(ws + WS_MVT) + ((size_t)((l * NB + b) * 4 + h) * 256) * 256;
    constexpr int RKX = 264, RVX = 68;
    constexpr int TILE_K = 64 * RKX * 2, TILE_V = 256 * RVX * 2;
    static_assert(2 * TILE_V <= 100 * 1024, "xattn LDS map");
    LAS unsigned char* L = F.lds + RING_OFF;
    const int tid = F.tid, lane = F.lane, wave = F.wave;
    const int l32 = lane & 31, hh = lane >> 5;
    const int row = b * SEQ + qb * 256 + wave * 32 + l32;
    bf16x8 qf[16];
    { const bf16* qr = QX + (size_t)row * DM + h * 256 + 8 * hh;
#pragma unroll
      for (int ks = 0; ks < 16; ++ks) qf[ks] = *(const bf16x8*)(qr + 16 * ks); }
    v4u pre[2];
    bf16x8 pf[16];
    float tmx[4], runM = -INFINITY, runL = 0.f;
    unsigned koff[4];
#pragma unroll
    for (int j_ = 0; j_ < 4; ++j_) { const int ch_ = tid + 512 * j_; koff[j_] = (unsigned)(((ch_ >> 5) * DM + 8 * (ch_ & 31)) * 2); }
#define XK_LOAD(mt, hf) do { const char* kb_ = (const char*)MK + (size_t)(64 * (mt)) * DM * 2; _Pragma("unroll") for (int j_ = 0; j_ < 2; ++j_) pre[j_] = *(const v4u*)(kb_ + koff[2 * (hf) + j_]); } while (0)
#define XK_STORE(buf, hf) do { _Pragma("unroll") for (int j_ = 0; j_ < 2; ++j_) { const int ch_ = tid + 512 * (2 * (hf) + j_); *(LAS v4u*)(L + (buf) * TILE_K + ((ch_ >> 5) * RKX + 8 * (ch_ & 31)) * 2) = pre[j_]; } } while (0)
    LDS_BAR();
    XK_LOAD(0, 0); XK_STORE(0, 0); XK_LOAD(0, 1); XK_STORE(0, 1);
#pragma unroll
    for (int mt = 0; mt < 4; ++mt) {
        LDS_BAR();
        LAS unsigned char* kbp = L + (mt & 1) * TILE_K + (l32 * RKX + 8 * hh) * 2; asm volatile("" : "+v"(kbp));
        f32x16 sc[2];
#pragma unroll
        for (int i = 0; i < 2; ++i) {
            if (mt + 1 < 4) XK_LOAD(mt + 1, i);
#pragma unroll
            for (int r = 0; r < 16; ++r) sc[i][r] = 0.f;
#pragma unroll
            for (int ks = 0; ks < 16; ++ks) { const bf16x8 A = *(const LAS bf16x8*)(kbp + (32 * i * RKX + 16 * ks) * 2); sc[i] = MFMA32(A, qf[ks], sc[i]);
                if ((ks & 3) == 3) __builtin_amdgcn_sched_barrier(0); }
            if (mt + 1 < 4) XK_STORE((mt + 1) & 1, i);
        }
        float m_ = -INFINITY;
#pragma unroll
        for (int i = 0; i < 2; ++i)
#pragma unroll
            for (int r = 0; r < 16; ++r) m_ = fmaxf(m_, sc[i][r]);
        m_ = fmaxf(m_, __shfl_xor(m_, 32));
        float s_ = 0.f;
#pragma unroll
        for (int i = 0; i < 2; ++i) {
#pragma unroll
            for (int r = 0; r < 16; ++r) { const float p = __builtin_amdgcn_exp2f(sc[i][r] - m_); sc[i][r] = p; s_ += p; }
#pragma unroll
            for (int j = 0; j < 2; ++j) pf[4 * mt + 2 * i + j] = __builtin_bit_cast(bf16x8, (v4u){cvtpk(sc[i][8 * j], sc[i][8 * j + 1]), cvtpk(sc[i][8 * j + 2], sc[i][8 * j + 3]), cvtpk(sc[i][8 * j + 4], sc[i][8 * j + 5]), cvtpk(sc[i][8 * j + 6], sc[i][8 * j + 7])});
        }
        tmx[mt] = m_; { const float nM = fmaxf(runM, m_); runL = runL * __builtin_amdgcn_exp2f(runM - nM) + s_ * __builtin_amdgcn_exp2f(m_ - nM); runM = nM; }
    }
#undef XK_LOAD
#undef XK_STORE
    const float mx = runM;
    float sum = runL;
#pragma unroll
    for (int mt = 0; mt < 4; ++mt) { const float scl_ = __builtin_amdgcn_exp2f(tmx[mt] - mx);
#pragma unroll
        for (int f = 0; f < 4; ++f) { const v4u w = __builtin_bit_cast(v4u, pf[4 * mt + f]);
            pf[4 * mt + f] = __builtin_bit_cast(bf16x8, (v4u){cvtpk(bflo(w.x) * scl_, bfhi(w.x) * scl_), cvtpk(bflo(w.y) * scl_, bfhi(w.y) * scl_), cvtpk(bflo(w.z) * scl_, bfhi(w.z) * scl_), cvtpk(bflo(w.w) * scl_, bfhi(w.w) * scl_)}); } }
    sum += __shfl_xor(sum, 32);
    const float inv = 1.f / sum;
    constexpr int TILE_H = 128 * RVX * 2;
    unsigned voff[2];
#pragma unroll
    for (int j_ = 0; j_ < 2; ++j_) { const int ch_ = tid + 512 * j_; voff[j_] = (unsigned)(((ch_ >> 3) * 256 + 8 * (ch_ & 7)) * 2); }
#define XV_LOAD(st) do { const char* vb_ = (const char*)MVT + ((size_t)(128 * ((st) >> 2)) * 256 + 64 * ((st) & 3)) * 2; _Pragma("unroll") for (int j_ = 0; j_ < 2; ++j_) pre[j_] = *(const v4u*)(vb_ + voff[j_]); } while (0)
#define XV_STORE(buf) do { _Pragma("unroll") for (int j_ = 0; j_ < 2; ++j_) { const int ch_ = tid + 512 * j_; LAS unsigned char* d_ = L + (buf) * TILE_H + ((ch_ >> 3) * RVX + 8 * (ch_ & 7)) * 2; *(LAS v2u*)d_ = (v2u){pre[j_].x, pre[j_].y}; *(LAS v2u*)(d_ + 8) = (v2u){pre[j_].z, pre[j_].w}; } } while (0)
    XV_LOAD(0);
    LDS_BAR();
    XV_STORE(0);
    bf16* orow = OX + (size_t)row * DM + h * 256 + 4 * hh;
#pragma unroll
    for (int dh = 0; dh < 2; ++dh) {
        f32x16 o[4];
#pragma unroll
        for (int i = 0; i < 4; ++i)
#pragma unroll
            for (int r = 0; r < 16; ++r) o[i][r] = 0.f;
#pragma unroll
        for (int mt = 0; mt < 4; ++mt) {
            const int st = 4 * dh + mt;
            if (st + 1 < 8) XV_LOAD(st + 1);
            LDS_BAR();
            LAS unsigned char* vbp = L + (st & 1) * TILE_H + (l32 * RVX + 4 * hh) * 2; asm volatile("" : "+v"(vbp));
#pragma unroll
            for (int dt = 0; dt < 4; ++dt) {
#pragma unroll
                for (int k4 = 0; k4 < 4; ++k4) {
                    const v2u lo = *(const LAS v2u*)(vbp + (32 * dt * RVX + 16 * k4) * 2);
                    const v2u hi = *(const LAS v2u*)(vbp + (32 * dt * RVX + 16 * k4 + 8) * 2);
                    o[dt] = MFMA32(__builtin_bit_cast(bf16x8, (v4u){lo.x, lo.y, hi.x, hi.y}), pf[4 * mt + k4], o[dt]);
                }
                __builtin_amdgcn_sched_barrier(0);
            }
            if (st + 1 < 8) XV_STORE((st + 1) & 1);
        }
#pragma unroll
        for (int dt = 0; dt < 4; ++dt)
#pragma unroll
            for (int g = 0; g < 4; ++g) { v2u w; w.x = cvtpk(o[dt][4 * g] * inv, o[dt][4 * g + 1] * inv); w.y = cvtpk(o[dt][4 * g + 2] * inv, o[dt][4 * g + 3] * inv); *(v2u*)(orow + 128 * dh + 32 * dt + 8 * g) = w; }
    }
#undef XV_LOAD
#undef XV_STORE
}

template <int K>
__device__ __forceinline__ void sample_slice_gemm(Frame& F, const bf16* A, const bf16* Wt, float* Yf, bf16* Qb, float sc, const float* rs = nullptr) {
    const int lane = F.lane, l16 = lane & 15, hq = lane >> 4, wave = F.wave;
    const int rg = blockIdx.x & 7, cs = blockIdx.x >> 3;
    constexpr int NKS = (K >> 5) / 8;
    const GAS bf16* ap = (const GAS bf16*)A + (size_t)(16 * rg + l16) * K + 8 * hq + 32 * NKS * wave;
    const GAS bf16* wp = (const GAS bf16*)Wt + (size_t)(32 * cs + l16) * K + 8 * hq + 32 * NKS * wave;
    f32x4 acc0 = {0.f, 0.f, 0.f, 0.f}, acc1 = acc0;
    bf16x8 a[NKS], b0[NKS], b1[NKS];
#pragma unroll
    for (int i = 0; i < NKS; ++i) { a[i] = *(const GAS bf16x8*)(ap + 32 * i); b0[i] = *(const GAS bf16x8*)(wp + 32 * i); b1[i] = *(const GAS bf16x8*)(wp + (size_t)16 * K + 32 * i); }
#pragma unroll
    for (int i = 0; i < NKS; ++i) { acc0 = MFMA16(a[i], b0[i], acc0); acc1 = MFMA16(a[i], b1[i], acc1); }
    LAS f32x4* red = (LAS f32x4*)(F.lds + RING_OFF);
    LDS_BAR();
    red[(wave * 2 + 0) * 64 + lane] = acc0; red[(wave * 2 + 1) * 64 + lane] = acc1;
    LDS_BAR();
    if (wave < 2) {
        f32x4 s = {0.f, 0.f, 0.f, 0.f};
#pragma unroll
        for (int w = 0; w < 8; ++w) s = s + red[(w * 2 + wave) * 64 + lane];
        const int n = 32 * cs + 16 * wave + l16;
#pragma unroll
        for (int e = 0; e < 4; ++e) { const size_t off = (size_t)(MP + 16 * rg + 4 * hq + e) * DM + n;
            const float rv = rs ? rs[16 * rg + 4 * hq + e] : 1.f;
            if (Yf) Yf[off] = s[e] * rv; else Qb[off] = (bf16)(cvtpk(s[e] * sc * rv, 0.f) & 0xffffu); }
    }
    LDS_BAR();
}

#ifndef MK_PER_PHASE
#define MK_PER_PHASE 0
#endif
#ifndef EN_CONV
#define EN_CONV 1
#endif
#ifndef EN_DOWN
#define EN_DOWN 1
#endif
#ifndef EN_INPROJ
#define EN_INPROJ 1
#endif
#ifndef EN_MEMKV
#define EN_MEMKV 1
#endif
#ifndef EN_MIX
#define EN_MIX 1
#endif
#ifndef EN_NORM
#define EN_NORM 1
#endif
#ifndef EN_PROLOG
#define EN_PROLOG 1
#endif
#ifndef EN_UP
#define EN_UP 1
#endif
#ifndef EN_WO
#define EN_WO 1
#endif
#ifndef EN_XATTN
#define EN_XATTN 1
#endif
#ifndef EN_XO
#define EN_XO 1
#endif
#ifndef EN_XQ
#define EN_XQ 1
#endif
#ifndef HGRN_NAIVE
#define HGRN_NAIVE 0
#endif
#ifndef DUP_PROLOG
#define DUP_PROLOG 0
#endif
#ifndef DUP_UP
#define DUP_UP 0
#endif
#ifndef DUP_WO
#define DUP_WO 0
#endif
#ifndef DUP_DOWN
#define DUP_DOWN 0
#endif
#ifndef DUP_P1
#define DUP_P1 0
#endif
#ifndef DUP_SWA
#define DUP_SWA 0
#endif
#ifndef DUP_SMP
#define DUP_SMP 0
#endif
#ifndef DUP_XP
#define DUP_XP 0
#endif
#ifndef DUP_XS
#define DUP_XS 0
#endif
#ifndef DUP_MIXB
#define DUP_MIXB 0
#endif
#ifndef DUP_MIX
#define DUP_MIX 0
#endif
#ifndef DUP_XATTN
#define DUP_XATTN 0
#endif
#ifndef DUP_CONV
#define DUP_CONV 0
#endif
#ifndef DUP_INPROJ
#define DUP_INPROJ 0
#endif
constexpr int N_PHASES = 2 + 13 * DEPTH;

struct Args { const float* in[29]; float* out; unsigned char* ws; int ph_lo, ph_hi; };

__global__ void __launch_bounds__(NTHR, 2) mk_fwd(Args args) {
    extern __shared__ __attribute__((aligned(16))) unsigned char lds[];
    Frame F;
    F.lds = (LAS unsigned char*)lds;
    F.MISC = (volatile LAS unsigned*)(F.lds + MISC_OFF);
    F.tid = threadIdx.x; F.lane = F.tid & 63; F.wave = __builtin_amdgcn_readfirstlane(F.tid >> 6);
    F.G = gridDim.x; F.gw = blockIdx.x * NWAVES + F.wave; F.ngw = F.G * NWAVES;
    F.ws = args.ws; F.out = args.out; F.ctl = (unsigned*)(args.ws + WS_CTL);
    F.in = args.in;
    for (int u = F.tid; u < (LDS_BYTES - LDSCTL_OFF) / 4; u += NTHR) ((LAS unsigned*)(F.lds + LDSCTL_OFF))[u] = 0u;
    __syncthreads();
    XcdBarrier bar = xcd_barrier_post(F.ctl + CW_BAR, F.MISC + 8);
    const int lo = args.ph_lo, hi = args.ph_hi;
    unsigned char* ws = args.ws; int bx = blockIdx.x;
#define FRESH() do { bx = blockIdx.x; F.vcu = (bx & 7) * (GRID / 8) + (bx >> 3); F.lane = (int)__builtin_amdgcn_mbcnt_hi(~0u, __builtin_amdgcn_mbcnt_lo(~0u, 0u)); F.tid = F.wave * 64 + F.lane; asm volatile("" : "+s"(ws), "+v"(F.tid), "+v"(F.lane), "+s"(F.wave), "+s"(F.gw), "+s"(bx), "+s"(F.vcu)); F.ws = ws; } while (0)
#define IN(k) (lo <= (k) && (k) < hi)
#define SEAM(k) do { if (IN((k) + 1)) xcd_barrier(bar); } while (0)
    LAS float* wl = (LAS float*)(F.lds + RING_OFF + 102400 + F.wave * 2048);

    if (EN_PROLOG && IN(0)) { _Pragma("unroll 1") for (int rep_ = 0; rep_ <= DUP_PROLOG; ++rep_) { FRESH(); p0_prologue(F); } SEAM(0); }
    if (EN_MEMKV && IN(1)) { FRESH();
        pg8::Gemm g{(const pg8::bf16_t*)(ws + WS_MEMN), (const pg8::bf16_t*)(ws + WS_WXKV), DEPTH * 2048, DEPTH * 2048, DM};
        pg8::BlockDiagOrder S{F.G, bx};
        pg8::EpiMemKV E{F.out + O_MKP, F.out + O_MVP, (pg8::bf16_t*)(ws + WS_MK), (pg8::bf16_t*)(ws + WS_MVT)};
        pg8::gemm_phase<pg8::EpiMemKV, pg8::BlockDiagOrder, true, true>(F.lds + RING_OFF, g, S, E, F.wave);
        SEAM(1);
    }
    for (int l = 0; l < DEPTH; ++l) {
        const int pb = 2 + 13 * l;
        if (EN_INPROJ && IN(pb + 0)) { FRESH();
            pg8::Gemm g{(const pg8::bf16_t*)(ws + WS_XN), (const pg8::bf16_t*)(ws + WS_WIN) + (size_t)l * PIN * DM, MT, PIN, DM};
            pg8::StaticOrder S; S.init(MT, PIN, F.G, bx);
            pg8::EpiProj E{(pg8::bf16_t*)(ws + WS_PROJ), (float*)(ws + WS_LF), (const float*)(ws + WS_TAB + TAB_LB) + l * 512, (pg8::bf16_t*)(ws + WS_HQ), (pg8::bf16_t*)(ws + WS_HK), (pg8::bf16_t*)(ws + WS_HV), (float*)(ws + WS_HLF)};
            _Pragma("unroll 1") for (int rep_ = 0; rep_ <= DUP_INPROJ; ++rep_) pg8::gemm_phase<pg8::EpiProj, pg8::StaticOrder, true, true>(F.lds + RING_OFF, g, S, E, F.wave);
            SEAM(pb + 0);
        }
        if (EN_MIX && IN(pb + 1)) { FRESH();
          _Pragma("unroll 1") for (int rep_ = 0; rep_ <= DUP_MIX; ++rep_) { FRESH();
            _Pragma("unroll 1") for (int r2_ = 0; r2_ <= DUP_P1; ++r2_) { FRESH(); for (int u = F.vcu; u < NB * 4 * 8; u += F.G) hgrn_pass1(F, l, u >> 5, (u >> 3) & 3, u & 7); }
            _Pragma("unroll 1") for (int r2_ = 0; r2_ <= DUP_SWA; ++r2_) { FRESH(); for (int u = F.vcu; u < NB * 2 * 16; u += F.G) swa_unit_prompt(F, l, u >> 5, (u >> 4) & 1, u & 15); }
            _Pragma("unroll 1") for (int r2_ = 0; r2_ <= DUP_SMP; ++r2_) { FRESH(); if (bx < DB) hgrn_unit_sample(F, l, bx); else if (bx < 2 * DB) swa_unit_sample(F, l, bx - DB); }
          }
            SEAM(pb + 1);
        }
        if (EN_MIX && IN(pb + 2)) { FRESH();
            _Pragma("unroll 1") for (int rep_ = 0; rep_ <= DUP_MIXB; ++rep_) { FRESH(); for (int u = F.vcu; u < NB * 4 * 8; u += F.G) hgrn_pass2(F, l, u >> 5, (u >> 3) & 3, u & 7); }
            SEAM(pb + 2);
        }
        if (EN_WO && IN(pb + 3)) { FRESH();
            sample_slice_gemm<DM>(F, (const bf16*)(ws + WS_MIX) + (size_t)MP * DM, (const bf16*)(ws + WS_WO) + (size_t)l * DM * DM, nullptr, (bf16*)(ws + WS_Y), 1.f);
            pg8::Gemm g{(const pg8::bf16_t*)(ws + WS_MIX), (const pg8::bf16_t*)(ws + WS_WO) + (size_t)l * DM * DM, MP, DM, DM};
            pg8::StaticOrder S; S.init(MP, DM, F.G, bx);
            pg8::EpiB16 E{(pg8::bf16_t*)(ws + WS_Y), DM, 1.0f, nullptr};
            _Pragma("unroll 1") for (int rep_ = 0; rep_ <= DUP_WO; ++rep_) pg8::gemm_phase<pg8::EpiB16, pg8::StaticOrder, true, true>(F.lds + RING_OFF, g, S, E, F.wave);
            SEAM(pb + 3);
        }
        if (EN_NORM && IN(pb + 4)) { FRESH(); norm_phase(F, F.in[IN_GQM] + l * DM, nullptr, false); SEAM(pb + 4); }
        if (EN_XQ && IN(pb + 5)) { FRESH();
            sample_slice_gemm<DM>(F, (const bf16*)(ws + WS_X) + (size_t)MP * DM, (const bf16*)(ws + WS_WXQ) + (size_t)l * DM * DM, nullptr, (bf16*)(ws + WS_QX), 0.0625f * 1.4426950408889634f, (const float*)(ws + WS_RS) + MP);
            pg8::Gemm g{(const pg8::bf16_t*)(ws + WS_X), (const pg8::bf16_t*)(ws + WS_WXQ) + (size_t)l * DM * DM, MP, DM, DM};
            pg8::StaticOrder S; S.init(MP, DM, F.G, bx);
            pg8::EpiB16 E{(pg8::bf16_t*)(ws + WS_QX), DM, 0.0625f * 1.4426950408889634f, (const float*)(ws + WS_RS)};
            pg8::gemm_phase<pg8::EpiB16, pg8::StaticOrder, true, true>(F.lds + RING_OFF, g, S, E, F.wave);
            SEAM(pb + 5);
        }
        if (EN_XATTN && IN(pb + 6)) { FRESH();
          _Pragma("unroll 1") for (int rep_ = 0; rep_ <= DUP_XATTN; ++rep_) { FRESH();
            if ((bx >> 3) & 1) for (int u = bx; u < DB * 4; u += F.G) xattn_unit_sample(F, l, u >> 2, u & 3);
            _Pragma("unroll 1") for (int r2_ = 0; r2_ <= DUP_XP; ++r2_) { FRESH(); for (int u = F.vcu; u < NB * 4 * 8; u += F.G) xattn_unit_prompt(F, l, u >> 5, (u >> 3) & 3, u & 7); }
            if (!((bx >> 3) & 1)) for (int u = bx; u < DB * 4; u += F.G) xattn_unit_sample(F, l, u >> 2, u & 3);
            _Pragma("unroll 1") for (int r2_ = 0; r2_ < DUP_XS; ++r2_) { FRESH(); for (int u = bx; u < DB * 4; u += F.G) xattn_unit_sample(F, l, u >> 2, u & 3); }
          }
            SEAM(pb + 6);
        }
        if (EN_XO && IN(pb + 7)) { FRESH();
            sample_slice_gemm<DM>(F, (const bf16*)(ws + WS_OX) + (size_t)MP * DM, (const bf16*)(ws + WS_WXO) + (size_t)l * DM * DM, nullptr, (bf16*)(ws + WS_Y), 1.f);
            pg8::Gemm g{(const pg8::bf16_t*)(ws + WS_OX), (const pg8::bf16_t*)(ws + WS_WXO) + (size_t)l * DM * DM, MP, DM, DM};
            pg8::StaticOrder S; S.init(MP, DM, F.G, bx);
            pg8::EpiB16 E{(pg8::bf16_t*)(ws + WS_Y), DM, 1.0f, nullptr};
            pg8::gemm_phase<pg8::EpiB16, pg8::StaticOrder, true, true>(F.lds + RING_OFF, g, S, E, F.wave);
            SEAM(pb + 7);
        }
        if (EN_NORM && IN(pb + 8)) { FRESH(); norm_phase(F, F.in[IN_GQX] + l * DM, nullptr, false); SEAM(pb + 8); }
        if (EN_UP && IN(pb + 9)) { FRESH();
            pg8::Gemm g{(const pg8::bf16_t*)(ws + WS_X), (const pg8::bf16_t*)(ws + WS_WUP) + (size_t)l * UPW * DM, MT, UPW, DM};
            pg8::StaticOrder S; S.init(MT, UPW, F.G, bx);
            pg8::EpiB16 E{(pg8::bf16_t*)(ws + WS_U), UPW, 1.0f, (const float*)(ws + WS_RS)};
            _Pragma("unroll 1") for (int rep_ = 0; rep_ <= DUP_UP; ++rep_) pg8::gemm_phase<pg8::EpiB16, pg8::StaticOrder, true, true>(F.lds + RING_OFF, g, S, E, F.wave);
            SEAM(pb + 9);
        }
        if (EN_CONV && IN(pb + 10)) { FRESH(); _Pragma("unroll 1") for (int rep_ = 0; rep_ <= DUP_CONV; ++rep_) { FRESH(); conv_phase(F, l); } SEAM(pb + 10); }
        if (EN_DOWN && IN(pb + 11)) { FRESH();
            sample_slice_gemm<DFF>(F, (const bf16*)(ws + WS_G) + (size_t)MP * DFF, (const bf16*)(ws + WS_WDN) + (size_t)l * DM * DFF, nullptr, (bf16*)(ws + WS_Y), 1.f);
            pg8::Gemm g{(const pg8::bf16_t*)(ws + WS_G), (const pg8::bf16_t*)(ws + WS_WDN) + (size_t)l * DM * DFF, MP, DM, DFF};
            pg8::StaticOrder S; S.init(MP, DM, F.G, bx);
            pg8::EpiB16 E{(pg8::bf16_t*)(ws + WS_Y), DM, 1.0f, nullptr};
            _Pragma("unroll 1") for (int rep_ = 0; rep_ <= DUP_DOWN; ++rep_) pg8::gemm_phase<pg8::EpiB16, pg8::StaticOrder, true, true>(F.lds + RING_OFF, g, S, E, F.wave);
            SEAM(pb + 11);
        }
        if (EN_NORM && IN(pb + 12)) { FRESH(); norm_phase(F, F.in[IN_GQF] + l * DM, F.in[IN_GPM] + (l + 1 < DEPTH ? l + 1 : 0) * DM, l == DEPTH - 1); SEAM(pb + 12); }
    }
#undef IN
#undef SEAM
}

extern "C" void kernel_launch(void* const* d_in, const int* in_sizes, int n_in, void* d_out, int out_size, void* d_ws, size_t ws_size, hipStream_t stream) {
    static int grid = 0;
    if (grid == 0) {
        if (n_in != 29 || (size_t)out_size != O_END || ws_size < WS_END) { fprintf(stderr, "kernel_launch: unexpected shapes (n_in %d out %d ws %zu need %zu)\n", n_in, out_size, ws_size, (size_t)WS_END); grid = -1; return; }
        int dev = 0, cus = 0, per_cu = 0;
        if (hipGetDevice(&dev) != hipSuccess || hipDeviceGetAttribute(&cus, hipDeviceAttributeMultiprocessorCount, dev) != hipSuccess) { grid = -1; return; }
        if (hipFuncSetAttribute((const void*)mk_fwd, hipFuncAttributeMaxDynamicSharedMemorySize, LDS_BYTES) != hipSuccess) { fprintf(stderr, "kernel_launch: hipFuncSetAttribute failed\n"); grid = -1; return; }
        if (hipOccupancyMaxActiveBlocksPerMultiprocessor(&per_cu, (const void*)mk_fwd, NTHR, LDS_BYTES) != hipSuccess || per_cu < 1) fprintf(stderr, "kernel_launch: occupancy query says %d\n", per_cu);
        (void)hipGetLastError();
        if (cus < GRID) { fprintf(stderr, "kernel_launch: %d CUs; this kernel needs %d (one resident workgroup per CU)\n", cus, GRID); grid = -1; return; }
        grid = GRID;
    }
    if (grid < 0) return;
    if (hipMemsetAsync((char*)d_ws + WS_CTL, 0, CTL_ZERO_BYTES, stream) != hipSuccess) return;
    Args a{};
    for (int i = 0; i < 29; ++i) a.in[i] = (const float*)d_in[i];
    a.out = (float*)d_out; a.ws = (unsigned char*)d_ws;
#if MK_PER_PHASE
    for (int p = 0; p < N_PHASES; ++p) { a.ph_lo = p; a.ph_hi = p + 1; hipLaunchKernelGGL(mk_fwd, dim3(grid), dim3(NTHR), LDS_BYTES, stream, a); }
#else
    a.ph_lo = 0; a.ph_hi = N_PHASES; hipLaunchKernelGGL(mk_fwd, dim3(grid), dim3(NTHR), LDS_BYTES, stream, a);
#endif
}
```

```cpp
#include <hip/hip_runtime.h>
#include <cstdio>
#include <cstdint>
#include <cmath>
namespace pg8 {
#define PG8_LAS __attribute__((address_space(3)))
typedef unsigned short bf16_t;
typedef short bf16x8 __attribute__((ext_vector_type(8)));
typedef float f32x4 __attribute__((ext_vector_type(4)));
typedef unsigned u32x4 __attribute__((ext_vector_type(4)));
constexpr int BM = 256, BK = 64, HALF = 128, HTB = HALF * BK * 2  , STAGE_BYTES = 8 * HTB, NXCD = 8, WGM = 8;

__host__ __device__ __forceinline__ int lds_byte(int r, int c) { const int st = (r >> 4) * 2 + (c >> 5), rr = r & 15, cc = c & 31, ob = rr * 64 + cc * 2; return st * 1024 + (ob ^ (((ob >> 9) & 1) << 5)); }
__host__ __device__ __forceinline__ void stage_rc(int b, int& R, int& C) { const int st = b / 1024, sb = b % 1024, swz = sb ^ (((sb >> 9) & 1) << 5); R = (st >> 1) * 16 + swz / 64; C = (st & 1) * 32 + (swz % 64) / 2; }
__host__ __device__ __forceinline__ int perm32(int rho) { const int n = rho >> 4, i = rho & 15; return 8 * (i >> 2) + 4 * n + (i & 3); }

struct Unit { int pm, pn; };
struct Gemm { const bf16_t* A; const bf16_t* Bt; int M, N, K; };

struct StaticOrder {
    int nM, nN, nwg, G, c;
    __host__ __device__ void init(int M, int N, int G_, int c_) { nM = M / BM; nN = N / BM; nwg = nM * nN; G = G_; c = c_; }
    __host__ __device__ bool next(int i, Unit& u) const {
        const long L = (long)i * G + c; if (L >= nwg) return false;
        int wgid = (int)L; { const int q = nwg / NXCD, r = nwg % NXCD, xcd = wgid % NXCD, off = wgid / NXCD; wgid = (xcd < r ? xcd * (q + 1) : r * (q + 1) + (xcd - r) * q) + off; }
        const int nig = WGM * nN, gid = wgid / nig, fm = gid * WGM, gsz = (nM - fm) < WGM ? (nM - fm) : WGM;
        u.pm = fm + ((wgid % nig) % gsz); u.pn = (wgid % nig) / gsz; return true;
    }
    __device__ __forceinline__ void a_ready(const Unit&) const {}
    __device__ __forceinline__ void done(const Unit&) const {}
};

__device__ __forceinline__ unsigned cvt_pk_bf16(float lo, float hi) { unsigned r; asm volatile("v_cvt_pk_bf16_f32 %0, %1, %2" : "=v"(r) : "v"(lo), "v"(hi)); return r; }
typedef float f32x2 __attribute__((ext_vector_type(2)));
template <class Epi, class Sched, bool ALIGN_EPI = false, bool SP2 = false>
__device__ __forceinline__ void gemm_phase(PG8_LAS unsigned char* lds, const Gemm g, const Sched& S, const Epi& E, int wave_) {
    int tid_ = (int)__builtin_amdgcn_mbcnt_hi(~0u, __builtin_amdgcn_mbcnt_lo(~0u, 0u)) + 64 * wave_; asm volatile("" : "+v"(tid_));
    const int tid = tid_, wid = __builtin_amdgcn_readfirstlane(tid >> 6), lane = tid & 63, wr = wid >> 2, wc = wid & 3, fr = lane & 15, fq = lane >> 4;
    const int K = g.K, nt = K / BK;
    unsigned voffA[2], voffB[2];
#pragma unroll
    for (int i = 0; i < 2; ++i) { int R, C; stage_rc(tid * 16 + i * 8192, R, C); const int Rb = Epi::PERM ? ((R & ~31) + perm32(R & 31)) : R;
        voffA[i] = (unsigned)(R * K + C) * 2u; voffB[i] = (unsigned)(Rb * K + C) * 2u; }
    const size_t kstep = (size_t)(BK * 2);
    const size_t hstep = (size_t)HALF * K * 2;
    const size_t tstep = 2 * hstep;
    const unsigned ldsw = (unsigned)wid * 1024u;
    const int aoff = lds_byte(wr * 64 + fr, fq * 8), boff = lds_byte(wc * 32 + fr, fq * 8);
#define PG8_SA(b, h) (((b) * 2 + (h)) * HTB)
#define PG8_SB(b, h) ((4 + (b) * 2 + (h)) * HTB)
#define PG8_STAGE(bufoff, gbase, voff) do { _Pragma("unroll") for (int _i = 0; _i < 2; ++_i) \
        __builtin_amdgcn_global_load_lds((const unsigned*)((const char*)(gbase) + (voff)[_i]), (PG8_LAS unsigned*)(lds + (bufoff) + ldsw + _i * 8192), 16, 0, 0); } while (0)
#define PG8_LDA(dst, b, h) do { _Pragma("unroll") for (int m = 0; m < 4; ++m) _Pragma("unroll") for (int k = 0; k < 2; ++k) dst[m][k] = *(const PG8_LAS bf16x8*)(lds + PG8_SA(b, h) + aoff + m * 2048 + k * 1024); } while (0)
#define PG8_LDB(dst, b, h) do { _Pragma("unroll") for (int n = 0; n < 2; ++n) _Pragma("unroll") for (int k = 0; k < 2; ++k) dst[n][k] = *(const PG8_LAS bf16x8*)(lds + PG8_SB(b, h) + boff + n * 2048 + k * 1024); } while (0)
#define PG8_MMA(ai, bj, At, Bt) do { __builtin_amdgcn_s_setprio(1); _Pragma("unroll") for (int m = 0; m < 4; ++m) _Pragma("unroll") for (int n = 0; n < 2; ++n) _Pragma("unroll") for (int k = 0; k < 2; ++k) \
        acc[ai][bj][m][n] = __builtin_amdgcn_mfma_f32_16x16x32_bf16(Bt[n][k], At[m][k], acc[ai][bj][m][n], 0, 0, 0); __builtin_amdgcn_s_setprio(0); } while (0)
#define PG8_WAIT_V(n) asm volatile("s_waitcnt vmcnt(" #n ")" ::: "memory")
#define PG8_WAIT_L(n) asm volatile("s_waitcnt lgkmcnt(" #n ")" ::: "memory")
#define PG8_BAR __builtin_amdgcn_s_barrier()
#define PG8_SCHED __builtin_amdgcn_sched_barrier(0)
    Unit cur, nxt; int ui = 0;
    if (!S.next(0, cur)) return;
    f32x4 acc[2][2][4][2];
#pragma unroll
    for (int a = 0; a < 2; ++a)
#pragma unroll
        for (int b = 0; b < 2; ++b)
#pragma unroll
            for (int m = 0; m < 4; ++m)
#pragma unroll
                for (int n = 0; n < 2; ++n) acc[a][b][m][n] = (f32x4){0.f, 0.f, 0.f, 0.f};
    bf16x8 At[4][2], B0[2][2], B1[2][2];
    const char* cA = (const char*)g.A + (size_t)cur.pm * tstep; const char* cB = (const char*)g.Bt + (size_t)cur.pn * tstep;
    S.a_ready(cur);
    if constexpr (SP2) {
        PG8_STAGE(PG8_SB(0, 0), cB, voffB); PG8_STAGE(PG8_SB(0, 1), cB + hstep, voffB); PG8_STAGE(PG8_SA(0, 0), cA, voffA); PG8_STAGE(PG8_SA(0, 1), cA + hstep, voffA);
        if (wr == 1) PG8_BAR;
        PG8_WAIT_V(2); PG8_BAR;
        PG8_STAGE(PG8_SB(1, 0), cB + kstep, voffB); PG8_STAGE(PG8_SA(1, 0), cA + kstep, voffA); PG8_STAGE(PG8_SB(1, 1), cB + hstep + kstep, voffB);
        PG8_WAIT_V(6); PG8_BAR;
    } else {
        PG8_STAGE(PG8_SB(0, 0), cB, voffB); PG8_STAGE(PG8_SA(0, 0), cA, voffA); PG8_STAGE(PG8_SB(0, 1), cB + hstep, voffB); PG8_STAGE(PG8_SA(0, 1), cA + hstep, voffA);
        if (wr == 1) PG8_BAR;
        PG8_WAIT_V(4); PG8_BAR;
        PG8_STAGE(PG8_SB(1, 0), cB + kstep, voffB); PG8_STAGE(PG8_SA(1, 0), cA + kstep, voffA); PG8_STAGE(PG8_SB(1, 1), cB + hstep + kstep, voffB);
        PG8_WAIT_V(6); PG8_BAR;
    }
    for (;;) {
        const bool has_next = S.next(ui + 1, nxt);
        const char* nA = has_next ? (const char*)g.A + (size_t)nxt.pm * tstep : cA; const char* nB = has_next ? (const char*)g.Bt + (size_t)nxt.pn * tstep : cB;
        for (int t = 0; t < nt; t += 2) {
            const bool last = (t == nt - 2);
            const char* a1 = cA + (size_t)(t + 1) * kstep;
            const char* a2 = last ? nA : cA + (size_t)(t + 2) * kstep; const char* b2 = last ? nB : cB + (size_t)(t + 2) * kstep;
            const char* a3 = a2 + kstep; const char* b3 = b2 + kstep;
            if (last && has_next) S.a_ready(nxt);
            if constexpr (SP2) {
            PG8_LDB(B0, 0, 0); PG8_LDB(B1, 0, 1); PG8_SCHED; PG8_LDA(At, 0, 0); PG8_STAGE(PG8_SA(1, 1), a1 + hstep, voffA);
            PG8_WAIT_V(8); PG8_WAIT_L(0); PG8_BAR; PG8_MMA(0, 0, At, B0); PG8_MMA(0, 1, At, B1); PG8_BAR; PG8_SCHED;
            PG8_LDA(At, 0, 1); PG8_STAGE(PG8_SB(0, 0), b2, voffB); PG8_STAGE(PG8_SB(0, 1), b2 + hstep, voffB); PG8_STAGE(PG8_SA(0, 0), a2, voffA);
            PG8_WAIT_V(8); PG8_WAIT_L(0); PG8_BAR; PG8_MMA(1, 0, At, B0); PG8_MMA(1, 1, At, B1); PG8_BAR; PG8_SCHED;
            PG8_LDB(B0, 1, 0); PG8_LDB(B1, 1, 1); PG8_SCHED; PG8_LDA(At, 1, 0); PG8_STAGE(PG8_SA(0, 1), a2 + hstep, voffA);
            PG8_WAIT_V(8); PG8_WAIT_L(0); PG8_BAR; PG8_MMA(0, 0, At, B0); PG8_MMA(0, 1, At, B1); PG8_BAR; PG8_SCHED;
            PG8_LDA(At, 1, 1); PG8_STAGE(PG8_SB(1, 0), b3, voffB); PG8_STAGE(PG8_SB(1, 1), b3 + hstep, voffB); PG8_STAGE(PG8_SA(1, 0), a3, voffA);
            PG8_WAIT_V(8); PG8_WAIT_L(0); PG8_BAR; PG8_MMA(1, 0, At, B0); PG8_MMA(1, 1, At, B1); PG8_BAR; PG8_SCHED;
            } else {
            PG8_LDB(B0, 0, 0); PG8_SCHED; PG8_LDA(At, 0, 0); PG8_STAGE(PG8_SA(1, 1), a1 + hstep, voffA);
            PG8_WAIT_L(8); PG8_BAR; PG8_WAIT_L(0); PG8_MMA(0, 0, At, B0); PG8_BAR; PG8_SCHED;
            PG8_LDB(B1, 0, 1); PG8_STAGE(PG8_SB(0, 0), b2, voffB);
            PG8_BAR; PG8_WAIT_L(0); PG8_MMA(0, 1, At, B1); PG8_BAR;
            PG8_LDA(At, 0, 1); PG8_STAGE(PG8_SA(0, 0), a2, voffA);
            PG8_BAR; PG8_WAIT_L(0); PG8_MMA(1, 0, At, B0); PG8_BAR; PG8_SCHED;
            PG8_STAGE(PG8_SB(0, 1), b2 + hstep, voffB);
            PG8_WAIT_V(6); PG8_BAR; PG8_MMA(1, 1, At, B1); PG8_BAR;
            PG8_LDB(B0, 1, 0); PG8_SCHED; PG8_LDA(At, 1, 0); PG8_STAGE(PG8_SA(0, 1), a2 + hstep, voffA);
            PG8_WAIT_L(8); PG8_BAR; PG8_WAIT_L(0); PG8_MMA(0, 0, At, B0); PG8_BAR; PG8_SCHED;
            PG8_LDB(B1, 1, 1); PG8_STAGE(PG8_SB(1, 0), b3, voffB);
            PG8_BAR; PG8_WAIT_L(0); PG8_MMA(0, 1, At, B1); PG8_BAR;
            PG8_LDA(At, 1, 1); PG8_STAGE(PG8_SA(1, 0), a3, voffA);
            PG8_BAR; PG8_WAIT_L(0); PG8_MMA(1, 0, At, B0); PG8_BAR; PG8_SCHED;
            PG8_STAGE(PG8_SB(1, 1), b3 + hstep, voffB);
            PG8_WAIT_V(6); PG8_BAR; PG8_MMA(1, 1, At, B1); PG8_BAR;
            }
        }
        if constexpr (ALIGN_EPI) { if (wr == 0) PG8_BAR; }
        if constexpr (Epi::ROWSCALE) {
#pragma unroll
            for (int a = 0; a < 2; ++a)
#pragma unroll
                for (int m = 0; m < 4; ++m) { const float s_ = E.rs[cur.pm * BM + a * HALF + wr * 64 + m * 16 + fr];
#pragma unroll
                    for (int b = 0; b < 2; ++b)
#pragma unroll
                        for (int n = 0; n < 2; ++n) acc[a][b][m][n] = acc[a][b][m][n] * s_; }
        }
        if constexpr (!Epi::AFTER_DRAIN) { E(acc, cur, wr, wc, fr, fq); S.done(cur); }
        if (!has_next) break;
#pragma unroll
        for (int a = 0; a < 2; ++a)
#pragma unroll
            for (int b = 0; b < 2; ++b)
#pragma unroll
                for (int m = 0; m < 4; ++m)
#pragma unroll
                    for (int n = 0; n < 2; ++n) acc[a][b][m][n] = (f32x4){0.f, 0.f, 0.f, 0.f};
        cur = nxt; cA = nA; cB = nB; ++ui;
        if constexpr (ALIGN_EPI) { if (wr == 1) PG8_BAR; }
    }
    PG8_WAIT_V(0);
    if constexpr (!ALIGN_EPI) { if (wr == 0) PG8_BAR; }
    PG8_BAR;
    if constexpr (Epi::AFTER_DRAIN) { E.fused(acc, cur, wr, wc, fr, fq, lds, wid, lane); S.done(cur); }
#undef PG8_SA
#undef PG8_SB
#undef PG8_STAGE
#undef PG8_LDA
#undef PG8_LDB
#undef PG8_MMA
#undef PG8_WAIT_V
#undef PG8_WAIT_L
#undef PG8_BAR
#undef PG8_SCHED
}
}

#define GAS __attribute__((address_space(1)))
#define LAS __attribute__((address_space(3)))
typedef unsigned short bf16;
typedef unsigned v4u __attribute__((ext_vector_type(4)));
typedef unsigned v2u __attribute__((ext_vector_type(2)));
typedef float f32x4 __attribute__((ext_vector_type(4)));
typedef float f32x2 __attribute__((ext_vector_type(2)));
typedef short bf16x8 __attribute__((ext_vector_type(8)));
typedef float f32x16 __attribute__((ext_vector_type(16)));
#define RLX_AGENT __ATOMIC_RELAXED, __HIP_MEMORY_SCOPE_AGENT
#define LDS_WAIT() asm volatile("s_waitcnt lgkmcnt(0)" ::: "memory")
#define VM_WAIT() asm volatile("s_waitcnt vmcnt(0)" ::: "memory")

constexpr int NWAVES = 8, NTHR = 512, GRID = 256;
constexpr int DM = 1024, NB = 8, SEQ = 2048, DEPTH = 4, DB = 128;
constexpr int MP = NB * SEQ;
constexpr int MS = DB;
constexpr int MR = MP + MS;
constexpr int MT = 16640;
constexpr int PIN = 2816, DFF = 2816, UPW = 5632;
constexpr int C_K = 512, C_V = 640, C_QR = 768, C_FR = 1280, C_IR = 1792, C_GR = 2304;
constexpr int NMEM = 256, XH = 4, XHD = 256;
constexpr int WIN = 128, PAST = 8192;
constexpr float EPS = 1e-6f;

constexpr size_t O_YP = 0;
constexpr size_t O_YS = O_YP + (size_t)MP * DM;
constexpr size_t O_WKP = O_YS + (size_t)MS * DM;
constexpr size_t O_WVP = O_WKP + (size_t)DEPTH * NB * 128 * 128;
constexpr size_t O_WKS = O_WVP + (size_t)DEPTH * NB * 128 * 128;
constexpr size_t O_WVS = O_WKS + (size_t)DEPTH * DB * 128;
constexpr size_t O_MKP = O_WVS + (size_t)DEPTH * DB * 128;
constexpr size_t O_MVP = O_MKP + (size_t)DEPTH * NB * NMEM * DM;
constexpr size_t O_HP = O_MVP + (size_t)DEPTH * NB * NMEM * DM;
constexpr size_t O_HS = O_HP + (size_t)DEPTH * NB * 4 * 128 * 128;
constexpr size_t O_CP = O_HS + (size_t)DEPTH * DB * 4 * 128 * 128;
constexpr size_t O_CS = O_CP + (size_t)DEPTH * NB * 2 * UPW;
constexpr size_t O_END = O_CS + (size_t)DEPTH * DB * 2 * UPW;

constexpr size_t MiB = 1u << 20;
constexpr size_t WS_CTL = 0, CTL_ZERO_BYTES = 1 * MiB;
constexpr size_t WS_TAB = 1 * MiB;
constexpr size_t TAB_COS = 0, TAB_SIN = 2049 * 32 * 4, TAB_LB = 2 * 2049 * 32 * 4;
constexpr size_t WS_WIN = 2 * MiB;
constexpr size_t WS_WO = WS_WIN + (size_t)DEPTH * PIN * DM * 2;
constexpr size_t WS_WXQ = WS_WO + (size_t)DEPTH * DM * DM * 2;
constexpr size_t WS_WXKV = WS_WXQ + (size_t)DEPTH * DM * DM * 2;
constexpr size_t WS_WXO = WS_WXKV + (size_t)DEPTH * 2 * DM * DM * 2;
constexpr size_t WS_WUP = WS_WXO + (size_t)DEPTH * DM * DM * 2;
constexpr size_t WS_WDN = WS_WUP + (size_t)DEPTH * UPW * DM * 2;
constexpr size_t WS_X = WS_WDN + (size_t)DEPTH * DM * DFF * 2;
constexpr size_t WS_XN = WS_X + (size_t)MT * DM * 4;
constexpr size_t WS_PROJ = WS_XN + (size_t)MT * DM * 2;
constexpr size_t WS_LF = WS_PROJ + (size_t)MT * PIN * 2;
constexpr size_t WS_MIX = WS_LF + (size_t)MT * 512 * 4;
constexpr size_t WS_Y = WS_MIX + (size_t)MT * DM * 2;
constexpr size_t WS_QX = WS_Y + (size_t)MT * DM * 4;
constexpr size_t WS_OX = WS_QX + (size_t)MT * DM * 2;
constexpr size_t WS_U = WS_OX + (size_t)MT * DM * 2;
constexpr size_t WS_G = WS_U + (size_t)MT * UPW * 2;
constexpr size_t WS_MEMN = WS_G + (size_t)MT * DFF * 2;
constexpr size_t WS_MK = WS_MEMN + (size_t)DEPTH * 2048 * DM * 2;
constexpr size_t WS_MVT = WS_MK + (size_t)DEPTH * 2048 * DM * 2;
constexpr size_t WS_HQ = WS_MVT + (size_t)DEPTH * 2048 * DM * 2;
constexpr size_t WS_HK = WS_HQ + (size_t)NB * 4 * 128 * SEQ * 2;
constexpr size_t WS_HV = WS_HK + (size_t)NB * 4 * 128 * SEQ * 2;
constexpr size_t WS_HLF = WS_HV + (size_t)NB * 4 * 128 * SEQ * 2;
constexpr size_t WS_HQB = WS_HLF + (size_t)NB * 4 * 128 * SEQ * 4;
constexpr size_t WS_HOP = WS_HQB + (size_t)MP * 512 * 2;
constexpr size_t WS_HSL = WS_HOP + (size_t)MP * 512 * 4;
constexpr size_t WS_HDE = WS_HSL + (size_t)256 * 128 * 128 * 4;
constexpr size_t WS_RS = WS_HDE + (size_t)256 * 128 * 4;
constexpr size_t WS_END = WS_RS + (size_t)MT * 4;
static_assert(WS_HK - WS_HQ == (size_t)NB * 4 * 128 * SEQ * 2 && WS_HV - WS_HK == WS_HK - WS_HQ, "HQ | HK | HV consecutive");

constexpr int CW_TMO = 0, CW_CODE = 1;
constexpr int CW_BAR = 4096;

constexpr int RING_OFF = 0, RING_BYTES = 131072;
constexpr int LDSCTL_OFF = RING_BYTES, MISC_OFF = LDSCTL_OFF + 320;
constexpr int LDS_BYTES = 147456;

__device__ __forceinline__ unsigned f2bf(float f) { unsigned u = __builtin_bit_cast(unsigned, f); return (u + 0x7fffu + ((u >> 16) & 1u)) >> 16; }
__device__ __forceinline__ unsigned pk2(float lo, float hi) { return f2bf(lo) | (f2bf(hi) << 16); }
__device__ __forceinline__ float bf2f(unsigned short b) { return __builtin_bit_cast(float, (unsigned)b << 16); }
__device__ __forceinline__ float bflo(unsigned w) { return __builtin_bit_cast(float, w << 16); }
__device__ __forceinline__ float bfhi(unsigned w) { return __builtin_bit_cast(float, w & 0xffff0000u); }
__device__ __forceinline__ float sigmoidf_(float z) { return 1.0f / (1.0f + __expf(-z)); }
__device__ __forceinline__ float siluf_(float z) { return z * __builtin_amdgcn_rcpf(1.0f + __expf(-z)); }
typedef __bf16 bf16x2_t __attribute__((ext_vector_type(2)));
__device__ __forceinline__ unsigned cvtpk(float lo, float hi) { f32x2 v = {lo, hi}; bf16x2_t b = __builtin_convertvector(v, bf16x2_t); return __builtin_bit_cast(unsigned, b); }
#define MFMA32(a, b, c) __builtin_amdgcn_mfma_f32_32x32x16_bf16((a), (b), (c), 0, 0, 0)
#define LDS_BAR() do { asm volatile("s_waitcnt lgkmcnt(0)" ::: "memory"); __builtin_amdgcn_s_barrier(); asm volatile("" ::: "memory"); } while (0)
__device__ __forceinline__ float wave_sum(float v) {
#pragma unroll
    for (int o = 1; o < 64; o <<= 1) v += __shfl_xor(v, o);
    return v;
}
__device__ __forceinline__ float wave_max(float v) {
#pragma unroll
    for (int o = 1; o < 64; o <<= 1) v = fmaxf(v, __shfl_xor(v, o));
    return v;
}

namespace pg8 {
struct EpiF32 {
    static constexpr bool PERM = false, AFTER_DRAIN = false, ROWSCALE = false;
    float* O; int ldc;
    __device__ __forceinline__ void operator()(const f32x4 (&acc)[2][2][4][2], const Unit& u, int wr, int wc, int fr, int fq) const {
        const int row0 = u.pm * BM + wr * 64 + fr, col0 = u.pn * BM + wc * 32 + 4 * fq;
#pragma unroll
        for (int ai = 0; ai < 2; ++ai)
#pragma unroll
            for (int m = 0; m < 4; ++m) { float* rowp = O + (size_t)(row0 + ai * HALF + m * 16) * ldc + col0;
#pragma unroll
                for (int bj = 0; bj < 2; ++bj)
#pragma unroll
                    for (int n = 0; n < 2; ++n) *(f32x4*)(rowp + bj * HALF + n * 16) = acc[ai][bj][m][n]; }
    }
};
struct EpiB16 {
    static constexpr bool PERM = true, AFTER_DRAIN = false, ROWSCALE = false;
    bf16_t* O; int ldc; float sc; const float* rs;
    __device__ __forceinline__ void operator()(const f32x4 (&acc)[2][2][4][2], const Unit& u, int wr, int wc, int fr, int fq) const {
        const int row0 = u.pm * BM + wr * 64 + fr, col0 = u.pn * BM + wc * 32 + 8 * fq;
#pragma unroll
        for (int ai = 0; ai < 2; ++ai)
#pragma unroll
            for (int m = 0; m < 4; ++m) { const int row = row0 + ai * HALF + m * 16; bf16_t* rowp = O + (size_t)row * ldc + col0; const float s = rs ? sc * rs[row] : sc;
#pragma unroll
                for (int bj = 0; bj < 2; ++bj) { const f32x4 v0 = acc[ai][bj][m][0] * s, v1 = acc[ai][bj][m][1] * s;
                    u32x4 w; w.x = cvt_pk_bf16(v0[0], v0[1]); w.y = cvt_pk_bf16(v0[2], v0[3]); w.z = cvt_pk_bf16(v1[0], v1[1]); w.w = cvt_pk_bf16(v1[2], v1[3]);
                    *(u32x4*)(rowp + bj * HALF) = w; } }
    }
};
struct EpiProj {
    static constexpr bool PERM = true, AFTER_DRAIN = false, ROWSCALE = false;
    bf16_t* P; float* LF; const float* lb;
    bf16_t* HQ; bf16_t* HK; bf16_t* HV; float* HLF;
    __device__ __forceinline__ void operator()(const f32x4 (&acc)[2][2][4][2], const Unit& u, int wr, int wc, int fr, int fq) const {
        const int row0 = u.pm * BM + wr * 64 + fr, col0 = u.pn * BM + wc * 32 + 8 * fq;
        const int pn = u.pn;
        const int mode = (pn == 3 || pn == 4 || pn == 9 || pn == 10) ? 1 : ((pn == 5 || pn == 6) ? 2 : 0);
        if (pn >= 3 && pn <= 8 && u.pm < 64) {
            const int grp = (pn - 3) >> 1;
            bf16_t* T16 = HQ + (size_t)grp * ((size_t)NB * 4 * 128 * SEQ);
#pragma unroll
            for (int bj = 0; bj < 2; ++bj) { const int hd = ((pn - 3) & 1) * 2 + bj, k0 = wc * 32 + 8 * fq; const int c = hd * 128 + k0;
                f32x4 l0 = {0.f, 0.f, 0.f, 0.f}, l1 = l0; if (grp == 1) { l0 = *(const f32x4*)(lb + c); l1 = *(const f32x4*)(lb + c + 4); }
#pragma unroll
                for (int ai = 0; ai < 2; ++ai)
#pragma unroll
                    for (int m = 0; m < 4; ++m) { const int row = row0 + ai * HALF + m * 16; const int b_ = row >> 11, t_ = row & 2047;
                        const unsigned base = ((((unsigned)(b_ * 4 + hd) * 32u + (unsigned)(t_ >> 6)) * 4u + (unsigned)((t_ >> 4) & 3)) * 128u + (unsigned)k0) * 16u + (unsigned)(t_ & 15);
#pragma unroll
                        for (int n = 0; n < 2; ++n)
#pragma unroll
                            for (int e = 0; e < 4; ++e) { float z = acc[ai][bj][m][n][e]; const unsigned a = base + (unsigned)(4 * n + e) * 16u;
                                if (grp == 0) { z = z * __builtin_amdgcn_rcpf(1.f + __expf(-z)); T16[a] = (bf16_t)(cvt_pk_bf16(z, 0.f) & 0xffffu); }
                                else if (grp == 2) { T16[a] = (bf16_t)(cvt_pk_bf16(z, 0.f) & 0xffffu); }
                                else { z = fminf(fmaxf(z, -40.f), 40.f); const float lbv = n ? l1[e] : l0[e]; const float ez = __expf(-z);
                                    const float rz = __builtin_amdgcn_rcpf(1.f + ez); const float f = lbv + (1.f - lbv) * rz, kk = (1.f - lbv) * ez * rz;
                                    (void)kk; T16[a] = __builtin_bit_cast(unsigned short, (_Float16)__log2f(f)); } } } }
        } else if (mode == 2) {
#pragma unroll
            for (int bj = 0; bj < 2; ++bj) { const int c = col0 + bj * HALF - 1280;
                const f32x4 l0 = *(const f32x4*)(lb + c), l1 = *(const f32x4*)(lb + c + 4);
#pragma unroll
                for (int ai = 0; ai < 2; ++ai)
#pragma unroll
                    for (int m = 0; m < 4; ++m) { const size_t row = (size_t)(row0 + ai * HALF + m * 16);
                        f32x4 z0 = acc[ai][bj][m][0], z1 = acc[ai][bj][m][1]; f32x4 f0, f1, k0, k1;
#pragma unroll
                        for (int e = 0; e < 4; ++e) { z0[e] = fminf(fmaxf(z0[e], -40.f), 40.f); z1[e] = fminf(fmaxf(z1[e], -40.f), 40.f); }
#pragma unroll
                        for (int e = 0; e < 4; ++e) { const float ez0 = __expf(-z0[e]), ez1 = __expf(-z1[e]);
                            const float r0_ = __builtin_amdgcn_rcpf(1.f + ez0), r1_ = __builtin_amdgcn_rcpf(1.f + ez1);
                            f0[e] = l0[e] + (1.f - l0[e]) * r0_; k0[e] = (1.f - l0[e]) * ez0 * r0_;
                            f1[e] = l1[e] + (1.f - l1[e]) * r1_; k1[e] = (1.f - l1[e]) * ez1 * r1_; }
#pragma unroll
                        for (int e = 0; e < 4; ++e) { f0[e] = __log2f(f0[e]); f1[e] = __log2f(f1[e]); }
                        *(f32x4*)(LF + row * 512 + c) = f0; *(f32x4*)(LF + row * 512 + c + 4) = f1;
                        u32x4 w; w.x = cvt_pk_bf16(k0[0], k0[1]); w.y = cvt_pk_bf16(k0[2], k0[3]); w.z = cvt_pk_bf16(k1[0], k1[1]); w.w = cvt_pk_bf16(k1[2], k1[3]);
                        *(u32x4*)(P + row * PIN + col0 + bj * HALF) = w; } }
        } else {
#pragma unroll
            for (int ai = 0; ai < 2; ++ai)
#pragma unroll
                for (int m = 0; m < 4; ++m) { bf16_t* rowp = P + (size_t)(row0 + ai * HALF + m * 16) * PIN + col0;
#pragma unroll
                    for (int bj = 0; bj < 2; ++bj) { f32x4 v0 = acc[ai][bj][m][0], v1 = acc[ai][bj][m][1];
                        if (mode == 1) {
#pragma unroll
                            for (int e = 0; e < 4; ++e) { v0[e] = v0[e] * __builtin_amdgcn_rcpf(1.f + __expf(-v0[e])); v1[e] = v1[e] * __builtin_amdgcn_rcpf(1.f + __expf(-v1[e])); } }
                        u32x4 w; w.x = cvt_pk_bf16(v0[0], v0[1]); w.y = cvt_pk_bf16(v0[2], v0[3]); w.z = cvt_pk_bf16(v1[0], v1[1]); w.w = cvt_pk_bf16(v1[2], v1[3]);
                        *(u32x4*)(rowp + bj * HALF) = w; } }
        }
    }
};
struct EpiMemKV {
    static constexpr bool PERM = false, AFTER_DRAIN = false, ROWSCALE = false;
    float* OK; float* OV; bf16_t* MK; bf16_t* MVT;
    __device__ __forceinline__ void operator()(const f32x4 (&acc)[2][2][4][2], const Unit& u, int wr, int wc, int fr, int fq) const {
        const int layer = u.pm >> 3, pml = u.pm & 7, pnl = u.pn & 7;
        const int row0 = pml * BM + wr * 64 + fr; const int col0 = (pnl & 3) * BM + wc * 32 + 4 * fq;
        if (pnl < 4) {
            float* O = OK + (size_t)layer * 2048 * 1024; bf16_t* B = MK + (size_t)layer * 2048 * 1024;
#pragma unroll
            for (int ai = 0; ai < 2; ++ai)
#pragma unroll
                for (int m = 0; m < 4; ++m) { const size_t off = (size_t)(row0 + ai * HALF + m * 16) * 1024 + col0;
#pragma unroll
                    for (int bj = 0; bj < 2; ++bj)
#pragma unroll
                        for (int n = 0; n < 2; ++n) { const f32x4 v = acc[ai][bj][m][n]; *(f32x4*)(O + off + bj * HALF + n * 16) = v;
                            v2u w; w.x = cvt_pk_bf16(v[0], v[1]); w.y = cvt_pk_bf16(v[2], v[3]); *(v2u*)(B + off + bj * HALF + n * 16) = w; } }
        } else {
            float* O = OV + (size_t)layer * 2048 * 1024; bf16_t* T = MVT + (size_t)layer * 2048 * 1024;
#pragma unroll
            for (int ai = 0; ai < 2; ++ai)
#pragma unroll
                for (int m = 0; m < 4; ++m) { const int row = row0 + ai * HALF + m * 16; const size_t off = (size_t)row * 1024 + col0; const int b_ = row >> 8, mm = row & 255;
#pragma unroll
                    for (int bj = 0; bj < 2; ++bj)
#pragma unroll
                        for (int n = 0; n < 2; ++n) { const f32x4 v = acc[ai][bj][m][n]; *(f32x4*)(O + off + bj * HALF + n * 16) = v;
                            const int c = col0 + bj * HALF + n * 16; const int hd = c >> 8, d = c & 255;
                            bf16_t* tp = T + ((size_t)(b_ * 4 + hd) * 256 + d) * 256 + mm;
                            const unsigned w0 = cvt_pk_bf16(v[0], v[1]), w1 = cvt_pk_bf16(v[2], v[3]);
                            tp[0] = (bf16_t)(w0 & 0xffffu); tp[256] = (bf16_t)(w0 >> 16); tp[512] = (bf16_t)(w1 & 0xffffu); tp[768] = (bf16_t)(w1 >> 16); } }
        }
    }
};

template <int CTRL> __device__ __forceinline__ float dppf(float x) { return __builtin_bit_cast(float, __builtin_amdgcn_update_dpp(0, __builtin_bit_cast(int, x), CTRL, 0xf, 0xf, true)); }
struct EpiUpConv {
    static constexpr bool PERM = true, AFTER_DRAIN = false, ROWSCALE = true;
    bf16_t* G; bf16_t* UB; bf16_t* US; const float* rs; const float* cw; const float* cb;
    __device__ __forceinline__ void operator()(const f32x4 (&acc)[2][2][4][2], const Unit& u, int wr, int wc, int fr, int fq) const {
        const int c0 = u.pn * 128 + wc * 32 + 8 * fq;
        if (u.pm == 64) {
#pragma unroll
            for (int m = 0; m < 4; ++m) { bf16_t* rowp = US + (size_t)(wr * 64 + m * 16 + fr) * UPW + c0;
#pragma unroll
                for (int bj = 0; bj < 2; ++bj) { const f32x4 v0 = acc[0][bj][m][0], v1 = acc[0][bj][m][1];
                    u32x4 w; w.x = cvt_pk_bf16(v0[0], v0[1]); w.y = cvt_pk_bf16(v0[2], v0[3]); w.z = cvt_pk_bf16(v1[0], v1[1]); w.w = cvt_pk_bf16(v1[2], v1[3]);
                    *(u32x4*)(rowp + bj * DFF) = w; } }
            return;
        }
        const float k1 = (fr == 0) ? 1.f : 0.f, k2 = (fr < 2) ? 1.f : 0.f;
#pragma unroll
        for (int n = 0; n < 2; ++n) {
            const int cc = c0 + 4 * n;
            const f32x4 wa0 = *(const f32x4*)(cw + cc), wa1 = *(const f32x4*)(cw + UPW + cc), wa2 = *(const f32x4*)(cw + 2 * UPW + cc), ba = *(const f32x4*)(cb + cc);
            const f32x4 wb0 = *(const f32x4*)(cw + DFF + cc), wb1 = *(const f32x4*)(cw + UPW + DFF + cc), wb2 = *(const f32x4*)(cw + 2 * UPW + DFF + cc), bb = *(const f32x4*)(cb + DFF + cc);
#pragma unroll
            for (int ai = 0; ai < 2; ++ai) {
                const int blk = u.pm * 4 + ai * 2 + wr, rowbase = u.pm * BM + ai * HALF + wr * 64;
                const bool seqstart = ((u.pm & 7) == 0) && ai == 0 && wr == 0;
#pragma unroll
                for (int m = 0; m < 4; ++m) {
                    const f32x4 ca = acc[ai][0][m][n], cv = acc[ai][1][m][n];
                    f32x4 g;
#pragma unroll
                    for (int e = 0; e < 4; ++e) {
                        float a1 = dppf<0x111>(ca[e]), a2 = dppf<0x112>(ca[e]), b1 = dppf<0x111>(cv[e]), b2 = dppf<0x112>(cv[e]);
                        if (m > 0) { const float pa = acc[ai][0][m - 1][n][e], pb = acc[ai][1][m - 1][n][e];
                            a1 += k1 * dppf<0x121>(pa); a2 += k2 * dppf<0x122>(pa); b1 += k1 * dppf<0x121>(pb); b2 += k2 * dppf<0x122>(pb); }
                        const float A = ba[e] + wa0[e] * a2 + wa1[e] * a1 + wa2[e] * ca[e];
                        const float B = bb[e] + wb0[e] * b2 + wb1[e] * b1 + wb2[e] * cv[e];
                        g[e] = A * __builtin_amdgcn_rcpf(1.f + __expf(-A)) * B;
                    }
                    const int row = rowbase + 16 * m + fr;
                    if (m > 0 || fr >= 2 || seqstart) { v2u w; w.x = cvt_pk_bf16(g[0], g[1]); w.y = cvt_pk_bf16(g[2], g[3]); *(v2u*)(G + (size_t)row * DFF + cc) = w; }
                    if ((m == 3 && fr >= 14) || (m == 0 && fr < 2)) { const int slot = (m == 3) ? fr - 14 : 2 + fr; bf16_t* up = UB + ((size_t)(blk * 4 + slot)) * UPW + cc;
                        v2u wa_; wa_.x = cvt_pk_bf16(ca[0], ca[1]); wa_.y = cvt_pk_bf16(ca[2], ca[3]); *(v2u*)up = wa_;
                        v2u wb_; wb_.x = cvt_pk_bf16(cv[0], cv[1]); wb_.y = cvt_pk_bf16(cv[2], cv[3]); *(v2u*)(up + DFF) = wb_; }
                }
            }
        }
    }
};
struct BlockDiagOrder {
    int G, c;
    __device__ __forceinline__ bool next(int i, Unit& u) const { const int L = i * G + c; if (L >= 256) return false; const int layer = L >> 6, r = L & 63; u.pm = layer * 8 + (r & 7); u.pn = layer * 8 + (r >> 3); return true; }
    __device__ __forceinline__ void a_ready(const Unit&) const {}
    __device__ __forceinline__ void done(const Unit&) const {}
};
}
#define XB_TMO      128
#define XB_XCNT(j)  (256  + 64 * (j))
#define XB_XSUB(j)  (1280 + 64 * (j))
#define XB_XGEN(j)  (2304 + 64 * (j))
#define XB_TOP      3328
#define XB_TOPGEN   3392
#define XCD_BAR_WORDS 3456
#define XB_SPIN_CAP (1u << 18)

__device__ __forceinline__ unsigned xb_ld(unsigned* p)              { return __hip_atomic_load(p, __ATOMIC_RELAXED, __HIP_MEMORY_SCOPE_AGENT); }
__device__ __forceinline__ unsigned xb_add(unsigned* p, unsigned v) { return __hip_atomic_fetch_add(p, v, __ATOMIC_RELAXED, __HIP_MEMORY_SCOPE_AGENT); }
__device__ __forceinline__ unsigned xb_xcc_id() { return (unsigned)__builtin_amdgcn_s_getreg((3 << 11) | 20) & 0xFu; }
#define XB_SPIN(cond, bar) do { unsigned _sp = 0; while (cond) { __builtin_amdgcn_s_sleep(1); \
    if ((++_sp & 255u) == 0u) { if (xb_ld(&(bar)[XB_TMO])) break; if (_sp > XB_SPIN_CAP) { atomicAdd(&(bar)[XB_TMO], 1u); break; } } } } while (0)

struct XcdBarrier {
    unsigned* bar; unsigned x;
    volatile LAS unsigned* st;
};

__device__ __forceinline__ XcdBarrier xcd_barrier_post(unsigned* bar, volatile LAS unsigned* st) {
    XcdBarrier b; b.bar = bar; b.x = xb_xcc_id(); b.st = st;
    if (threadIdx.x == 0) (void)xb_add(&bar[XB_XCNT(b.x)], 1u);
    return b;
}
__device__ __forceinline__ void xcd_barrier_complete(unsigned* bar, unsigned x, unsigned& nloc, unsigned& nx) {
    const unsigned G = gridDim.x * gridDim.y * gridDim.z;
    unsigned sum, cnt, mine, sp = 0u;
    for (;;) {
        sum = 0u; cnt = 0u; mine = 0u;
#pragma unroll
        for (unsigned j = 0; j < 16; ++j) { const unsigned c = xb_ld(&bar[XB_XCNT(j)]); sum += c; cnt += (c > 0u) ? 1u : 0u; mine = (j == x) ? c : mine; }
        if (sum == G) break;
        __builtin_amdgcn_s_sleep(1);
        if ((++sp & 255u) == 0u) { if (xb_ld(&bar[XB_TMO])) break; if (sp > XB_SPIN_CAP) { atomicAdd(&bar[XB_TMO], 1u); break; } }
    }
    nloc = mine > 0u ? mine : 1u; nx = cnt > 0u ? cnt : 1u;
}

__device__ __forceinline__ void xcd_barrier(const XcdBarrier& b) {
    asm volatile("s_waitcnt vmcnt(0)" ::: "memory");
    __syncthreads();
    if (threadIdx.x == 0) {
        unsigned* bar = b.bar;
        __builtin_amdgcn_s_waitcnt(0);
        unsigned nloc = b.st[0], nx = b.st[1];
        if (nloc == 0u) { xcd_barrier_complete(bar, b.x, nloc, nx); b.st[0] = nloc; b.st[1] = nx; }
        const unsigned old = xb_add(&bar[XB_XSUB(b.x)], 1u);
        const unsigned gen = old / nloc;
        if (old + 1u == (gen + 1u) * nloc) {
            __builtin_amdgcn_fence(__ATOMIC_RELEASE, "agent");
            asm volatile("s_waitcnt vmcnt(0)" ::: "memory");
            const unsigned og = xb_add(&bar[XB_TOP], 1u);
            const unsigned tg = og / nx;
            if (og + 1u == (tg + 1u) * nx) xb_add(&bar[XB_TOPGEN], 1u);
            else XB_SPIN(xb_ld(&bar[XB_TOPGEN]) == tg, bar);
            __builtin_amdgcn_fence(__ATOMIC_ACQUIRE, "agent");
            xb_add(&bar[XB_XGEN(b.x)], 1u);
            asm volatile("s_waitcnt vmcnt(0)" ::: "memory");
        } else {
            XB_SPIN(xb_ld(&bar[XB_XGEN(b.x)]) == gen, bar);
            __builtin_amdgcn_fence(__ATOMIC_ACQUIRE, "agent");
            asm volatile("s_waitcnt vmcnt(0)" ::: "memory");
        }
    }
    __syncthreads();
}

struct Frame {
    LAS unsigned char* lds;
    volatile LAS unsigned* MISC;
    unsigned* ctl;
    int tid, lane, wave, G, gw, ngw, vcu;
    const float* const* in; float* out; unsigned char* ws;
};
#define IN_XP 0
#define IN_XS 1
#define IN_CWK 2
#define IN_CWV 3
#define IN_CMK 4
#define IN_CMV 5
#define IN_SH 6
#define IN_CFC 7
#define IN_MEM 8
#define IN_WIN 9
#define IN_WO 10
#define IN_SINK 11
#define IN_LBL 12
#define IN_HN 13
#define IN_WXQ 14
#define IN_WXK 15
#define IN_WXV 16
#define IN_WXO 17
#define IN_WUP 18
#define IN_CW 19
#define IN_CB 20
#define IN_WDN 21
#define IN_GPM 22
#define IN_GQM 23
#define IN_GPX 24
#define IN_GQX 25
#define IN_GMEM 26
#define IN_GPF 27
#define IN_GQF 28

__device__ __forceinline__ void p0_transpose_item(const float* W, int K, int N, bf16* WT, int row_off, LAS float* scr, int item, int lane, const float* gk = nullptr, bf16* WTT = nullptr) {
    const int nblk = N / 32, kb = item / nblk, nb = item % nblk, k0 = 64 * kb, n0 = 32 * nb;
#pragma unroll 8
    for (int i = 0; i < 32; ++i) { const int kk = 2 * i + (lane >> 5); scr[kk * 33 + (lane & 31)] = W[(size_t)(k0 + kk) * N + n0 + (lane & 31)]; }
    LDS_WAIT(); asm volatile("" ::: "memory");
    const int c = lane & 7;
    float g8[8];
    if (gk) { const f32x4 a_ = *(const f32x4*)(gk + k0 + 8 * c), b_ = *(const f32x4*)(gk + k0 + 8 * c + 4); g8[0] = a_.x; g8[1] = a_.y; g8[2] = a_.z; g8[3] = a_.w; g8[4] = b_.x; g8[5] = b_.y; g8[6] = b_.z; g8[7] = b_.w; } else {
#pragma unroll
        for (int e = 0; e < 8; ++e) g8[e] = 1.f; }
#pragma unroll
    for (int j = 0; j < 4; ++j) { const int n = (lane >> 3) + 8 * j; const LAS float* s = scr + (8 * c) * 33 + n;
        v4u o; o.x = cvtpk(s[0 * 33] * g8[0], s[1 * 33] * g8[1]); o.y = cvtpk(s[2 * 33] * g8[2], s[3 * 33] * g8[3]); o.z = cvtpk(s[4 * 33] * g8[4], s[5 * 33] * g8[5]); o.w = cvtpk(s[6 * 33] * g8[6], s[7 * 33] * g8[7]);
        *(GAS v4u*)(WT + (size_t)(row_off + n0 + n) * K + k0 + 8 * c) = o;
        if (WTT) { const int nn = n0 + n, kk_ = k0 + 8 * c; *(GAS v4u*)(WTT + ((size_t)((nn >> 4) * (K >> 5) + (kk_ >> 5)) * 64 + ((kk_ & 31) >> 3) * 16 + (nn & 15)) * 8) = o; } }
    LDS_WAIT(); asm volatile("" ::: "memory");
}
__device__ __forceinline__ void row_load(const float* p, int lane, f32x4 (&v)[4]) {
    const GAS f32x4* r = (const GAS f32x4*)p + lane;
#pragma unroll
    for (int j = 0; j < 4; ++j) v[j] = r[64 * j];
}
__device__ __forceinline__ float row_ss(const f32x4 (&v)[4]) {
    float s = 0.f;
#pragma unroll
    for (int j = 0; j < 4; ++j) s += (v[j].x * v[j].x + v[j].y * v[j].y) + (v[j].z * v[j].z + v[j].w * v[j].w);
    return wave_sum(s);
}
__device__ __forceinline__ void row_store_bf16(bf16* p, int lane, const f32x4 (&v)[4]) {
    GAS unsigned long long* o8 = (GAS unsigned long long*)p + lane;
#pragma unroll
    for (int j = 0; j < 4; ++j) o8[64 * j] = (unsigned long long)pk2(v[j].x, v[j].y) | ((unsigned long long)pk2(v[j].z, v[j].w) << 32);
}
__device__ __forceinline__ void row_store_f32(float* p, int lane, const f32x4 (&v)[4]) {
    GAS f32x4* r = (GAS f32x4*)p + lane;
#pragma unroll
    for (int j = 0; j < 4; ++j) r[64 * j] = v[j];
}

__device__ __forceinline__ void p0_prologue(Frame& F) {
    LAS float* scr = (LAS float*)(F.lds + RING_OFF + F.wave * 16384);
    unsigned char* ws = F.ws;
    constexpr int I_IN = 16 * (PIN / 32), I_SQ = 16 * (DM / 32), I_UP = 16 * (UPW / 32), I_DN = (DFF / 64) * (DM / 32);
    constexpr int I_LAYER = I_IN + 5 * I_SQ + I_UP + I_DN;
    for (int it = F.gw; it < DEPTH * I_LAYER; it += F.ngw) {
        const int l = it / I_LAYER; int r = it % I_LAYER;
        if (r < I_IN) { p0_transpose_item(F.in[IN_WIN] + (size_t)l * DM * PIN, DM, PIN, (bf16*)(ws + WS_WIN) + (size_t)l * PIN * DM, 0, scr, r, F.lane); continue; } r -= I_IN;
        if (r < I_SQ) { p0_transpose_item(F.in[IN_WO] + (size_t)l * DM * DM, DM, DM, (bf16*)(ws + WS_WO) + (size_t)l * DM * DM, 0, scr, r, F.lane); continue; } r -= I_SQ;
        if (r < I_SQ) { p0_transpose_item(F.in[IN_WXQ] + (size_t)l * DM * DM, DM, DM, (bf16*)(ws + WS_WXQ) + (size_t)l * DM * DM, 0, scr, r, F.lane, F.in[IN_GPX] + l * DM); continue; } r -= I_SQ;
        if (r < I_SQ) { p0_transpose_item(F.in[IN_WXK] + (size_t)l * DM * DM, DM, DM, (bf16*)(ws + WS_WXKV) + (size_t)l * 2 * DM * DM, 0, scr, r, F.lane); continue; } r -= I_SQ;
        if (r < I_SQ) { p0_transpose_item(F.in[IN_WXV] + (size_t)l * DM * DM, DM, DM, (bf16*)(ws + WS_WXKV) + (size_t)l * 2 * DM * DM, DM, scr, r, F.lane); continue; } r -= I_SQ;
        if (r < I_SQ) { p0_transpose_item(F.in[IN_WXO] + (size_t)l * DM * DM, DM, DM, (bf16*)(ws + WS_WXO) + (size_t)l * DM * DM, 0, scr, r, F.lane); continue; } r -= I_SQ;
        if (r < I_UP) { const int n0_ = 32 * (r % (UPW / 32));
            const int cA_ = n0_ < DFF ? n0_ : n0_ - DFF; const int dst_ = 256 * (cA_ / 128) + (cA_ % 128) + (n0_ < DFF ? 0 : 128);
            p0_transpose_item(F.in[IN_WUP] + (size_t)l * DM * UPW, DM, UPW, (bf16*)(ws + WS_WUP) + (size_t)l * UPW * DM, dst_ - n0_, scr, r, F.lane, F.in[IN_GPF] + l * DM); continue; } r -= I_UP;
        p0_transpose_item(F.in[IN_WDN] + (size_t)l * DFF * DM, DFF, DM, (bf16*)(ws + WS_WDN) + (size_t)l * DM * DFF, 0, scr, r, F.lane);
    }
    {
        f32x4 g[4]; row_load(F.in[IN_GPM], F.lane, g);
        for (int m = F.gw; m < MR; m += F.ngw) {
            const float* src = (m < MP) ? F.in[IN_XP] + (size_t)m * DM : F.in[IN_XS] + (size_t)(m - MP) * DM;
            f32x4 v[4]; row_load(src, F.lane, v);
            row_store_bf16((bf16*)(ws + WS_X) + (size_t)m * DM, F.lane, v);
            const float r = rsqrtf(row_ss(v) * (1.f / DM) + EPS);
#pragma unroll
            for (int j = 0; j < 4; ++j) v[j] = v[j] * r * g[j];
            row_store_bf16((bf16*)(ws + WS_XN) + (size_t)m * DM, F.lane, v);
        }
    }
    for (int m = F.gw; m < NB * NMEM; m += F.ngw) {
        f32x4 v[4]; row_load(F.in[IN_MEM] + (size_t)m * DM, F.lane, v);
        const float r = rsqrtf(row_ss(v) * (1.f / DM) + EPS);
        for (int l = 0; l < DEPTH; ++l) { f32x4 g[4], o[4]; row_load(F.in[IN_GMEM] + (size_t)l * DM, F.lane, g);
#pragma unroll
            for (int j = 0; j < 4; ++j) o[j] = v[j] * r * g[j];
            row_store_bf16((bf16*)(ws + WS_MEMN) + ((size_t)l * 2048 + m) * DM, F.lane, o); }
    }
    {
        float* cs = (float*)(ws + WS_TAB + TAB_COS); float* sn = (float*)(ws + WS_TAB + TAB_SIN); float* lbt = (float*)(ws + WS_TAB + TAB_LB);
        const int gt = blockIdx.x * NTHR + F.tid; constexpr int nt = GRID * NTHR;
        for (int i = gt; i < 2049 * 32; i += nt) { const int p = i >> 5, d = i & 31; const double pos = (p == 2048) ? (double)PAST : (double)p;
            const double inv = pow(10000.0, -(double)d / 32.0); const double a = pos * inv; cs[i] = (float)cos(a); sn[i] = (float)sin(a); }
        for (int c = gt; c < 512; c += nt) { float z[DEPTH], mx = -1e30f;
            for (int l = 0; l < DEPTH; ++l) { z[l] = F.in[IN_LBL][l * 512 + c]; mx = fmaxf(mx, z[l]); }
            float s = 0.f; for (int l = 0; l < DEPTH; ++l) { z[l] = expf(z[l] - mx); s += z[l]; }
            float cum = 0.f, c0 = 0.f; for (int l = 0; l < DEPTH; ++l) { cum += z[l] / s; if (l == 0) c0 = cum; lbt[l * 512 + c] = cum - c0; } }
    }
}

__device__ __forceinline__ void row_load_bf16(const bf16* p, int lane, f32x4 (&v)[4]) {
    const GAS v2u* r = (const GAS v2u*)p + lane;
#pragma unroll
    for (int j = 0; j < 4; ++j) { const v2u w = r[64 * j]; v[j] = (f32x4){bflo(w.x), bfhi(w.x), bflo(w.y), bfhi(w.y)}; }
}
__device__ __forceinline__ void norm_row(Frame& F, int m, f32x4 (&y)[4], f32x4 (&x)[4], const f32x4 (&gq)[4], const f32x4 (&gp)[4], bool final_, bool xn_) {
    unsigned char* ws = F.ws;
    const float r = rsqrtf(row_ss(y) * (1.f / DM) + EPS);
#pragma unroll
    for (int j = 0; j < 4; ++j) x[j] = x[j] + y[j] * r * gq[j];
    if (final_) { float* o = (m < MP) ? F.out + O_YP + (size_t)m * DM : F.out + O_YS + (size_t)(m - MP) * DM; row_store_f32(o, F.lane, x); }
    else {
        row_store_bf16((bf16*)(ws + WS_X) + (size_t)m * DM, F.lane, x);
        const float r2 = rsqrtf(row_ss(x) * (1.f / DM) + EPS);
        if (xn_) {
#pragma unroll
            for (int j = 0; j < 4; ++j) x[j] = x[j] * r2 * gp[j];
            row_store_bf16((bf16*)(ws + WS_XN) + (size_t)m * DM, F.lane, x);
        } else if (F.lane == 0) ((float*)(ws + WS_RS))[m] = r2;
    }
}
__device__ __forceinline__ void norm_phase(Frame& F, const float* gpost, const float* gpre, bool final_) {
    unsigned char* ws = F.ws;
    f32x4 gq[4], gp[4]; row_load(gpost, F.lane, gq); row_load(gpre ? gpre : gpost, F.lane, gp);
    const bool xn_ = gpre != nullptr;
    const bf16* Y = (const bf16*)(ws + WS_Y); const bf16* X = (const bf16*)(ws + WS_X);
    const int rbeg = F.vcu * 65, rend = (rbeg + 65 < MR) ? rbeg + 65 : MR;
    for (int m = rbeg + F.wave; m < rend; m += 16) {
        const int m2 = m + 8; const bool two = m2 < rend;
        f32x4 y0[4], x0[4], y1[4], x1[4];
        row_load_bf16(Y + (size_t)m * DM, F.lane, y0); row_load_bf16(X + (size_t)m * DM, F.lane, x0);
        if (two) { row_load_bf16(Y + (size_t)m2 * DM, F.lane, y1); row_load_bf16(X + (size_t)m2 * DM, F.lane, x1); }
        norm_row(F, m, y0, x0, gq, gp, final_, xn_);
        if (two) norm_row(F, m2, y1, x1, gq, gp, final_, xn_);
    }
}

__device__ __forceinline__ void unpack8(const v4u w, float (&f)[8]) {
    f[0] = bflo(w.x); f[1] = bfhi(w.x); f[2] = bflo(w.y); f[3] = bfhi(w.y); f[4] = bflo(w.z); f[5] = bfhi(w.z); f[6] = bflo(w.w); f[7] = bfhi(w.w);
}
__device__ __forceinline__ void load8f(const float* p, float (&f)[8]) { const f32x4 a = *(const f32x4*)p, b = *(const f32x4*)(p + 4); f[0] = a.x; f[1] = a.y; f[2] = a.z; f[3] = a.w; f[4] = b.x; f[5] = b.y; f[6] = b.z; f[7] = b.w; }

__device__ __forceinline__ void conv_phase(Frame& F, int l) {
    unsigned char* ws = F.ws;
    const bf16* UB = (const bf16*)(ws + WS_U); const bf16* US = UB + (size_t)256 * 4 * UPW; bf16* Gb = (bf16*)(ws + WS_G);
    const float* cw = F.in[IN_CW] + (size_t)l * 3 * UPW; const float* cb = F.in[IN_CB] + (size_t)l * UPW;
    const float* cfc = F.in[IN_CFC] + (size_t)l * DB * 2 * UPW;
    const int gt = blockIdx.x * NTHR + F.tid; constexpr int nthr = GRID * NTHR;
    constexpr int NCG = DFF / 8;
    constexpr int N_P = 256 * 2 * NCG, N_S = MS * NCG;
    for (int it = gt; it < N_P + N_S; it += nthr) {
        const bool samp = it >= N_P; const int it2 = samp ? it - N_P : it;
        const int cg = it2 % NCG, c0 = cg * 8;
        float wa[3][8], wb[3][8], ba[8], bb[8];
#pragma unroll
        for (int j = 0; j < 3; ++j) { load8f(cw + j * UPW + c0, wa[j]); load8f(cw + j * UPW + DFF + c0, wb[j]); }
        load8f(cb + c0, ba); load8f(cb + DFF + c0, bb);
        float a2[8], a1[8], b2[8], b1[8], a0[8], b0[8]; int grow;
        if (samp) {
            const int sr = it2 / NCG; grow = MP + sr; const float* c = cfc + (size_t)sr * 2 * UPW;
            load8f(c + c0, a2); load8f(c + DFF + c0, b2); load8f(c + UPW + c0, a1); load8f(c + UPW + DFF + c0, b1);
            unpack8(*(const v4u*)(US + (size_t)sr * UPW + c0), a0); unpack8(*(const v4u*)(US + (size_t)sr * UPW + DFF + c0), b0);
        } else {
            const int k = it2 / (2 * NCG), j = (it2 / NCG) & 1;
            if ((k & 31) == 0) continue;
            grow = 64 * k + j;
            const bf16* r2 = UB + ((size_t)((k - 1) * 4 + j)) * UPW;
            const bf16* r1 = j ? UB + ((size_t)(k * 4 + 2)) * UPW : UB + ((size_t)((k - 1) * 4 + 1)) * UPW;
            const bf16* r0 = UB + ((size_t)(k * 4 + 2 + j)) * UPW;
            unpack8(*(const v4u*)(r2 + c0), a2); unpack8(*(const v4u*)(r2 + DFF + c0), b2); unpack8(*(const v4u*)(r1 + c0), a1); unpack8(*(const v4u*)(r1 + DFF + c0), b1);
            unpack8(*(const v4u*)(r0 + c0), a0); unpack8(*(const v4u*)(r0 + DFF + c0), b0);
        }
        float o[8];
#pragma unroll
        for (int e = 0; e < 8; ++e) { const float a = ba[e] + wa[0][e] * a2[e] + wa[1][e] * a1[e] + wa[2][e] * a0[e]; const float b = bb[e] + wb[0][e] * b2[e] + wb[1][e] * b1[e] + wb[2][e] * b0[e]; o[e] = siluf_(a) * b; }
        *(v4u*)(Gb + (size_t)grow * DFF + c0) = (v4u){cvtpk(o[0], o[1]), cvtpk(o[2], o[3]), cvtpk(o[4], o[5]), cvtpk(o[6], o[7])};
    }
    float* ocp = F.out + O_CP + (size_t)l * NB * 2 * UPW; float* ocs = F.out + O_CS + (size_t)l * DB * 2 * UPW;
    for (int i = gt; i < NB * 2 * UPW; i += nthr) { const int b = i / (2 * UPW), j = (i / UPW) % 2, c = i % UPW; ocp[i] = bf2f(UB[((size_t)((b * 32 + 31) * 4 + j)) * UPW + c]); }
    for (int i = gt; i < DB * 2 * UPW; i += nthr) { const int s = i / (2 * UPW), j = (i / UPW) % 2, c = i % UPW;
        ocs[i] = (j == 0) ? cfc[(size_t)s * 2 * UPW + UPW + c] : bf2f(US[(size_t)s * UPW + c]); }
}

__device__ __forceinline__ void xattn_unit_sample(Frame& F, int l, int s, int h) {
    unsigned char* ws = F.ws; const bf16* QX = (const bf16*)(ws + WS_QX); bf16* OX = (bf16*)(ws + WS_OX);
    const int lane = F.lane, wave = F.wave, m = MP + s;
    LAS float* scl = (LAS float*)(F.lds + RING_OFF); LAS float* part = scl + 256;
    const v2u qw = *(const v2u*)(QX + (size_t)m * DM + h * 256 + 4 * lane);
    const f32x4 q = {bflo(qw.x), bfhi(qw.x), bflo(qw.y), bfhi(qw.y)};
    const GAS f32x4* CK = (const GAS f32x4*)(F.in[IN_CMK] + ((size_t)(l * DB + s) * 256 + 32 * wave) * DM + h * 256) + lane;
    const GAS f32x4* CV = (const GAS f32x4*)(F.in[IN_CMV] + ((size_t)(l * DB + s) * 256 + 32 * wave) * DM + h * 256) + lane;
    LDS_BAR();
    {
        f32x4 k[32];
#pragma unroll
        for (int i = 0; i < 32; ++i) k[i] = CK[(size_t)i * (DM / 4)];
#pragma unroll
        for (int i = 0; i < 32; ++i) { const float d = wave_sum((k[i].x * q.x + k[i].y * q.y) + (k[i].z * q.z + k[i].w * q.w)); if (lane == 0) scl[32 * wave + i] = d; }
    }
    f32x4 v[32];
#pragma unroll
    for (int i = 0; i < 32; ++i) v[i] = CV[(size_t)i * (DM / 4)];
    LDS_BAR();
    float mx, inv;
    { const float s0 = scl[lane], s1 = scl[64 + lane], s2 = scl[128 + lane], s3 = scl[192 + lane];
      mx = wave_max(fmaxf(fmaxf(s0, s1), fmaxf(s2, s3)));
      inv = 1.f / wave_sum((exp2f(s0 - mx) + exp2f(s1 - mx)) + (exp2f(s2 - mx) + exp2f(s3 - mx))); }
    f32x4 o = {0.f, 0.f, 0.f, 0.f};
#pragma unroll
    for (int i = 0; i < 32; ++i) { const float p = exp2f(scl[32 * wave + i] - mx); o = o + v[i] * p; }
    *(LAS f32x4*)(part + wave * 256 + 4 * lane) = o;
    LDS_BAR();
    if (F.tid < 256) { float t = 0.f;
#pragma unroll
        for (int w = 0; w < 8; ++w) t += part[w * 256 + F.tid];
        OX[(size_t)m * DM + h * 256 + F.tid] = (bf16)(cvtpk(t * inv, 0.f) & 0xffffu); }
}

__device__ __forceinline__ void hgrn_unit_sample(Frame& F, int l, int s) {
    unsigned char* ws = F.ws; const bf16* P = (const bf16*)(ws + WS_PROJ); bf16* MIX = (bf16*)(ws + WS_MIX); const float* LFp = (const float*)(ws + WS_LF);
    const int lane = F.lane, wave = F.wave, m = MP + s, hd = wave >> 1, kh = wave & 1, vq = lane & 31, kp = lane >> 5;
    LAS float* wl = (LAS float*)(F.lds + RING_OFF + 102400 + wave * 2048);
    LAS f32x4* red = (LAS f32x4*)(F.lds + RING_OFF + 98304);
    LDS_BAR();
    { const int k = 64 * kh + lane; wl[lane] = exp2f(LFp[(size_t)m * 512 + hd * 128 + k]); wl[64 + lane] = bf2f(P[(size_t)m * PIN + C_FR + hd * 128 + k]); wl[128 + lane] = bf2f(P[(size_t)m * PIN + C_QR + hd * 128 + k]); }
    LDS_WAIT(); asm volatile("" ::: "memory");
    const v2u vw = *(const v2u*)(P + (size_t)m * PIN + C_IR + hd * 128 + 4 * vq);
    const f32x4 vv = {bflo(vw.x), bfhi(vw.x), bflo(vw.y), bfhi(vw.y)};
    const size_t sb = (((size_t)(l * DB + s) * 4 + hd) * 128 + 64 * kh) * 128 + 4 * vq;
    const GAS float* S0 = (const GAS float*)F.in[IN_SH] + sb; GAS float* S1 = (GAS float*)F.out + O_HS + sb;
    f32x4 o = {0.f, 0.f, 0.f, 0.f};
#pragma unroll 1
    for (int g = 0; g < 4; ++g) {
        f32x4 s0[8];
#pragma unroll
        for (int i = 0; i < 8; ++i) s0[i] = *(const GAS f32x4*)(S0 + (size_t)(16 * g + 2 * i + kp) * 128);
#pragma unroll
        for (int i = 0; i < 8; ++i) { const int kr = 16 * g + 2 * i + kp; const float f = wl[kr], kk = wl[64 + kr], q = wl[128 + kr];
            const f32x4 s1 = s0[i] * f + vv * kk; *(GAS f32x4*)(S1 + (size_t)kr * 128) = s1; o = o + s1 * q; }
    }
    o.x += __shfl_xor(o.x, 32); o.y += __shfl_xor(o.y, 32); o.z += __shfl_xor(o.z, 32); o.w += __shfl_xor(o.w, 32);
    if (lane < 32) red[wave * 32 + vq] = o;
    LDS_BAR();
    o = red[(2 * hd) * 32 + vq] + red[(2 * hd + 1) * 32 + vq];
    float ss = (o.x * o.x + o.y * o.y) + (o.z * o.z + o.w * o.w);
    ss += __shfl_xor(ss, 1); ss += __shfl_xor(ss, 2); ss += __shfl_xor(ss, 4); ss += __shfl_xor(ss, 8); ss += __shfl_xor(ss, 16);
    const float r = rsqrtf(ss * (1.f / 128.f) + EPS);
    if (kh == 0 && lane < 32) { const f32x4 g4 = *(const f32x4*)(F.in[IN_HN] + l * 512 + hd * 128 + 4 * vq); const v2u gw = *(const v2u*)(P + (size_t)m * PIN + C_GR + hd * 128 + 4 * vq);
        v2u w; w.x = cvtpk(o.x * r * g4.x * bflo(gw.x), o.y * r * g4.y * bfhi(gw.x)); w.y = cvtpk(o.z * r * g4.z * bflo(gw.y), o.w * r * g4.w * bfhi(gw.y));
        *(v2u*)(MIX + (size_t)m * DM + 512 + hd * 128 + 4 * vq) = w; }
}
__device__ __forceinline__ void swa_unit_sample(Frame& F, int l, int s) {
    unsigned char* ws = F.ws; const bf16* P = (const bf16*)(ws + WS_PROJ); bf16* MIX = (bf16*)(ws + WS_MIX);
    const float* cs = (const float*)(ws + WS_TAB + TAB_COS) + 2048 * 32; const float* sn = (const float*)(ws + WS_TAB + TAB_SIN) + 2048 * 32;
    constexpr int RS = 136;
    LAS unsigned char* KL = F.lds + RING_OFF; LAS unsigned char* VL = KL + 128 * RS * 2;
    const int lane = F.lane, h = F.wave, m = MP + s, kvh = h >> 2;
    LAS float* wl = (LAS float*)(F.lds + RING_OFF + 102400 + h * 2048);
    const GAS float* ck = (const GAS float*)F.in[IN_CWK] + (size_t)(l * DB + s) * 128 * 128; const GAS float* cv = (const GAS float*)F.in[IN_CWV] + (size_t)(l * DB + s) * 128 * 128;
    LDS_BAR();
    { f32x4 kx[8], vx[8];
#pragma unroll
      for (int i = 0; i < 8; ++i) { const int ch = F.tid + 512 * i; kx[i] = *(const GAS f32x4*)(ck + (size_t)(ch >> 5) * 128 + 4 * (ch & 31)); vx[i] = *(const GAS f32x4*)(cv + (size_t)(ch >> 5) * 128 + 4 * (ch & 31)); }
#pragma unroll
      for (int i = 0; i < 8; ++i) { const int ch = F.tid + 512 * i; const int off = ((ch >> 5) * RS + 4 * (ch & 31)) * 2;
          *(LAS v2u*)(KL + off) = (v2u){cvtpk(kx[i].x, kx[i].y), cvtpk(kx[i].z, kx[i].w)}; *(LAS v2u*)(VL + off) = (v2u){cvtpk(vx[i].x, vx[i].y), cvtpk(vx[i].z, vx[i].w)}; } }
    float knew = 0.f;
    { const int d = lane & 31; const float c = cs[d], sv = sn[d];
      const float q1 = bf2f(P[(size_t)m * PIN + h * 64 + d]), q2 = bf2f(P[(size_t)m * PIN + h * 64 + 32 + d]);
      const float k1 = bf2f(P[(size_t)m * PIN + C_K + kvh * 64 + d]), k2 = bf2f(P[(size_t)m * PIN + C_K + kvh * 64 + 32 + d]);
      if (lane < 32) { wl[lane] = (q1 * c - q2 * sv) * 0.125f; knew = k1 * c - k2 * sv; } else { wl[lane] = (q2 * c + q1 * sv) * 0.125f; knew = k2 * c + k1 * sv; } }
    const float vnew = bf2f(P[(size_t)m * PIN + C_V + kvh * 64 + lane]);
    if ((h & 3) == 0) { F.out[O_WKS + ((size_t)(l * DB + s) * 2 + kvh) * 64 + lane] = knew; F.out[O_WVS + ((size_t)(l * DB + s) * 2 + kvh) * 64 + lane] = vnew; }
    LDS_BAR();
    const float snew = wave_sum(wl[lane] * knew);
    float sc[2];
#pragma unroll
    for (int i = 0; i < 2; ++i) { const LAS unsigned char* kr = KL + ((lane + 64 * i) * RS + kvh * 64) * 2; float acc = 0.f;
#pragma unroll
        for (int c8 = 0; c8 < 8; ++c8) { float kf[8]; unpack8(*(const LAS v4u*)(kr + 16 * c8), kf);
#pragma unroll
            for (int e = 0; e < 8; ++e) acc += wl[c8 * 8 + e] * kf[e]; }
        sc[i] = acc; }
    const float sink = F.in[IN_SINK][l * 8 + h];
    const float mx = fmaxf(fmaxf(wave_max(fmaxf(sc[0], sc[1])), snew), sink);
    const float p0 = __expf(sc[0] - mx), p1 = __expf(sc[1] - mx), pn = __expf(snew - mx);
    const float den = wave_sum(p0 + p1) + pn + __expf(sink - mx);
    wl[64 + lane] = p0; wl[128 + lane] = p1;
    LDS_WAIT(); asm volatile("" ::: "memory");
    float o = pn * vnew;
    const LAS bf16* vp = (const LAS bf16*)VL + kvh * 64 + lane;
#pragma unroll 8
    for (int j = 0; j < 128; ++j) o += wl[64 + j] * bf2f(vp[j * RS]);
    MIX[(size_t)m * DM + h * 64 + lane] = (bf16)(cvtpk(o / den, 0.f) & 0xffffu);
}

__device__ __forceinline__ void hgrn_pass1(Frame& F, int l, int b, int h, int seg) {
    unsigned char* ws = F.ws; bf16* QB = (bf16*)(ws + WS_HQB); bf16* OP = (bf16*)(ws + WS_HOP);
    constexpr int RSK = 136, RST = 72;
    constexpr int O_QT = 0, O_KT = O_QT + 64 * RSK * 2, O_KTT = O_KT + 64 * RSK * 2, O_VT = O_KTT + 128 * RST * 2, O_SP = O_VT + 128 * RST * 2,
                  O_SEG = O_SP + 128 * RSK * 2, O_EB = O_SEG + 2048, O_EBR = O_EB + 512, O_SSQ = O_EBR + 512, O_ENDL = O_SSQ + 1024;
    static_assert(O_ENDL <= RING_BYTES, "hgrn LDS map");
    LAS unsigned char* L = F.lds + RING_OFF;
    LAS bf16* QT = (LAS bf16*)(L + O_QT); LAS bf16* KT = (LAS bf16*)(L + O_KT);
    LAS float* SEG = (LAS float*)(L + O_SEG); LAS float* EB = (LAS float*)(L + O_EB); LAS float* EBR = (LAS float*)(L + O_EBR);
    const int tid = F.tid, lane = F.lane, wave = F.wave;
    const int vt = wave >> 1, tt = wave & 1;
    int k = tid & 127, sg = tid >> 7, l32 = lane & 31, hh = lane >> 5;
    f32x16 S0, S1;
#pragma unroll
    for (int r = 0; r < 16; ++r) { S0[r] = 0.f; S1[r] = 0.f; }
    float Bseg = 0.f;
    const size_t hb = ((size_t)(b * 4 + h) * 32 * 4 + sg) * 128 * 16 + (size_t)k * 16;
    const bf16* HQp = (const bf16*)(ws + WS_HQ) + hb; const bf16* HKp = (const bf16*)(ws + WS_HK) + hb; const bf16* HVp = (const bf16*)(ws + WS_HV) + hb; const float* HLp = (const float*)(ws + WS_HLF) + hb;
    v4u n_q0, n_q1, n_k0, n_k1, n_v0, n_v1;
#define HG_LOAD_L(cn) do { } while (0)
#define HG_LOAD_QKV(cn) do { const int o_ = 8192 * (cn); n_q0 = *(const v4u*)(HQp + o_); n_q1 = *(const v4u*)(HQp + o_ + 8); n_k0 = *(const v4u*)(HKp + o_); n_k1 = *(const v4u*)(HKp + o_ + 8); \
        n_v0 = *(const v4u*)(HVp + o_); n_v1 = *(const v4u*)(HVp + o_ + 8); } while (0)
    HG_LOAD_L(4 * seg); HG_LOAD_QKV(4 * seg);
    LDS_BAR();
    for (int c = 4 * seg; c < 4 * seg + 4; ++c) {
        const int mb = b * SEQ + c * 64;
        asm volatile("" : "+v"(k), "+v"(sg), "+v"(l32), "+v"(hh));
        float cl[16], q[16], kk[16];
        { float run = 0.f;
#pragma unroll
          for (int j = 0; j < 8; ++j) { const unsigned w_ = j < 4 ? n_k0[j] : n_k1[j - 4];
              const float l0_ = (float)__builtin_bit_cast(_Float16, (unsigned short)(w_ & 0xffffu)), l1_ = (float)__builtin_bit_cast(_Float16, (unsigned short)(w_ >> 16));
              run += l0_; cl[2 * j] = run; kk[2 * j] = 1.f - __builtin_amdgcn_exp2f(l0_); run += l1_; cl[2 * j + 1] = run; kk[2 * j + 1] = 1.f - __builtin_amdgcn_exp2f(l1_); }
          SEG[sg * 128 + k] = run; }
#define HG_UNP(dst, o, V_) do { const v4u u_ = (V_); dst[o] = bflo(u_.x); dst[o + 1] = bfhi(u_.x); dst[o + 2] = bflo(u_.y); dst[o + 3] = bfhi(u_.y); dst[o + 4] = bflo(u_.z); dst[o + 5] = bfhi(u_.z); dst[o + 6] = bflo(u_.w); dst[o + 7] = bfhi(u_.w); } while (0)
        HG_UNP(q, 0, n_q0); HG_UNP(q, 8, n_q1);
#undef HG_UNP
        const v4u vv0 = n_v0, vv1 = n_v1;
        if (c + 1 < 4 * seg + 4) { HG_LOAD_L(c + 1); HG_LOAD_QKV(c + 1); }
        LDS_BAR();
#pragma unroll
        for (int kti = 0; kti < 2; ++kti) { const int kt = 2 * tt + kti;
#pragma unroll
            for (int g = 0; g < 4; ++g) { const int k0 = 32 * kt + 8 * g + 4 * hh;
                const f32x4 r0 = *(const LAS f32x4*)(SEG + k0), r1 = *(const LAS f32x4*)(SEG + 128 + k0);
                const float s0 = kti ? S1[4 * g] : S0[4 * g], s1 = kti ? S1[4 * g + 1] : S0[4 * g + 1], s2 = kti ? S1[4 * g + 2] : S0[4 * g + 2], s3 = kti ? S1[4 * g + 3] : S0[4 * g + 3];
                v2u w; w.x = cvtpk(s0 * __builtin_amdgcn_exp2f(r0.x + r1.x), s1 * __builtin_amdgcn_exp2f(r0.y + r1.y));
                w.y = cvtpk(s2 * __builtin_amdgcn_exp2f(r0.z + r1.z), s3 * __builtin_amdgcn_exp2f(r0.w + r1.w));
                *(LAS v2u*)(L + O_SP + ((32 * vt + l32) * RSK + k0) * 2) = w; } }
        {
            const float t0 = SEG[k], t1 = SEG[128 + k], t2 = SEG[256 + k], t3 = SEG[384 + k];
            const float pre = (sg > 0 ? t0 : 0.f) + (sg > 1 ? t1 : 0.f) + (sg > 2 ? t2 : 0.f);
            const float ref = t0 + t1, blast = ref + t2 + t3;
            unsigned kp[8];
#pragma unroll
            for (int i = 0; i < 16; i += 2) {
                const float b0 = pre + cl[i], b1 = pre + cl[i + 1];
                const float qt0 = q[i] * __builtin_amdgcn_exp2f(b0 - ref), qt1 = q[i + 1] * __builtin_amdgcn_exp2f(b1 - ref);
                const float kt0 = kk[i] * __builtin_amdgcn_exp2f(ref - b0), kt1 = kk[i + 1] * __builtin_amdgcn_exp2f(ref - b1);
                const unsigned wq = cvtpk(qt0, qt1), wk = cvtpk(kt0, kt1), wb = cvtpk(q[i] * __builtin_amdgcn_exp2f(Bseg + b0), q[i + 1] * __builtin_amdgcn_exp2f(Bseg + b1));
                const int t = 16 * sg + i;
                QB[(size_t)(mb + t) * 512 + h * 128 + k] = (bf16)(wb & 0xffffu); QB[(size_t)(mb + t + 1) * 512 + h * 128 + k] = (bf16)(wb >> 16);
                QT[t * RSK + k] = (bf16)(wq & 0xffffu); QT[(t + 1) * RSK + k] = (bf16)(wq >> 16);
                KT[t * RSK + k] = (bf16)(wk & 0xffffu); KT[(t + 1) * RSK + k] = (bf16)(wk >> 16);
                kp[i >> 1] = wk;
            }
            *(LAS v4u*)(L + O_KTT + (k * RST + 16 * sg) * 2) = (v4u){kp[0], kp[1], kp[2], kp[3]};
            *(LAS v4u*)(L + O_KTT + (k * RST + 16 * sg + 8) * 2) = (v4u){kp[4], kp[5], kp[6], kp[7]};
            *(LAS v4u*)(L + O_VT + (k * RST + 16 * sg) * 2) = vv0;
            *(LAS v4u*)(L + O_VT + (k * RST + 16 * sg + 8) * 2) = vv1;
            if (sg == 0) { EB[k] = __builtin_amdgcn_exp2f(blast); EBR[k] = __builtin_amdgcn_exp2f(blast - ref); }
            Bseg += blast;
        }
        LDS_BAR();
        __builtin_amdgcn_sched_barrier(0);
        f32x16 oT;
#pragma unroll
        for (int r = 0; r < 16; ++r) oT[r] = 0.f;
#pragma unroll
        for (int st = 0; st < 2; ++st) {
            if (st <= tt) {
                f32x16 a;
#pragma unroll
                for (int r = 0; r < 16; ++r) a[r] = 0.f;
#pragma unroll
                for (int ks = 0; ks < 8; ++ks) {
                    const bf16x8 A = *(const LAS bf16x8*)(L + O_KT + ((32 * st + l32) * RSK + 16 * ks + 8 * hh) * 2);
                    const bf16x8 B = *(const LAS bf16x8*)(L + O_QT + ((32 * tt + l32) * RSK + 16 * ks + 8 * hh) * 2);
                    a = MFMA32(A, B, a);
                    if (ks & 1) __builtin_amdgcn_sched_barrier(0);
                }
                if (st == tt) {
#pragma unroll
                    for (int r = 0; r < 16; ++r) { const int sl = 8 * (r >> 2) + 4 * hh + (r & 3); if (sl > l32) a[r] = 0.f; }
                }
#pragma unroll
                for (int j = 0; j < 2; ++j) {
                    v4u bp; bp.x = cvtpk(a[8 * j], a[8 * j + 1]); bp.y = cvtpk(a[8 * j + 2], a[8 * j + 3]); bp.z = cvtpk(a[8 * j + 4], a[8 * j + 5]); bp.w = cvtpk(a[8 * j + 6], a[8 * j + 7]);
                    const v2u lo = *(const LAS v2u*)(L + O_VT + ((32 * vt + l32) * RST + 32 * st + 16 * j + 4 * hh) * 2);
                    const v2u hi = *(const LAS v2u*)(L + O_VT + ((32 * vt + l32) * RST + 32 * st + 16 * j + 8 + 4 * hh) * 2);
                    const v4u av = (v4u){lo.x, lo.y, hi.x, hi.y};
                    oT = MFMA32(__builtin_bit_cast(bf16x8, av), __builtin_bit_cast(bf16x8, bp), oT);
                    __builtin_amdgcn_sched_barrier(0);
                }
            }
            __builtin_amdgcn_sched_barrier(0);
        }
#pragma unroll
        for (int ks = 0; ks < 8; ++ks) {
            const bf16x8 A = *(const LAS bf16x8*)(L + O_SP + ((32 * vt + l32) * RSK + 16 * ks + 8 * hh) * 2);
            const bf16x8 B = *(const LAS bf16x8*)(L + O_QT + ((32 * tt + l32) * RSK + 16 * ks + 8 * hh) * 2);
            oT = MFMA32(A, B, oT);
            if (ks & 1) __builtin_amdgcn_sched_barrier(0);
        }
        __builtin_amdgcn_sched_barrier(0);
#pragma unroll
        for (int kti = 0; kti < 2; ++kti) {
            const int kt = 2 * tt + kti;
            f32x16 T;
#pragma unroll
            for (int r = 0; r < 16; ++r) T[r] = 0.f;
#pragma unroll
            for (int ts = 0; ts < 4; ++ts) {
                const bf16x8 A = *(const LAS bf16x8*)(L + O_KTT + ((32 * kt + l32) * RST + 16 * ts + 8 * hh) * 2);
                const bf16x8 B = *(const LAS bf16x8*)(L + O_VT + ((32 * vt + l32) * RST + 16 * ts + 8 * hh) * 2);
                T = MFMA32(A, B, T);
                if (ts & 1) __builtin_amdgcn_sched_barrier(0);
            }
#pragma unroll
            for (int g = 0; g < 4; ++g) {
                const f32x4 eb = *(const LAS f32x4*)(EB + 32 * kt + 8 * g + 4 * hh), ebr = *(const LAS f32x4*)(EBR + 32 * kt + 8 * g + 4 * hh);
#pragma unroll
                for (int e = 0; e < 4; ++e) { if (kti) S1[4 * g + e] = eb[e] * S1[4 * g + e] + ebr[e] * T[4 * g + e]; else S0[4 * g + e] = eb[e] * S0[4 * g + e] + ebr[e] * T[4 * g + e]; }
            }
            __builtin_amdgcn_sched_barrier(0);
        }
        {
            bf16* op = OP + ((size_t)(((b * 4 + h) * 8 + seg) * 4 + (c & 3)) * 8 + wave) * 1024 + (size_t)lane * 4;
#pragma unroll
            for (int g = 0; g < 4; ++g) *(v2u*)(op + 256 * g) = (v2u){cvtpk(oT[4 * g], oT[4 * g + 1]), cvtpk(oT[4 * g + 2], oT[4 * g + 3])};
        }
    }
#undef HG_LOAD_L
#undef HG_LOAD_QKV
    asm volatile("" : "+v"(l32), "+v"(hh));
    const int un = (b * 4 + h) * 8 + seg;
    float* So = (float*)(ws + WS_HSL) + (size_t)un * 128 * 128;
    if (sg == 0) ((float*)(ws + WS_HDE))[un * 128 + k] = __builtin_amdgcn_exp2f(Bseg);
#pragma unroll
    for (int kti = 0; kti < 2; ++kti)
#pragma unroll
        for (int g = 0; g < 4; ++g) *(f32x4*)(So + (size_t)(((wave * 2 + kti) * 4 + g) * 64 + lane) * 4) = kti ? (f32x4){S1[4 * g], S1[4 * g + 1], S1[4 * g + 2], S1[4 * g + 3]} : (f32x4){S0[4 * g], S0[4 * g + 1], S0[4 * g + 2], S0[4 * g + 3]};
    LDS_BAR();
}

__device__ __forceinline__ void hgrn_pass2(Frame& F, int l, int b, int h, int seg) {
    unsigned char* ws = F.ws; const bf16* P = (const bf16*)(ws + WS_PROJ); bf16* MIX = (bf16*)(ws + WS_MIX); const bf16* QB = (const bf16*)(ws + WS_HQB); const bf16* OP = (const bf16*)(ws + WS_HOP);
    constexpr int RSK = 136;
    constexpr int O_SP = 0, O_QB = 128 * RSK * 2, O_SSQ = O_QB + 256 * RSK * 2, O_ENDL = O_SSQ + 4096;
    static_assert(O_ENDL <= RING_BYTES, "hgrn pass 2 LDS map");
    LAS unsigned char* L = F.lds + RING_OFF; LAS float* SSQ = (LAS float*)(L + O_SSQ);
    const int tid = F.tid, lane = F.lane, wave = F.wave, vt = wave >> 1, tt = wave & 1;
    int l32 = lane & 31, hh = lane >> 5;
    const int u0 = (b * 4 + h) * 8, m0 = b * SEQ + seg * 256;
    const float* SL = (const float*)(ws + WS_HSL); const float* DE = (const float*)(ws + WS_HDE);
    f32x16 S0, S1;
    {
        f32x4 w[8], acc[8];
#pragma unroll
        for (int q = 0; q < 8; ++q) { w[q] = (f32x4){1.f, 1.f, 1.f, 1.f}; acc[q] = (f32x4){0.f, 0.f, 0.f, 0.f}; }
#pragma unroll 1
        for (int j = seg - 1; j >= 0; --j) {
            const float* sl = SL + (size_t)(u0 + j) * 128 * 128 + (size_t)(wave * 8 * 64 + lane) * 4;
            f32x4 x[8];
#pragma unroll
            for (int q = 0; q < 8; ++q) x[q] = *(const f32x4*)(sl + (size_t)q * 256);
#pragma unroll
            for (int q = 0; q < 8; ++q) acc[q] = acc[q] + w[q] * x[q];
            if (j > 0) { const float* de = DE + (u0 + j) * 128;
#pragma unroll
                for (int q = 0; q < 8; ++q) w[q] = w[q] * *(const f32x4*)(de + 32 * (2 * tt + (q >> 2)) + 8 * (q & 3) + 4 * hh); }
        }
#pragma unroll
        for (int g = 0; g < 4; ++g) { S0[4 * g] = acc[g].x; S0[4 * g + 1] = acc[g].y; S0[4 * g + 2] = acc[g].z; S0[4 * g + 3] = acc[g].w;
            S1[4 * g] = acc[4 + g].x; S1[4 * g + 1] = acc[4 + g].y; S1[4 * g + 2] = acc[4 + g].z; S1[4 * g + 3] = acc[4 + g].w; }
    }
    v4u qv[8];
    if (seg > 0) {
#pragma unroll
        for (int i = 0; i < 8; ++i) { const int ch = tid + 512 * i; qv[i] = *(const v4u*)(QB + (size_t)(m0 + (ch >> 4)) * 512 + h * 128 + 8 * (ch & 15)); } }
    LDS_BAR();
#pragma unroll
    for (int kti = 0; kti < 2; ++kti) { const int kt = 2 * tt + kti;
#pragma unroll
        for (int g = 0; g < 4; ++g) { const int k0 = 32 * kt + 8 * g + 4 * hh;
            v2u w; w.x = kti ? cvtpk(S1[4 * g], S1[4 * g + 1]) : cvtpk(S0[4 * g], S0[4 * g + 1]); w.y = kti ? cvtpk(S1[4 * g + 2], S1[4 * g + 3]) : cvtpk(S0[4 * g + 2], S0[4 * g + 3]);
            *(LAS v2u*)(L + O_SP + ((32 * vt + l32) * RSK + k0) * 2) = w; } }
    if (seg > 0) {
#pragma unroll
        for (int i = 0; i < 8; ++i) { const int ch = tid + 512 * i; *(LAS v4u*)(L + O_QB + ((ch >> 4) * RSK + 8 * (ch & 15)) * 2) = qv[i]; } }
    if (seg == 7) {
        const float* sl = SL + (size_t)(u0 + 7) * 128 * 128 + (size_t)(wave * 8 * 64 + lane) * 4; const float* de = DE + (u0 + 7) * 128;
        float* So = F.out + O_HP + ((size_t)(l * NB + b) * 4 + h) * 128 * 128 + 32 * vt + l32;
#pragma unroll
        for (int kti = 0; kti < 2; ++kti) { const int kt = 2 * tt + kti;
#pragma unroll
            for (int g = 0; g < 4; ++g) { const int k0 = 32 * kt + 8 * g + 4 * hh; const f32x4 d4 = *(const f32x4*)(de + k0); const f32x4 x4 = *(const f32x4*)(sl + (size_t)(kti * 4 + g) * 256);
#pragma unroll
                for (int e = 0; e < 4; ++e) So[(size_t)(k0 + e) * 128] = d4[e] * (kti ? S1[4 * g + e] : S0[4 * g + e]) + x4[e]; } }
    }
    LDS_BAR();
    asm volatile("" : "+v"(l32), "+v"(hh));
    f32x16 oT[4];
#pragma unroll
    for (int i = 0; i < 4; ++i) {
        { const bf16* op = OP + ((size_t)((u0 + seg) * 4 + i) * 8 + wave) * 1024 + (size_t)lane * 4;
#pragma unroll
          for (int g = 0; g < 4; ++g) { const v2u x = *(const v2u*)(op + 256 * g); oT[i][4 * g] = bflo(x.x); oT[i][4 * g + 1] = bfhi(x.x); oT[i][4 * g + 2] = bflo(x.y); oT[i][4 * g + 3] = bfhi(x.y); } }
        if (seg > 0) {
            LAS unsigned char* spb = L + O_SP + ((32 * vt + l32) * RSK + 8 * hh) * 2; asm volatile("" : "+v"(spb));
            LAS unsigned char* qbb = L + O_QB + ((64 * i + 32 * tt + l32) * RSK + 8 * hh) * 2; asm volatile("" : "+v"(qbb));
#pragma unroll
            for (int ks = 0; ks < 8; ++ks) { const bf16x8 A = *(const LAS bf16x8*)(spb + 32 * ks); const bf16x8 B = *(const LAS bf16x8*)(qbb + 32 * ks); oT[i] = MFMA32(A, B, oT[i]);
                if (ks & 1) __builtin_amdgcn_sched_barrier(0); }
        }
        float ss = 0.f;
#pragma unroll
        for (int r = 0; r < 16; ++r) ss += oT[i][r] * oT[i][r];
        ss += __shfl_xor(ss, 32);
        if (hh == 0) SSQ[vt * 256 + 64 * i + 32 * tt + l32] = ss;
    }
    LDS_BAR();
    const float* gn = F.in[IN_HN] + l * 512 + h * 128;
#pragma unroll
    for (int i = 0; i < 4; ++i) {
        const int tl = 64 * i + 32 * tt + l32;
        const float tot = (SSQ[tl] + SSQ[256 + tl]) + (SSQ[512 + tl] + SSQ[768 + tl]);
        const float rinv = rsqrtf(tot * (1.f / 128.f) + EPS);
#pragma unroll
        for (int g = 0; g < 4; ++g) { const int v0 = 32 * vt + 8 * g + 4 * hh; const f32x4 g4 = *(const f32x4*)(gn + v0);
            v2u w; w.x = cvtpk(oT[i][4 * g] * rinv * g4.x, oT[i][4 * g + 1] * rinv * g4.y); w.y = cvtpk(oT[i][4 * g + 2] * rinv * g4.z, oT[i][4 * g + 3] * rinv * g4.w);
            *(LAS v2u*)(L + O_QB + (tl * RSK + v0) * 2) = w; }
    }
    LDS_BAR();
#pragma unroll
    for (int i = 0; i < 8; ++i) { const int ch = tid + 512 * i, row = ch >> 4, c8 = 8 * (ch & 15);
        float o[8], g[8]; unpack8(*(const LAS v4u*)(L + O_QB + (row * RSK + c8) * 2), o); unpack8(*(const v4u*)(P + (size_t)(m0 + row) * PIN + C_GR + h * 128 + c8), g);
        *(v4u*)(MIX + (size_t)(m0 + row) * DM + 512 + h * 128 + c8) = (v4u){cvtpk(o[0] * g[0], o[1] * g[1]), cvtpk(o[2] * g[2], o[3] * g[3]), cvtpk(o[4] * g[4], o[5] * g[5]), cvtpk(o[6] * g[6], o[7] * g[7])}; }
}

__device__ __forceinline__ void swa_unit_prompt(Frame& F, int l, int b, int kvh, int jb) {
    unsigned char* ws = F.ws; const bf16* P = (const bf16*)(ws + WS_PROJ); bf16* MIX = (bf16*)(ws + WS_MIX);
    const float* cs = (const float*)(ws + WS_TAB + TAB_COS); const float* sn = (const float*)(ws + WS_TAB + TAB_SIN);
    constexpr int RK = 72, RV = 264;
    constexpr int O_KR = 0, O_VT = 256 * RK * 2, O_E = O_VT + 64 * RV * 2;
    static_assert(O_E <= 100 * 1024, "swa LDS map");
    LAS unsigned char* L = F.lds + RING_OFF;
    const int tid = F.tid, lane = F.lane, wave = F.wave;
    const int l32 = lane & 31, hh = lane >> 5;
    const int p0 = jb * 128 - 128;
    LDS_BAR();
#pragma unroll
    for (int i = 0; i < 2; ++i) { const int item = tid + 512 * i, ci = item >> 2, c8 = item & 3, kp = p0 + ci;
        v4u w1 = {0u, 0u, 0u, 0u}, w2 = w1;
        if (kp >= 0) { const bf16* kr = P + (size_t)(b * SEQ + kp) * PIN + C_K + kvh * 64 + c8 * 8;
            float k1[8], k2[8], cc[8], ss[8]; unpack8(*(const v4u*)kr, k1); unpack8(*(const v4u*)(kr + 32), k2); load8f(cs + kp * 32 + c8 * 8, cc); load8f(sn + kp * 32 + c8 * 8, ss);
            float r1[8], r2[8];
#pragma unroll
            for (int e = 0; e < 8; ++e) { r1[e] = k1[e] * cc[e] - k2[e] * ss[e]; r2[e] = k2[e] * cc[e] + k1[e] * ss[e]; }
            w1 = (v4u){cvtpk(r1[0], r1[1]), cvtpk(r1[2], r1[3]), cvtpk(r1[4], r1[5]), cvtpk(r1[6], r1[7])};
            w2 = (v4u){cvtpk(r2[0], r2[1]), cvtpk(r2[2], r2[3]), cvtpk(r2[4], r2[5]), cvtpk(r2[6], r2[7])};
            if (jb == SEQ / 128 - 1 && ci >= 128) { float* ok = F.out + O_WKP + (((size_t)(l * NB + b) * 128 + (ci - 128)) * 2 + kvh) * 64 + c8 * 8;
                *(f32x4*)ok = (f32x4){r1[0], r1[1], r1[2], r1[3]}; *(f32x4*)(ok + 4) = (f32x4){r1[4], r1[5], r1[6], r1[7]};
                *(f32x4*)(ok + 32) = (f32x4){r2[0], r2[1], r2[2], r2[3]}; *(f32x4*)(ok + 36) = (f32x4){r2[4], r2[5], r2[6], r2[7]}; } }
        *(LAS v4u*)(L + O_KR + (ci * RK + c8 * 8) * 2) = w1; *(LAS v4u*)(L + O_KR + (ci * RK + 32 + c8 * 8) * 2) = w2; }
    { const int d = tid & 63, kg = tid >> 6;
#pragma unroll
      for (int q4 = 0; q4 < 4; ++q4) { unsigned w[4];
#pragma unroll
          for (int e = 0; e < 4; ++e) { const int ci = 32 * kg + 8 * q4 + 2 * e, kp = p0 + ci; unsigned short a = 0, c = 0;
              if (kp >= 0) { a = P[(size_t)(b * SEQ + kp) * PIN + C_V + kvh * 64 + d]; c = P[(size_t)(b * SEQ + kp + 1) * PIN + C_V + kvh * 64 + d];
                  if (jb == SEQ / 128 - 1 && ci >= 128) { float* ov = F.out + O_WVP + (((size_t)(l * NB + b) * 128 + (ci - 128)) * 2 + kvh) * 64 + d; ov[0] = bf2f(a); ov[128] = bf2f(c); } }
              w[e] = (unsigned)a | ((unsigned)c << 16); }
          *(LAS v4u*)(L + O_VT + (d * RV + 32 * kg + 8 * q4) * 2) = (v4u){w[0], w[1], w[2], w[3]}; } }
    LDS_BAR();
    const int g = wave >> 1, h = kvh * 4 + g;
    const float sink2 = F.in[IN_SINK][l * 8 + h] * 1.4426950408889634f;
#pragma unroll 1
    for (int s = 0; s < 2; ++s) {
        const int r0 = 64 * (wave & 1) + 32 * s;
        const int t = jb * 128 + r0 + l32;
        bf16x8 qf[4];
        { const bf16* qr = P + (size_t)(b * SEQ + t) * PIN + h * 64 + 8 * hh;
          float x[4][8]; unpack8(*(const v4u*)qr, x[0]); unpack8(*(const v4u*)(qr + 16), x[1]); unpack8(*(const v4u*)(qr + 32), x[2]); unpack8(*(const v4u*)(qr + 48), x[3]);
          const float qs = 0.125f * 1.4426950408889634f;
#pragma unroll
          for (int ks = 0; ks < 2; ++ks) { float cc[8], ss[8]; load8f(cs + t * 32 + 16 * ks + 8 * hh, cc); load8f(sn + t * 32 + 16 * ks + 8 * hh, ss); float r1[8], r2[8];
#pragma unroll
              for (int e = 0; e < 8; ++e) { r1[e] = (x[ks][e] * cc[e] - x[ks + 2][e] * ss[e]) * qs; r2[e] = (x[ks + 2][e] * cc[e] + x[ks][e] * ss[e]) * qs; }
              qf[ks] = __builtin_bit_cast(bf16x8, (v4u){cvtpk(r1[0], r1[1]), cvtpk(r1[2], r1[3]), cvtpk(r1[4], r1[5]), cvtpk(r1[6], r1[7])});
              qf[ks + 2] = __builtin_bit_cast(bf16x8, (v4u){cvtpk(r2[0], r2[1]), cvtpk(r2[2], r2[3]), cvtpk(r2[4], r2[5]), cvtpk(r2[6], r2[7])}); } }
        f32x16 sc[5];
#pragma unroll
        for (int kt = 0; kt < 5; ++kt) {
#pragma unroll
            for (int r = 0; r < 16; ++r) sc[kt][r] = 0.f;
#pragma unroll
            for (int ks = 0; ks < 4; ++ks) { const bf16x8 A = *(const LAS bf16x8*)(L + O_KR + ((r0 + 32 * kt + l32) * RK + 16 * ks + 8 * hh) * 2); sc[kt] = MFMA32(A, qf[ks], sc[kt]); }
            __builtin_amdgcn_sched_barrier(0);
        }
        const int kt_lo = (jb == 0) ? 4 - (r0 >> 5) : 0;
        float mx = sink2;
#pragma unroll
        for (int kt = 0; kt < 5; ++kt)
#pragma unroll
            for (int r = 0; r < 16; ++r) { const int kl = 8 * (r >> 2) + 4 * hh + (r & 3);
                bool ok = kt >= kt_lo; if (kt == 0) ok = ok && (kl >= l32); if (kt == 4) ok = ok && (kl <= l32);
                const float v = ok ? sc[kt][r] : -INFINITY; sc[kt][r] = v; mx = fmaxf(mx, v); }
        mx = fmaxf(mx, __shfl_xor(mx, 32));
        float sum = 0.f;
#pragma unroll
        for (int kt = 0; kt < 5; ++kt)
#pragma unroll
            for (int r = 0; r < 16; ++r) { const float p = __builtin_amdgcn_exp2f(sc[kt][r] - mx); sc[kt][r] = p; sum += p; }
        sum += __shfl_xor(sum, 32);
        const float inv = 1.f / (sum + __builtin_amdgcn_exp2f(sink2 - mx));
        f32x16 o[2];
#pragma unroll
        for (int dt = 0; dt < 2; ++dt) {
#pragma unroll
            for (int r = 0; r < 16; ++r) o[dt][r] = 0.f; }
#pragma unroll
        for (int kt = 0; kt < 5; ++kt) {
#pragma unroll
            for (int j = 0; j < 2; ++j) {
                const v4u bp = {cvtpk(sc[kt][8 * j], sc[kt][8 * j + 1]), cvtpk(sc[kt][8 * j + 2], sc[kt][8 * j + 3]), cvtpk(sc[kt][8 * j + 4], sc[kt][8 * j + 5]), cvtpk(sc[kt][8 * j + 6], sc[kt][8 * j + 7])};
#pragma unroll
                for (int dt = 0; dt < 2; ++dt) {
                    const v2u lo = *(const LAS v2u*)(L + O_VT + ((32 * dt + l32) * RV + r0 + 32 * kt + 16 * j + 4 * hh) * 2);
                    const v2u hi = *(const LAS v2u*)(L + O_VT + ((32 * dt + l32) * RV + r0 + 32 * kt + 16 * j + 8 + 4 * hh) * 2);
                    o[dt] = MFMA32(__builtin_bit_cast(bf16x8, (v4u){lo.x, lo.y, hi.x, hi.y}), __builtin_bit_cast(bf16x8, bp), o[dt]);
                }
            }
            __builtin_amdgcn_sched_barrier(0);
        }
        bf16* orow = MIX + (size_t)(b * SEQ + t) * DM + h * 64 + 4 * hh;
#pragma unroll
        for (int dt = 0; dt < 2; ++dt)
#pragma unroll
            for (int g4 = 0; g4 < 4; ++g4) { v2u w; w.x = cvtpk(o[dt][4 * g4] * inv, o[dt][4 * g4 + 1] * inv); w.y = cvtpk(o[dt][4 * g4 + 2] * inv, o[dt][4 * g4 + 3] * inv);
                *(v2u*)(orow + 32 * dt + 8 * g4) = w; }
    }
}

#define MFMA16(a, b, c) __builtin_amdgcn_mfma_f32_16x16x32_bf16((a), (b), (c), 0, 0, 0)
__device__ __forceinline__ void xattn_unit_prompt(Frame& F, int l, int b, int h, int qb) {
    unsigned char* ws = F.ws; const bf16* QX = (const bf16*)(ws + WS_QX); bf16* OX = (bf16*)(ws + WS_OX);
    const bf16* MK = (const bf16*)(ws + WS_MK) + ((size_t)l * 2048 + b * 256) * DM + h * 256;
    const bf16* MVT = (const bf16*)(ws + WS_MVT) + ((size_t)((l * NB + b) * 4 + h) * 256) * 256;
    constexpr int RKX = 264, RVX = 68;
    constexpr int TILE_K = 64 * RKX * 2, TILE_V = 256 * RVX * 2;
    static_assert(2 * TILE_V <= 100 * 1024, "xattn LDS map");
    LAS unsigned char* L = F.lds + RING_OFF;
    const int tid = F.tid, lane = F.lane, wave = F.wave;
    const int l32 = lane & 31, hh = lane >> 5;
    const int row = b * SEQ + qb * 256 + wave * 32 + l32;
    bf16x8 qf[16];
    { const bf16* qr = QX + (size_t)row * DM + h * 256 + 8 * hh;
#pragma unroll
      for (int ks = 0; ks < 16; ++ks) qf[ks] = *(const bf16x8*)(qr + 16 * ks); }
    v4u pre[2];
    bf16x8 pf[16];
    float tmx[4], runM = -INFINITY, runL = 0.f;
    unsigned koff[4];
#pragma unroll
    for (int j_ = 0; j_ < 4; ++j_) { const int ch_ = tid + 512 * j_; koff[j_] = (unsigned)(((ch_ >> 5) * DM + 8 * (ch_ & 31)) * 2); }
#define XK_LOAD(mt, hf) do { const char* kb_ = (const char*)MK + (size_t)(64 * (mt)) * DM * 2; _Pragma("unroll") for (int j_ = 0; j_ < 2; ++j_) pre[j_] = *(const v4u*)(kb_ + koff[2 * (hf) + j_]); } while (0)
#define XK_STORE(buf, hf) do { _Pragma("unroll") for (int j_ = 0; j_ < 2; ++j_) { const int ch_ = tid + 512 * (2 * (hf) + j_); *(LAS v4u*)(L + (buf) * TILE_K + ((ch_ >> 5) * RKX + 8 * (ch_ & 31)) * 2) = pre[j_]; } } while (0)
    LDS_BAR();
    XK_LOAD(0, 0); XK_STORE(0, 0); XK_LOAD(0, 1); XK_STORE(0, 1);
#pragma unroll
    for (int mt = 0; mt < 4; ++mt) {
        LDS_BAR();
        LAS unsigned char* kbp = L + (mt & 1) * TILE_K + (l32 * RKX + 8 * hh) * 2; asm volatile("" : "+v"(kbp));
        f32x16 sc[2];
#pragma unroll
        for (int i = 0; i < 2; ++i) {
            if (mt + 1 < 4) XK_LOAD(mt + 1, i);
#pragma unroll
            for (int r = 0; r < 16; ++r) sc[i][r] = 0.f;
#pragma unroll
            for (int ks = 0; ks < 16; ++ks) { const bf16x8 A = *(const LAS bf16x8*)(kbp + (32 * i * RKX + 16 * ks) * 2); sc[i] = MFMA32(A, qf[ks], sc[i]);
                if ((ks & 3) == 3) __builtin_amdgcn_sched_barrier(0); }
            if (mt + 1 < 4) XK_STORE((mt + 1) & 1, i);
        }
        float m_ = -INFINITY;
#pragma unroll
        for (int i = 0; i < 2; ++i)
#pragma unroll
            for (int r = 0; r < 16; ++r) m_ = fmaxf(m_, sc[i][r]);
        m_ = fmaxf(m_, __shfl_xor(m_, 32));
        float s_ = 0.f;
#pragma unroll
        for (int i = 0; i < 2; ++i) {
#pragma unroll
            for (int r = 0; r < 16; ++r) { const float p = __builtin_amdgcn_exp2f(sc[i][r] - m_); sc[i][r] = p; s_ += p; }
#pragma unroll
            for (int j = 0; j < 2; ++j) pf[4 * mt + 2 * i + j] = __builtin_bit_cast(bf16x8, (v4u){cvtpk(sc[i][8 * j], sc[i][8 * j + 1]), cvtpk(sc[i][8 * j + 2], sc[i][8 * j + 3]), cvtpk(sc[i][8 * j + 4], sc[i][8 * j + 5]), cvtpk(sc[i][8 * j + 6], sc[i][8 * j + 7])});
        }
        tmx[mt] = m_; { const float nM = fmaxf(runM, m_); runL = runL * __builtin_amdgcn_exp2f(runM - nM) + s_ * __builtin_amdgcn_exp2f(m_ - nM); runM = nM; }
    }
#undef XK_LOAD
#undef XK_STORE
    const float mx = runM;
    float sum = runL;
#pragma unroll
    for (int mt = 0; mt < 4; ++mt) { const float scl_ = __builtin_amdgcn_exp2f(tmx[mt] - mx);
#pragma unroll
        for (int f = 0; f < 4; ++f) { const v4u w = __builtin_bit_cast(v4u, pf[4 * mt + f]);
            pf[4 * mt + f] = __builtin_bit_cast(bf16x8, (v4u){cvtpk(bflo(w.x) * scl_, bfhi(w.x) * scl_), cvtpk(bflo(w.y) * scl_, bfhi(w.y) * scl_), cvtpk(bflo(w.z) * scl_, bfhi(w.z) * scl_), cvtpk(bflo(w.w) * scl_, bfhi(w.w) * scl_)}); } }
    sum += __shfl_xor(sum, 32);
    const float inv = 1.f / sum;
    constexpr int TILE_H = 128 * RVX * 2;
    unsigned voff[2];
#pragma unroll
    for (int j_ = 0; j_ < 2; ++j_) { const int ch_ = tid + 512 * j_; voff[j_] = (unsigned)(((ch_ >> 3) * 256 + 8 * (ch_ & 7)) * 2); }
#define XV_LOAD(st) do { const char* vb_ = (const char*)MVT + ((size_t)(128 * ((st) >> 2)) * 256 + 64 * ((st) & 3)) * 2; _Pragma("unroll") for (int j_ = 0; j_ < 2; ++j_) pre[j_] = *(const v4u*)(vb_ + voff[j_]); } while (0)
#define XV_STORE(buf) do { _Pragma("unroll") for (int j_ = 0; j_ < 2; ++j_) { const int ch_ = tid + 512 * j_; LAS unsigned char* d_ = L + (buf) * TILE_H + ((ch_ >> 3) * RVX + 8 * (ch_ & 7)) * 2; *(LAS v2u*)d_ = (v2u){pre[j_].x, pre[j_].y}; *(LAS v2u*)(d_ + 8) = (v2u){pre[j_].z, pre[j_].w}; } } while (0)
    XV_LOAD(0);
    LDS_BAR();
    XV_STORE(0);
    bf16* orow = OX + (size_t)row * DM + h * 256 + 4 * hh;
#pragma unroll
    for (int dh = 0; dh < 2; ++dh) {
        f32x16 o[4];
#pragma unroll
        for (int i = 0; i < 4; ++i)
#pragma unroll
            for (int r = 0; r < 16; ++r) o[i][r] = 0.f;
#pragma unroll
        for (int mt = 0; mt < 4; ++mt) {
            const int st = 4 * dh + mt;
            if (st + 1 < 8) XV_LOAD(st + 1);
            LDS_BAR();
            LAS unsigned char* vbp = L + (st & 1) * TILE_H + (l32 * RVX + 4 * hh) * 2; asm volatile("" : "+v"(vbp));
#pragma unroll
            for (int dt = 0; dt < 4; ++dt) {
#pragma unroll
                for (int k4 = 0; k4 < 4; ++k4) {
                    const v2u lo = *(const LAS v2u*)(vbp + (32 * dt * RVX + 16 * k4) * 2);
                    const v2u hi = *(const LAS v2u*)(vbp + (32 * dt * RVX + 16 * k4 + 8) * 2);
                    o[dt] = MFMA32(__builtin_bit_cast(bf16x8, (v4u){lo.x, lo.y, hi.x, hi.y}), pf[4 * mt + k4], o[dt]);
                }
                __builtin_amdgcn_sched_barrier(0);
            }
            if (st + 1 < 8) XV_STORE((st + 1) & 1);
        }
#pragma unroll
        for (int dt = 0; dt < 4; ++dt)
#pragma unroll
            for (int g = 0; g < 4; ++g) { v2u w; w.x = cvtpk(o[dt][4 * g] * inv, o[dt][4 * g + 1] * inv); w.y = cvtpk(o[dt][4 * g + 2] * inv, o[dt][4 * g + 3] * inv); *(v2u*)(orow + 128 * dh + 32 * dt + 8 * g) = w; }
    }
#undef XV_LOAD
#undef XV_STORE
}

template <int K>
__device__ __forceinline__ void sample_slice_gemm(Frame& F, const bf16* A, const bf16* Wt, float* Yf, bf16* Qb, float sc, const float* rs = nullptr) {
    const int lane = F.lane, l16 = lane & 15, hq = lane >> 4, wave = F.wave;
    const int rg = blockIdx.x & 7, cs = blockIdx.x >> 3;
    constexpr int NKS = (K >> 5) / 8;
    const GAS bf16* ap = (const GAS bf16*)A + (size_t)(16 * rg + l16) * K + 8 * hq + 32 * NKS * wave;
    const GAS bf16* wp = (const GAS bf16*)Wt + (size_t)(32 * cs + l16) * K + 8 * hq + 32 * NKS * wave;
    f32x4 acc0 = {0.f, 0.f, 0.f, 0.f}, acc1 = acc0;
    bf16x8 a[NKS], b0[NKS], b1[NKS];
#pragma unroll
    for (int i = 0; i < NKS; ++i) { a[i] = *(const GAS bf16x8*)(ap + 32 * i); b0[i] = *(const GAS bf16x8*)(wp + 32 * i); b1[i] = *(const GAS bf16x8*)(wp + (size_t)16 * K + 32 * i); }
#pragma unroll
    for (int i = 0; i < NKS; ++i) { acc0 = MFMA16(a[i], b0[i], acc0); acc1 = MFMA16(a[i], b1[i], acc1); }
    LAS f32x4* red = (LAS f32x4*)(F.lds + RING_OFF);
    LDS_BAR();
    red[(wave * 2 + 0) * 64 + lane] = acc0; red[(wave * 2 + 1) * 64 + lane] = acc1;
    LDS_BAR();
    if (wave < 2) {
        f32x4 s = {0.f, 0.f, 0.f, 0.f};
#pragma unroll
        for (int w = 0; w < 8; ++w) s = s + red[(w * 2 + wave) * 64 + lane];
        const int n = 32 * cs + 16 * wave + l16;
#pragma unroll
        for (int e = 0; e < 4; ++e) { const size_t off = (size_t)(MP + 16 * rg + 4 * hq + e) * DM + n;
            const float rv = rs ? rs[16 * rg + 4 * hq + e] : 1.f;
            if (Yf) Yf[off] = s[e] * rv; else Qb[off] = (bf16)(cvtpk(s[e] * sc * rv, 0.f) & 0xffffu); }
    }
    LDS_BAR();
}

#ifndef MK_PER_PHASE
#define MK_PER_PHASE 0
#endif
#ifndef EN_CONV
#define EN_CONV 1
#endif
#ifndef EN_DOWN
#define EN_DOWN 1
#endif
#ifndef EN_INPROJ
#define EN_INPROJ 1
#endif
#ifndef EN_MEMKV
#define EN_MEMKV 1
#endif
#ifndef EN_MIX
#define EN_MIX 1
#endif
#ifndef EN_NORM
#define EN_NORM 1
#endif
#ifndef EN_PROLOG
#define EN_PROLOG 1
#endif
#ifndef EN_UP
#define EN_UP 1
#endif
#ifndef EN_WO
#define EN_WO 1
#endif
#ifndef EN_XATTN
#define EN_XATTN 1
#endif
#ifndef EN_XO
#define EN_XO 1
#endif
#ifndef EN_XQ
#define EN_XQ 1
#endif
#ifndef HGRN_NAIVE
#define HGRN_NAIVE 0
#endif
#ifndef DUP_PROLOG
#define DUP_PROLOG 0
#endif
#ifndef DUP_UP
#define DUP_UP 0
#endif
#ifndef DUP_WO
#define DUP_WO 0
#endif
#ifndef DUP_DOWN
#define DUP_DOWN 0
#endif
#ifndef DUP_P1
#define DUP_P1 0
#endif
#ifndef DUP_SWA
#define DUP_SWA 0
#endif
#ifndef DUP_SMP
#define DUP_SMP 0
#endif
#ifndef DUP_XP
#define DUP_XP 0
#endif
#ifndef DUP_XS
#define DUP_XS 0
#endif
#ifndef DUP_MIXB
#define DUP_MIXB 0
#endif
#ifndef DUP_MIX
#define DUP_MIX 0
#endif
#ifndef DUP_XATTN
#define DUP_XATTN 0
#endif
#ifndef DUP_CONV
#define DUP_CONV 0
#endif
#ifndef DUP_INPROJ
#define DUP_INPROJ 0
#endif
constexpr int N_PHASES = 2 + 13 * DEPTH;

struct Args { const float* in[29]; float* out; unsigned char* ws; int ph_lo, ph_hi; };

__global__ void __launch_bounds__(NTHR, 2) mk_fwd(Args args) {
    extern __shared__ __attribute__((aligned(16))) unsigned char lds[];
    Frame F;
    F.lds = (LAS unsigned char*)lds;
    F.MISC = (volatile LAS unsigned*)(F.lds + MISC_OFF);
    F.tid = threadIdx.x; F.lane = F.tid & 63; F.wave = __builtin_amdgcn_readfirstlane(F.tid >> 6);
    F.G = gridDim.x; F.gw = blockIdx.x * NWAVES + F.wave; F.ngw = F.G * NWAVES;
    F.ws = args.ws; F.out = args.out; F.ctl = (unsigned*)(args.ws + WS_CTL);
    F.in = args.in;
    for (int u = F.tid; u < (LDS_BYTES - LDSCTL_OFF) / 4; u += NTHR) ((LAS unsigned*)(F.lds + LDSCTL_OFF))[u] = 0u;
    __syncthreads();
    XcdBarrier bar = xcd_barrier_post(F.ctl + CW_BAR, F.MISC + 8);
    const int lo = args.ph_lo, hi = args.ph_hi;
    unsigned char* ws = args.ws; int bx = blockIdx.x;
#define FRESH() do { bx = blockIdx.x; F.vcu = (bx & 7) * (GRID / 8) + (bx >> 3); F.lane = (int)__builtin_amdgcn_mbcnt_hi(~0u, __builtin_amdgcn_mbcnt_lo(~0u, 0u)); F.tid = F.wave * 64 + F.lane; asm volatile("" : "+s"(ws), "+v"(F.tid), "+v"(F.lane), "+s"(F.wave), "+s"(F.gw), "+s"(bx), "+s"(F.vcu)); F.ws = ws; } while (0)
#define IN(k) (lo <= (k) && (k) < hi)
#define SEAM(k) do { if (IN((k) + 1)) xcd_barrier(bar); } while (0)
    LAS float* wl = (LAS float*)(F.lds + RING_OFF + 102400 + F.wave * 2048);

    if (EN_PROLOG && IN(0)) { _Pragma("unroll 1") for (int rep_ = 0; rep_ <= DUP_PROLOG; ++rep_) { FRESH(); p0_prologue(F); } SEAM(0); }
    if (EN_MEMKV && IN(1)) { FRESH();
        pg8::Gemm g{(const pg8::bf16_t*)(ws + WS_MEMN), (const pg8::bf16_t*)(ws + WS_WXKV), DEPTH * 2048, DEPTH * 2048, DM};
        pg8::BlockDiagOrder S{F.G, bx};
        pg8::EpiMemKV E{F.out + O_MKP, F.out + O_MVP, (pg8::bf16_t*)(ws + WS_MK), (pg8::bf16_t*)(ws + WS_MVT)};
        pg8::gemm_phase<pg8::EpiMemKV, pg8::BlockDiagOrder, true, true>(F.lds + RING_OFF, g, S, E, F.wave);
        SEAM(1);
    }
    for (int l = 0; l < DEPTH; ++l) {
        const int pb = 2 + 13 * l;
        if (EN_INPROJ && IN(pb + 0)) { FRESH();
            pg8::Gemm g{(const pg8::bf16_t*)(ws + WS_XN), (const pg8::bf16_t*)(ws + WS_WIN) + (size_t)l * PIN * DM, MT, PIN, DM};
            pg8::StaticOrder S; S.init(MT, PIN, F.G, bx);
            pg8::EpiProj E{(pg8::bf16_t*)(ws + WS_PROJ), (float*)(ws + WS_LF), (const float*)(ws + WS_TAB + TAB_LB) + l * 512, (pg8::bf16_t*)(ws + WS_HQ), (pg8::bf16_t*)(ws + WS_HK), (pg8::bf16_t*)(ws + WS_HV), (float*)(ws + WS_HLF)};
            _Pragma("unroll 1") for (int rep_ = 0; rep_ <= DUP_INPROJ; ++rep_) pg8::gemm_phase<pg8::EpiProj, pg8::StaticOrder, true, true>(F.lds + RING_OFF, g, S, E, F.wave);
            SEAM(pb + 0);
        }
        if (EN_MIX && IN(pb + 1)) { FRESH();
          _Pragma("unroll 1") for (int rep_ = 0; rep_ <= DUP_MIX; ++rep_) { FRESH();
            _Pragma("unroll 1") for (int r2_ = 0; r2_ <= DUP_P1; ++r2_) { FRESH(); for (int u = F.vcu; u < NB * 4 * 8; u += F.G) hgrn_pass1(F, l, u >> 5, (u >> 3) & 3, u & 7); }
            _Pragma("unroll 1") for (int r2_ = 0; r2_ <= DUP_SWA; ++r2_) { FRESH(); for (int u = F.vcu; u < NB * 2 * 16; u += F.G) swa_unit_prompt(F, l, u >> 5, (u >> 4) & 1, u & 15); }
            _Pragma("unroll 1") for (int r2_ = 0; r2_ <= DUP_SMP; ++r2_) { FRESH(); if (bx < DB) hgrn_unit_sample(F, l, bx); else if (bx < 2 * DB) swa_unit_sample(F, l, bx - DB); }
          }
            SEAM(pb + 1);
        }
        if (EN_MIX && IN(pb + 2)) { FRESH();
            _Pragma("unroll 1") for (int rep_ = 0; rep_ <= DUP_MIXB; ++rep_) { FRESH(); for (int u = F.vcu; u < NB * 4 * 8; u += F.G) hgrn_pass2(F, l, u >> 5, (u >> 3) & 3, u & 7); }
            SEAM(pb + 2);
        }
        if (EN_WO && IN(pb + 3)) { FRESH();
            sample_slice_gemm<DM>(F, (const bf16*)(ws + WS_MIX) + (size_t)MP * DM, (const bf16*)(ws + WS_WO) + (size_t)l * DM * DM, nullptr, (bf16*)(ws + WS_Y), 1.f);
            pg8::Gemm g{(const pg8::bf16_t*)(ws + WS_MIX), (const pg8::bf16_t*)(ws + WS_WO) + (size_t)l * DM * DM, MP, DM, DM};
            pg8::StaticOrder S; S.init(MP, DM, F.G, bx);
            pg8::EpiB16 E{(pg8::bf16_t*)(ws + WS_Y), DM, 1.0f, nullptr};
            _Pragma("unroll 1") for (int rep_ = 0; rep_ <= DUP_WO; ++rep_) pg8::gemm_phase<pg8::EpiB16, pg8::StaticOrder, true, true>(F.lds + RING_OFF, g, S, E, F.wave);
            SEAM(pb + 3);
        }
        if (EN_NORM && IN(pb + 4)) { FRESH(); norm_phase(F, F.in[IN_GQM] + l * DM, nullptr, false); SEAM(pb + 4); }
        if (EN_XQ && IN(pb + 5)) { FRESH();
            sample_slice_gemm<DM>(F, (const bf16*)(ws + WS_X) + (size_t)MP * DM, (const bf16*)(ws + WS_WXQ) + (size_t)l * DM * DM, nullptr, (bf16*)(ws + WS_QX), 0.0625f * 1.4426950408889634f, (const float*)(ws + WS_RS) + MP);
            pg8::Gemm g{(const pg8::bf16_t*)(ws + WS_X), (const pg8::bf16_t*)(ws + WS_WXQ) + (size_t)l * DM * DM, MP, DM, DM};
            pg8::StaticOrder S; S.init(MP, DM, F.G, bx);
            pg8::EpiB16 E{(pg8::bf16_t*)(ws + WS_QX), DM, 0.0625f * 1.4426950408889634f, (const float*)(ws + WS_RS)};
            pg8::gemm_phase<pg8::EpiB16, pg8::StaticOrder, true, true>(F.lds + RING_OFF, g, S, E, F.wave);
            SEAM(pb + 5);
        }
        if (EN_XATTN && IN(pb + 6)) { FRESH();
          _Pragma("unroll 1") for (int rep_ = 0; rep_ <= DUP_XATTN; ++rep_) { FRESH();
            if ((bx >> 3) & 1) for (int u = bx; u < DB * 4; u += F.G) xattn_unit_sample(F, l, u >> 2, u & 3);
            _Pragma("unroll 1") for (int r2_ = 0; r2_ <= DUP_XP; ++r2_) { FRESH(); for (int u = F.vcu; u < NB * 4 * 8; u += F.G) xattn_unit_prompt(F, l, u >> 5, (u >> 3) & 3, u & 7); }
            if (!((bx >> 3) & 1)) for (int u = bx; u < DB * 4; u += F.G) xattn_unit_sample(F, l, u >> 2, u & 3);
            _Pragma("unroll 1") for (int r2_ = 0; r2_ < DUP_XS; ++r2_) { FRESH(); for (int u = bx; u < DB * 4; u += F.G) xattn_unit_sample(F, l, u >> 2, u & 3); }
          }
            SEAM(pb + 6);
        }
        if (EN_XO && IN(pb + 7)) { FRESH();
            sample_slice_gemm<DM>(F, (const bf16*)(ws + WS_OX) + (size_t)MP * DM, (const bf16*)(ws + WS_WXO) + (size_t)l * DM * DM, nullptr, (bf16*)(ws + WS_Y), 1.f);
            pg8::Gemm g{(const pg8::bf16_t*)(ws + WS_OX), (const pg8::bf16_t*)(ws + WS_WXO) + (size_t)l * DM * DM, MP, DM, DM};
            pg8::StaticOrder S; S.init(MP, DM, F.G, bx);
            pg8::EpiB16 E{(pg8::bf16_t*)(ws + WS_Y), DM, 1.0f, nullptr};
            pg8::gemm_phase<pg8::EpiB16, pg8::StaticOrder, true, true>(F.lds + RING_OFF, g, S, E, F.wave);
            SEAM(pb + 7);
        }
        if (EN_NORM && IN(pb + 8)) { FRESH(); norm_phase(F, F.in[IN_GQX] + l * DM, nullptr, false); SEAM(pb + 8); }
        if (EN_UP && IN(pb + 9)) { FRESH();
            pg8::Gemm g{(const pg8::bf16_t*)(ws + WS_X), (const pg8::bf16_t*)(ws + WS_WUP) + (size_t)l * UPW * DM, MT, UPW, DM};
            pg8::StaticOrder S; S.init(MT, UPW, F.G, bx);
            pg8::EpiUpConv E{(pg8::bf16_t*)(ws + WS_G), (pg8::bf16_t*)(ws + WS_U), (pg8::bf16_t*)(ws + WS_U) + (size_t)256 * 4 * UPW, (const float*)(ws + WS_RS), F.in[IN_CW] + (size_t)l * 3 * UPW, F.in[IN_CB] + (size_t)l * UPW};
            pg8::gemm_phase<pg8::EpiUpConv, pg8::StaticOrder, true, true>(F.lds + RING_OFF, g, S, E, F.wave);
            SEAM(pb + 9);
        }
        if (EN_CONV && IN(pb + 10)) { FRESH(); _Pragma("unroll 1") for (int rep_ = 0; rep_ <= DUP_CONV; ++rep_) { FRESH(); conv_phase(F, l); } SEAM(pb + 10); }
        if (EN_DOWN && IN(pb + 11)) { FRESH();
            sample_slice_gemm<DFF>(F, (const bf16*)(ws + WS_G) + (size_t)MP * DFF, (const bf16*)(ws + WS_WDN) + (size_t)l * DM * DFF, nullptr, (bf16*)(ws + WS_Y), 1.f);
            pg8::Gemm g{(const pg8::bf16_t*)(ws + WS_G), (const pg8::bf16_t*)(ws + WS_WDN) + (size_t)l * DM * DFF, MP, DM, DFF};
            pg8::StaticOrder S; S.init(MP, DM, F.G, bx);
            pg8::EpiB16 E{(pg8::bf16_t*)(ws + WS_Y), DM, 1.0f, nullptr};
            _Pragma("unroll 1") for (int rep_ = 0; rep_ <= DUP_DOWN; ++rep_) pg8::gemm_phase<pg8::EpiB16, pg8::StaticOrder, true, true>(F.lds + RING_OFF, g, S, E, F.wave);
            SEAM(pb + 11);
        }
        if (EN_NORM && IN(pb + 12)) { FRESH(); norm_phase(F, F.in[IN_GQF] + l * DM, F.in[IN_GPM] + (l + 1 < DEPTH ? l + 1 : 0) * DM, l == DEPTH - 1); SEAM(pb + 12); }
    }
#undef IN
#undef SEAM
}

extern "C" void kernel_launch(void* const* d_in, const int* in_sizes, int n_in, void* d_out, int out_size, void* d_ws, size_t ws_size, hipStream_t stream) {
    static int grid = 0;
    if (grid == 0) {
        if (n_in != 29 || (size_t)out_size != O_END || ws_size < WS_END) { fprintf(stderr, "kernel_launch: unexpected shapes (n_in %d out %d ws %zu need %zu)\n", n_in, out_size, ws_size, (size_t)WS_END); grid = -1; return; }
        int dev = 0, cus = 0, per_cu = 0;
        if (hipGetDevice(&dev) != hipSuccess || hipDeviceGetAttribute(&cus, hipDeviceAttributeMultiprocessorCount, dev) != hipSuccess) { grid = -1; return; }
        if (hipFuncSetAttribute((const void*)mk_fwd, hipFuncAttributeMaxDynamicSharedMemorySize, LDS_BYTES) != hipSuccess) { fprintf(stderr, "kernel_launch: hipFuncSetAttribute failed\n"); grid = -1; return; }
        if (hipOccupancyMaxActiveBlocksPerMultiprocessor(&per_cu, (const void*)mk_fwd, NTHR, LDS_BYTES) != hipSuccess || per_cu < 1) fprintf(stderr, "kernel_launch: occupancy query says %d\n", per_cu);
        (void)hipGetLastError();
        if (cus < GRID) { fprintf(stderr, "kernel_launch: %d CUs; this kernel needs %d (one resident workgroup per CU)\n", cus, GRID); grid = -1; return; }
        grid = GRID;
    }
    if (grid < 0) return;
    if (hipMemsetAsync((char*)d_ws + WS_CTL, 0, CTL_ZERO_BYTES, stream) != hipSuccess) return;
    Args a{};
    for (int i = 0; i < 29; ++i) a.in[i] = (const float*)d_in[i];
    a.out = (float*)d_out; a.ws = (unsigned char*)d_ws;
#if MK_PER_PHASE
    for (int p = 0; p < N_PHASES; ++p) { a.ph_lo = p; a.ph_hi = p + 1; hipLaunchKernelGGL(mk_fwd, dim3(grid), dim3(NTHR), LDS_BYTES, stream, a); }
#else
    a.ph_lo = 0; a.ph_hi = N_PHASES; hipLaunchKernelGGL(mk_fwd, dim3(grid), dim3(NTHR), LDS_BYTES, stream, a);
#endif
}
```

```cpp
#include <hip/hip_runtime.h>
#include <cstdio>
#include <cstdint>
#include <cmath>
namespace pg8 {
#define PG8_LAS __attribute__((address_space(3)))
typedef unsigned short bf16_t;
typedef short bf16x8 __attribute__((ext_vector_type(8)));
typedef float f32x4 __attribute__((ext_vector_type(4)));
typedef unsigned u32x4 __attribute__((ext_vector_type(4)));
constexpr int BM = 256, BK = 64, HALF = 128, HTB = HALF * BK * 2  , STAGE_BYTES = 8 * HTB, NXCD = 8, WGM = 8;

__host__ __device__ __forceinline__ int lds_byte(int r, int c) { const int st = (r >> 4) * 2 + (c >> 5), rr = r & 15, cc = c & 31, ob = rr * 64 + cc * 2; return st * 1024 + (ob ^ (((ob >> 9) & 1) << 5)); }
__host__ __device__ __forceinline__ void stage_rc(int b, int& R, int& C) { const int st = b / 1024, sb = b % 1024, swz = sb ^ (((sb >> 9) & 1) << 5); R = (st >> 1) * 16 + swz / 64; C = (st & 1) * 32 + (swz % 64) / 2; }
__host__ __device__ __forceinline__ int perm32(int rho) { const int n = rho >> 4, i = rho & 15; return 8 * (i >> 2) + 4 * n + (i & 3); }

struct Unit { int pm, pn; };
struct Gemm { const bf16_t* A; const bf16_t* Bt; int M, N, K; };

struct StaticOrder {
    int nM, nN, nwg, G, c;
    __host__ __device__ void init(int M, int N, int G_, int c_) { nM = M / BM; nN = N / BM; nwg = nM * nN; G = G_; c = c_; }
    __host__ __device__ bool next(int i, Unit& u) const {
        const long L = (long)i * G + c; if (L >= nwg) return false;
        int wgid = (int)L; { const int q = nwg / NXCD, r = nwg % NXCD, xcd = wgid % NXCD, off = wgid / NXCD; wgid = (xcd < r ? xcd * (q + 1) : r * (q + 1) + (xcd - r) * q) + off; }
        const int nig = WGM * nN, gid = wgid / nig, fm = gid * WGM, gsz = (nM - fm) < WGM ? (nM - fm) : WGM;
        u.pm = fm + ((wgid % nig) % gsz); u.pn = (wgid % nig) / gsz; return true;
    }
    __device__ __forceinline__ void a_ready(const Unit&) const {}
    __device__ __forceinline__ void done(const Unit&) const {}
};

__device__ __forceinline__ unsigned cvt_pk_bf16(float lo, float hi) { unsigned r; asm volatile("v_cvt_pk_bf16_f32 %0, %1, %2" : "=v"(r) : "v"(lo), "v"(hi)); return r; }
typedef float f32x2 __attribute__((ext_vector_type(2)));
template <class Epi, class Sched, bool ALIGN_EPI = false, bool SP2 = false>
__device__ __forceinline__ void gemm_phase(PG8_LAS unsigned char* lds, const Gemm g, const Sched& S, const Epi& E, int wave_) {
    int tid_ = (int)__builtin_amdgcn_mbcnt_hi(~0u, __builtin_amdgcn_mbcnt_lo(~0u, 0u)) + 64 * wave_; asm volatile("" : "+v"(tid_));
    const int tid = tid_, wid = __builtin_amdgcn_readfirstlane(tid >> 6), lane = tid & 63, wr = wid >> 2, wc = wid & 3, fr = lane & 15, fq = lane >> 4;
    const int K = g.K, nt = K / BK;
    unsigned voffA[2], voffB[2];
#pragma unroll
    for (int i = 0; i < 2; ++i) { int R, C; stage_rc(tid * 16 + i * 8192, R, C); const int Rb = Epi::PERM ? ((R & ~31) + perm32(R & 31)) : R;
        voffA[i] = (unsigned)(R * K + C) * 2u; voffB[i] = (unsigned)(Rb * K + C) * 2u; }
    const size_t kstep = (size_t)(BK * 2);
    const size_t hstep = (size_t)HALF * K * 2;
    const size_t tstep = 2 * hstep;
    const unsigned ldsw = (unsigned)wid * 1024u;
    const int aoff = lds_byte(wr * 64 + fr, fq * 8), boff = lds_byte(wc * 32 + fr, fq * 8);
#define PG8_SA(b, h) (((b) * 2 + (h)) * HTB)
#define PG8_SB(b, h) ((4 + (b) * 2 + (h)) * HTB)
#define PG8_STAGE(bufoff, gbase, voff) do { _Pragma("unroll") for (int _i = 0; _i < 2; ++_i) \
        __builtin_amdgcn_global_load_lds((const unsigned*)((const char*)(gbase) + (voff)[_i]), (PG8_LAS unsigned*)(lds + (bufoff) + ldsw + _i * 8192), 16, 0, 0); } while (0)
#define PG8_LDA(dst, b, h) do { _Pragma("unroll") for (int m = 0; m < 4; ++m) _Pragma("unroll") for (int k = 0; k < 2; ++k) dst[m][k] = *(const PG8_LAS bf16x8*)(lds + PG8_SA(b, h) + aoff + m * 2048 + k * 1024); } while (0)
#define PG8_LDB(dst, b, h) do { _Pragma("unroll") for (int n = 0; n < 2; ++n) _Pragma("unroll") for (int k = 0; k < 2; ++k) dst[n][k] = *(const PG8_LAS bf16x8*)(lds + PG8_SB(b, h) + boff + n * 2048 + k * 1024); } while (0)
#define PG8_MMA(ai, bj, At, Bt) do { __builtin_amdgcn_s_setprio(1); _Pragma("unroll") for (int m = 0; m < 4; ++m) _Pragma("unroll") for (int n = 0; n < 2; ++n) _Pragma("unroll") for (int k = 0; k < 2; ++k) \
        acc[ai][bj][m][n] = __builtin_amdgcn_mfma_f32_16x16x32_bf16(Bt[n][k], At[m][k], acc[ai][bj][m][n], 0, 0, 0); __builtin_amdgcn_s_setprio(0); } while (0)
#define PG8_WAIT_V(n) asm volatile("s_waitcnt vmcnt(" #n ")" ::: "memory")
#define PG8_WAIT_L(n) asm volatile("s_waitcnt lgkmcnt(" #n ")" ::: "memory")
#define PG8_BAR __builtin_amdgcn_s_barrier()
#define PG8_SCHED __builtin_amdgcn_sched_barrier(0)
    Unit cur, nxt; int ui = 0;
    if (!S.next(0, cur)) return;
    f32x4 acc[2][2][4][2];
#pragma unroll
    for (int a = 0; a < 2; ++a)
#pragma unroll
        for (int b = 0; b < 2; ++b)
#pragma unroll
            for (int m = 0; m < 4; ++m)
#pragma unroll
                for (int n = 0; n < 2; ++n) acc[a][b][m][n] = (f32x4){0.f, 0.f, 0.f, 0.f};
    bf16x8 At[4][2], B0[2][2], B1[2][2];
    const char* cA = (const char*)g.A + (size_t)cur.pm * tstep; const char* cB = (const char*)g.Bt + (size_t)cur.pn * tstep;
    S.a_ready(cur);
    if constexpr (SP2) {
        PG8_STAGE(PG8_SB(0, 0), cB, voffB); PG8_STAGE(PG8_SB(0, 1), cB + hstep, voffB); PG8_STAGE(PG8_SA(0, 0), cA, voffA); PG8_STAGE(PG8_SA(0, 1), cA + hstep, voffA);
        if (wr == 1) PG8_BAR;
        PG8_WAIT_V(2); PG8_BAR;
        PG8_STAGE(PG8_SB(1, 0), cB + kstep, voffB); PG8_STAGE(PG8_SA(1, 0), cA + kstep, voffA); PG8_STAGE(PG8_SB(1, 1), cB + hstep + kstep, voffB);
        PG8_WAIT_V(6); PG8_BAR;
    } else {
        PG8_STAGE(PG8_SB(0, 0), cB, voffB); PG8_STAGE(PG8_SA(0, 0), cA, voffA); PG8_STAGE(PG8_SB(0, 1), cB + hstep, voffB); PG8_STAGE(PG8_SA(0, 1), cA + hstep, voffA);
        if (wr == 1) PG8_BAR;
        PG8_WAIT_V(4); PG8_BAR;
        PG8_STAGE(PG8_SB(1, 0), cB + kstep, voffB); PG8_STAGE(PG8_SA(1, 0), cA + kstep, voffA); PG8_STAGE(PG8_SB(1, 1), cB + hstep + kstep, voffB);
        PG8_WAIT_V(6); PG8_BAR;
    }
    for (;;) {
        const bool has_next = S.next(ui + 1, nxt);
        const char* nA = has_next ? (const char*)g.A + (size_t)nxt.pm * tstep : cA; const char* nB = has_next ? (const char*)g.Bt + (size_t)nxt.pn * tstep : cB;
        for (int t = 0; t < nt; t += 2) {
            const bool last = (t == nt - 2);
            const char* a1 = cA + (size_t)(t + 1) * kstep;
            const char* a2 = last ? nA : cA + (size_t)(t + 2) * kstep; const char* b2 = last ? nB : cB + (size_t)(t + 2) * kstep;
            const char* a3 = a2 + kstep; const char* b3 = b2 + kstep;
            if (last && has_next) S.a_ready(nxt);
            if constexpr (SP2) {
            PG8_LDB(B0, 0, 0); PG8_LDB(B1, 0, 1); PG8_SCHED; PG8_LDA(At, 0, 0); PG8_STAGE(PG8_SA(1, 1), a1 + hstep, voffA);
            PG8_WAIT_V(8); PG8_WAIT_L(0); PG8_BAR; PG8_MMA(0, 0, At, B0); PG8_MMA(0, 1, At, B1); PG8_BAR; PG8_SCHED;
            PG8_LDA(At, 0, 1); PG8_STAGE(PG8_SB(0, 0), b2, voffB); PG8_STAGE(PG8_SB(0, 1), b2 + hstep, voffB); PG8_STAGE(PG8_SA(0, 0), a2, voffA);
            PG8_WAIT_V(8); PG8_WAIT_L(0); PG8_BAR; PG8_MMA(1, 0, At, B0); PG8_MMA(1, 1, At, B1); PG8_BAR; PG8_SCHED;
            PG8_LDB(B0, 1, 0); PG8_LDB(B1, 1, 1); PG8_SCHED; PG8_LDA(At, 1, 0); PG8_STAGE(PG8_SA(0, 1), a2 + hstep, voffA);
            PG8_WAIT_V(8); PG8_WAIT_L(0); PG8_BAR; PG8_MMA(0, 0, At, B0); PG8_MMA(0, 1, At, B1); PG8_BAR; PG8_SCHED;
            PG8_LDA(At, 1, 1); PG8_STAGE(PG8_SB(1, 0), b3, voffB); PG8_STAGE(PG8_SB(1, 1), b3 + hstep, voffB); PG8_STAGE(PG8_SA(1, 0), a3, voffA);
            PG8_WAIT_V(8); PG8_WAIT_L(0); PG8_BAR; PG8_MMA(1, 0, At, B0); PG8_MMA(1, 1, At, B1); PG8_BAR; PG8_SCHED;
            } else {
            PG8_LDB(B0, 0, 0); PG8_SCHED; PG8_LDA(At, 0, 0); PG8_STAGE(PG8_SA(1, 1), a1 + hstep, voffA);
            PG8_WAIT_L(8); PG8_BAR; PG8_WAIT_L(0); PG8_MMA(0, 0, At, B0); PG8_BAR; PG8_SCHED;
            PG8_LDB(B1, 0, 1); PG8_STAGE(PG8_SB(0, 0), b2, voffB);
            PG8_BAR; PG8_WAIT_L(0); PG8_MMA(0, 1, At, B1); PG8_BAR;
            PG8_LDA(At, 0, 1); PG8_STAGE(PG8_SA(0, 0), a2, voffA);
            PG8_BAR; PG8_WAIT_L(0); PG8_MMA(1, 0, At, B0); PG8_BAR; PG8_SCHED;
            PG8_STAGE(PG8_SB(0, 1), b2 + hstep, voffB);
            PG8_WAIT_V(6); PG8_BAR; PG8_MMA(1, 1, At, B1); PG8_BAR;
            PG8_LDB(B0, 1, 0); PG8_SCHED; PG8_LDA(At, 1, 0); PG8_STAGE(PG8_SA(0, 1), a2 + hstep, voffA);
            PG8_WAIT_L(8); PG8_BAR; PG8_WAIT_L(0); PG8_MMA(0, 0, At, B0); PG8_BAR; PG8_SCHED;
            PG8_LDB(B1, 1, 1); PG8_STAGE(PG8_SB(1, 0), b3, voffB);
            PG8_BAR; PG8_WAIT_L(0); PG8_MMA(0, 1, At, B1); PG8_BAR;
            PG8_LDA(At, 1, 1); PG8_STAGE(PG8_SA(1, 0), a3, voffA);
            PG8_BAR; PG8_WAIT_L(0); PG8_MMA(1, 0, At, B0); PG8_BAR; PG8_SCHED;
            PG8_STAGE(PG8_SB(1, 1), b3 + hstep, voffB);
            PG8_WAIT_V(6); PG8_BAR; PG8_MMA(1, 1, At, B1); PG8_BAR;
            }
        }
        if constexpr (ALIGN_EPI) { if (wr == 0) PG8_BAR; }
        if constexpr (Epi::ROWSCALE) {
#pragma unroll
            for (int a = 0; a < 2; ++a)
#pragma unroll
                for (int m = 0; m < 4; ++m) { const float s_ = E.rs[cur.pm * BM + a * HALF + wr * 64 + m * 16 + fr];
#pragma unroll
                    for (int b = 0; b < 2; ++b)
#pragma unroll
                        for (int n = 0; n < 2; ++n) acc[a][b][m][n] = acc[a][b][m][n] * s_; }
        }
        if constexpr (!Epi::AFTER_DRAIN) { E(acc, cur, wr, wc, fr, fq); S.done(cur); }
        if (!has_next) break;
#pragma unroll
        for (int a = 0; a < 2; ++a)
#pragma unroll
            for (int b = 0; b < 2; ++b)
#pragma unroll
                for (int m = 0; m < 4; ++m)
#pragma unroll
                    for (int n = 0; n < 2; ++n) acc[a][b][m][n] = (f32x4){0.f, 0.f, 0.f, 0.f};
        cur = nxt; cA = nA; cB = nB; ++ui;
        if constexpr (ALIGN_EPI) { if (wr == 1) PG8_BAR; }
    }
    PG8_WAIT_V(0);
    if constexpr (!ALIGN_EPI) { if (wr == 0) PG8_BAR; }
    PG8_BAR;
    if constexpr (Epi::AFTER_DRAIN) { E.fused(acc, cur, wr, wc, fr, fq, lds, wid, lane); S.done(cur); }
#undef PG8_SA
#undef PG8_SB
#undef PG8_STAGE
#undef PG8_LDA
#undef PG8_LDB
#undef PG8_MMA
#undef PG8_WAIT_V
#undef PG8_WAIT_L
#undef PG8_BAR
#undef PG8_SCHED
}
}

#define GAS __attribute__((address_space(1)))
#define LAS __attribute__((address_space(3)))
typedef unsigned short bf16;
typedef unsigned v4u __attribute__((ext_vector_type(4)));
typedef unsigned v2u __attribute__((ext_vector_type(2)));
typedef float f32x4 __attribute__((ext_vector_type(4)));
typedef float f32x2 __attribute__((ext_vector_type(2)));
typedef short bf16x8 __attribute__((ext_vector_type(8)));
typedef float f32x16 __attribute__((ext_vector_type(16)));
#define RLX_AGENT __ATOMIC_RELAXED, __HIP_MEMORY_SCOPE_AGENT
#define LDS_WAIT() asm volatile("s_waitcnt lgkmcnt(0)" ::: "memory")
#define VM_WAIT() asm volatile("s_waitcnt vmcnt(0)" ::: "memory")

constexpr int NWAVES = 8, NTHR = 512, GRID = 256;
constexpr int DM = 1024, NB = 8, SEQ = 2048, DEPTH = 4, DB = 128;
constexpr int MP = NB * SEQ;
constexpr int MS = DB;
constexpr int MR = MP + MS;
constexpr int MT = 16640;
constexpr int PIN = 2816, DFF = 2816, UPW = 5632;
constexpr int C_K = 512, C_V = 640, C_QR = 768, C_FR = 1280, C_IR = 1792, C_GR = 2304;
constexpr int NMEM = 256, XH = 4, XHD = 256;
constexpr int WIN = 128, PAST = 8192;
constexpr float EPS = 1e-6f;

constexpr size_t O_YP = 0;
constexpr size_t O_YS = O_YP + (size_t)MP * DM;
constexpr size_t O_WKP = O_YS + (size_t)MS * DM;
constexpr size_t O_WVP = O_WKP + (size_t)DEPTH * NB * 128 * 128;
constexpr size_t O_WKS = O_WVP + (size_t)DEPTH * NB * 128 * 128;
constexpr size_t O_WVS = O_WKS + (size_t)DEPTH * DB * 128;
constexpr size_t O_MKP = O_WVS + (size_t)DEPTH * DB * 128;
constexpr size_t O_MVP = O_MKP + (size_t)DEPTH * NB * NMEM * DM;
constexpr size_t O_HP = O_MVP + (size_t)DEPTH * NB * NMEM * DM;
constexpr size_t O_HS = O_HP + (size_t)DEPTH * NB * 4 * 128 * 128;
constexpr size_t O_CP = O_HS + (size_t)DEPTH * DB * 4 * 128 * 128;
constexpr size_t O_CS = O_CP + (size_t)DEPTH * NB * 2 * UPW;
constexpr size_t O_END = O_CS + (size_t)DEPTH * DB * 2 * UPW;

constexpr size_t MiB = 1u << 20;
constexpr size_t WS_CTL = 0, CTL_ZERO_BYTES = 1 * MiB;
constexpr size_t WS_TAB = 1 * MiB;
constexpr size_t TAB_COS = 0, TAB_SIN = 2049 * 32 * 4, TAB_LB = 2 * 2049 * 32 * 4;
constexpr size_t WS_WIN = 2 * MiB;
constexpr size_t WS_WO = WS_WIN + (size_t)DEPTH * PIN * DM * 2;
constexpr size_t WS_WXQ = WS_WO + (size_t)DEPTH * DM * DM * 2;
constexpr size_t WS_WXKV = WS_WXQ + (size_t)DEPTH * DM * DM * 2;
constexpr size_t WS_WXO = WS_WXKV + (size_t)DEPTH * 2 * DM * DM * 2;
constexpr size_t WS_WUP = WS_WXO + (size_t)DEPTH * DM * DM * 2;
constexpr size_t WS_WDN = WS_WUP + (size_t)DEPTH * UPW * DM * 2;
constexpr size_t WS_X = WS_WDN + (size_t)DEPTH * DM * DFF * 2;
constexpr size_t WS_XN = WS_X + (size_t)MT * DM * 4;
constexpr size_t WS_PROJ = WS_XN + (size_t)MT * DM * 2;
constexpr size_t WS_LF = WS_PROJ + (size_t)MT * PIN * 2;
constexpr size_t WS_MIX = WS_LF + (size_t)MT * 512 * 4;
constexpr size_t WS_Y = WS_MIX + (size_t)MT * DM * 2;
constexpr size_t WS_QX = WS_Y + (size_t)MT * DM * 4;
constexpr size_t WS_OX = WS_QX + (size_t)MT * DM * 2;
constexpr size_t WS_U = WS_OX + (size_t)MT * DM * 2;
constexpr size_t WS_G = WS_U + (size_t)MT * UPW * 2;
constexpr size_t WS_MEMN = WS_G + (size_t)MT * DFF * 2;
constexpr size_t WS_MK = WS_MEMN + (size_t)DEPTH * 2048 * DM * 2;
constexpr size_t WS_MVT = WS_MK + (size_t)DEPTH * 2048 * DM * 2;
constexpr size_t WS_HQ = WS_MVT + (size_t)DEPTH * 2048 * DM * 2;
constexpr size_t WS_HK = WS_HQ + (size_t)NB * 4 * 128 * SEQ * 2;
constexpr size_t WS_HV = WS_HK + (size_t)NB * 4 * 128 * SEQ * 2;
constexpr size_t WS_HLF = WS_HV + (size_t)NB * 4 * 128 * SEQ * 2;
constexpr size_t WS_HQB = WS_HLF + (size_t)NB * 4 * 128 * SEQ * 4;
constexpr size_t WS_HOP = WS_HQB + (size_t)MP * 512 * 2;
constexpr size_t WS_HSL = WS_HOP + (size_t)MP * 512 * 4;
constexpr size_t WS_HDE = WS_HSL + (size_t)256 * 128 * 128 * 4;
constexpr size_t WS_RS = WS_HDE + (size_t)256 * 128 * 4;
constexpr size_t WS_END = WS_RS + (size_t)MT * 4;
static_assert(WS_HK - WS_HQ == (size_t)NB * 4 * 128 * SEQ * 2 && WS_HV - WS_HK == WS_HK - WS_HQ, "HQ | HK | HV consecutive");

constexpr int CW_TMO = 0, CW_CODE = 1;
constexpr int CW_BAR = 4096;

constexpr int RING_OFF = 0, RING_BYTES = 131072;
constexpr int LDSCTL_OFF = RING_BYTES, MISC_OFF = LDSCTL_OFF + 320;
constexpr int LDS_BYTES = 147456;

__device__ __forceinline__ unsigned f2bf(float f) { unsigned u = __builtin_bit_cast(unsigned, f); return (u + 0x7fffu + ((u >> 16) & 1u)) >> 16; }
__device__ __forceinline__ unsigned pk2(float lo, float hi) { return f2bf(lo) | (f2bf(hi) << 16); }
__device__ __forceinline__ float bf2f(unsigned short b) { return __builtin_bit_cast(float, (unsigned)b << 16); }
__device__ __forceinline__ float bflo(unsigned w) { return __builtin_bit_cast(float, w << 16); }
__device__ __forceinline__ float bfhi(unsigned w) { return __builtin_bit_cast(float, w & 0xffff0000u); }
__device__ __forceinline__ float sigmoidf_(float z) { return 1.0f / (1.0f + __expf(-z)); }
__device__ __forceinline__ float siluf_(float z) { return z * __builtin_amdgcn_rcpf(1.0f + __expf(-z)); }
typedef __bf16 bf16x2_t __attribute__((ext_vector_type(2)));
__device__ __forceinline__ unsigned cvtpk(float lo, float hi) { f32x2 v = {lo, hi}; bf16x2_t b = __builtin_convertvector(v, bf16x2_t); return __builtin_bit_cast(unsigned, b); }
#define MFMA32(a, b, c) __builtin_amdgcn_mfma_f32_32x32x16_bf16((a), (b), (c), 0, 0, 0)
#define LDS_BAR() do { asm volatile("s_waitcnt lgkmcnt(0)" ::: "memory"); __builtin_amdgcn_s_barrier(); asm volatile("" ::: "memory"); } while (0)
__device__ __forceinline__ float wave_sum(float v) {
#pragma unroll
    for (int o = 1; o < 64; o <<= 1) v += __shfl_xor(v, o);
    return v;
}
__device__ __forceinline__ float wave_max(float v) {
#pragma unroll
    for (int o = 1; o < 64; o <<= 1) v = fmaxf(v, __shfl_xor(v, o));
    return v;
}

namespace pg8 {
struct EpiF32 {
    static constexpr bool PERM = false, AFTER_DRAIN = false, ROWSCALE = false;
    float* O; int ldc;
    __device__ __forceinline__ void operator()(const f32x4 (&acc)[2][2][4][2], const Unit& u, int wr, int wc, int fr, int fq) const {
        const int row0 = u.pm * BM + wr * 64 + fr, col0 = u.pn * BM + wc * 32 + 4 * fq;
#pragma unroll
        for (int ai = 0; ai < 2; ++ai)
#pragma unroll
            for (int m = 0; m < 4; ++m) { float* rowp = O + (size_t)(row0 + ai * HALF + m * 16) * ldc + col0;
#pragma unroll
                for (int bj = 0; bj < 2; ++bj)
#pragma unroll
                    for (int n = 0; n < 2; ++n) *(f32x4*)(rowp + bj * HALF + n * 16) = acc[ai][bj][m][n]; }
    }
};
struct EpiB16 {
    static constexpr bool PERM = true, AFTER_DRAIN = false, ROWSCALE = false;
    bf16_t* O; int ldc; float sc; const float* rs;
    __device__ __forceinline__ void operator()(const f32x4 (&acc)[2][2][4][2], const Unit& u, int wr, int wc, int fr, int fq) const {
        const int row0 = u.pm * BM + wr * 64 + fr, col0 = u.pn * BM + wc * 32 + 8 * fq;
#pragma unroll
        for (int ai = 0; ai < 2; ++ai)
#pragma unroll
            for (int m = 0; m < 4; ++m) { const int row = row0 + ai * HALF + m * 16; bf16_t* rowp = O + (size_t)row * ldc + col0; const float s = rs ? sc * rs[row] : sc;
#pragma unroll
                for (int bj = 0; bj < 2; ++bj) { const f32x4 v0 = acc[ai][bj][m][0] * s, v1 = acc[ai][bj][m][1] * s;
                    u32x4 w; w.x = cvt_pk_bf16(v0[0], v0[1]); w.y = cvt_pk_bf16(v0[2], v0[3]); w.z = cvt_pk_bf16(v1[0], v1[1]); w.w = cvt_pk_bf16(v1[2], v1[3]);
                    *(u32x4*)(rowp + bj * HALF) = w; } }
    }
};
struct EpiProj {
    static constexpr bool PERM = true, AFTER_DRAIN = false, ROWSCALE = false;
    bf16_t* P; float* LF; const float* lb;
    bf16_t* HQ; bf16_t* HK; bf16_t* HV; float* HLF;
    __device__ __forceinline__ void operator()(const f32x4 (&acc)[2][2][4][2], const Unit& u, int wr, int wc, int fr, int fq) const {
        const int row0 = u.pm * BM + wr * 64 + fr, col0 = u.pn * BM + wc * 32 + 8 * fq;
        const int pn = u.pn;
        const int mode = (pn == 3 || pn == 4 || pn == 9 || pn == 10) ? 1 : ((pn == 5 || pn == 6) ? 2 : 0);
        if (pn >= 3 && pn <= 8 && u.pm < 64) {
            const int grp = (pn - 3) >> 1;
            bf16_t* T16 = HQ + (size_t)grp * ((size_t)NB * 4 * 128 * SEQ);
#pragma unroll
            for (int bj = 0; bj < 2; ++bj) { const int hd = ((pn - 3) & 1) * 2 + bj, k0 = wc * 32 + 8 * fq; const int c = hd * 128 + k0;
                f32x4 l0 = {0.f, 0.f, 0.f, 0.f}, l1 = l0; if (grp == 1) { l0 = *(const f32x4*)(lb + c); l1 = *(const f32x4*)(lb + c + 4); }
#pragma unroll
                for (int ai = 0; ai < 2; ++ai)
#pragma unroll
                    for (int m = 0; m < 4; ++m) { const int row = row0 + ai * HALF + m * 16; const int b_ = row >> 11, t_ = row & 2047;
                        const unsigned base = ((((unsigned)(b_ * 4 + hd) * 32u + (unsigned)(t_ >> 6)) * 4u + (unsigned)((t_ >> 4) & 3)) * 128u + (unsigned)k0) * 16u + (unsigned)(t_ & 15);
#pragma unroll
                        for (int n = 0; n < 2; ++n)
#pragma unroll
                            for (int e = 0; e < 4; ++e) { float z = acc[ai][bj][m][n][e]; const unsigned a = base + (unsigned)(4 * n + e) * 16u;
                                if (grp == 0) { z = z * __builtin_amdgcn_rcpf(1.f + __expf(-z)); T16[a] = (bf16_t)(cvt_pk_bf16(z, 0.f) & 0xffffu); }
                                else if (grp == 2) { T16[a] = (bf16_t)(cvt_pk_bf16(z, 0.f) & 0xffffu); }
                                else { z = fminf(fmaxf(z, -40.f), 40.f); const float lbv = n ? l1[e] : l0[e]; const float ez = __expf(-z);
                                    const float rz = __builtin_amdgcn_rcpf(1.f + ez); const float f = lbv + (1.f - lbv) * rz, kk = (1.f - lbv) * ez * rz;
                                    (void)kk; T16[a] = __builtin_bit_cast(unsigned short, (_Float16)__log2f(f)); } } } }
        } else if (mode == 2) {
#pragma unroll
            for (int bj = 0; bj < 2; ++bj) { const int c = col0 + bj * HALF - 1280;
                const f32x4 l0 = *(const f32x4*)(lb + c), l1 = *(const f32x4*)(lb + c + 4);
#pragma unroll
                for (int ai = 0; ai < 2; ++ai)
#pragma unroll
                    for (int m = 0; m < 4; ++m) { const size_t row = (size_t)(row0 + ai * HALF + m * 16);
                        f32x4 z0 = acc[ai][bj][m][0], z1 = acc[ai][bj][m][1]; f32x4 f0, f1, k0, k1;
#pragma unroll
                        for (int e = 0; e < 4; ++e) { z0[e] = fminf(fmaxf(z0[e], -40.f), 40.f); z1[e] = fminf(fmaxf(z1[e], -40.f), 40.f); }
#pragma unroll
                        for (int e = 0; e < 4; ++e) { const float ez0 = __expf(-z0[e]), ez1 = __expf(-z1[e]);
                            const float r0_ = __builtin_amdgcn_rcpf(1.f + ez0), r1_ = __builtin_amdgcn_rcpf(1.f + ez1);
                            f0[e] = l0[e] + (1.f - l0[e]) * r0_; k0[e] = (1.f - l0[e]) * ez0 * r0_;
                            f1[e] = l1[e] + (1.f - l1[e]) * r1_; k1[e] = (1.f - l1[e]) * ez1 * r1_; }
#pragma unroll
                        for (int e = 0; e < 4; ++e) { f0[e] = __log2f(f0[e]); f1[e] = __log2f(f1[e]); }
                        *(f32x4*)(LF + row * 512 + c) = f0; *(f32x4*)(LF + row * 512 + c + 4) = f1;
                        u32x4 w; w.x = cvt_pk_bf16(k0[0], k0[1]); w.y = cvt_pk_bf16(k0[2], k0[3]); w.z = cvt_pk_bf16(k1[0], k1[1]); w.w = cvt_pk_bf16(k1[2], k1[3]);
                        *(u32x4*)(P + row * PIN + col0 + bj * HALF) = w; } }
        } else {
#pragma unroll
            for (int ai = 0; ai < 2; ++ai)
#pragma unroll
                for (int m = 0; m < 4; ++m) { bf16_t* rowp = P + (size_t)(row0 + ai * HALF + m * 16) * PIN + col0;
#pragma unroll
                    for (int bj = 0; bj < 2; ++bj) { f32x4 v0 = acc[ai][bj][m][0], v1 = acc[ai][bj][m][1];
                        if (mode == 1) {
#pragma unroll
                            for (int e = 0; e < 4; ++e) { v0[e] = v0[e] * __builtin_amdgcn_rcpf(1.f + __expf(-v0[e])); v1[e] = v1[e] * __builtin_amdgcn_rcpf(1.f + __expf(-v1[e])); } }
                        u32x4 w; w.x = cvt_pk_bf16(v0[0], v0[1]); w.y = cvt_pk_bf16(v0[2], v0[3]); w.z = cvt_pk_bf16(v1[0], v1[1]); w.w = cvt_pk_bf16(v1[2], v1[3]);
                        *(u32x4*)(rowp + bj * HALF) = w; } }
        }
    }
};
struct EpiMemKV {
    static constexpr bool PERM = false, AFTER_DRAIN = false, ROWSCALE = false;
    float* OK; float* OV; bf16_t* MK; bf16_t* MVT;
    __device__ __forceinline__ void operator()(const f32x4 (&acc)[2][2][4][2], const Unit& u, int wr, int wc, int fr, int fq) const {
        const int layer = u.pm >> 3, pml = u.pm & 7, pnl = u.pn & 7;
        const int row0 = pml * BM + wr * 64 + fr; const int col0 = (pnl & 3) * BM + wc * 32 + 4 * fq;
        if (pnl < 4) {
            float* O = OK + (size_t)layer * 2048 * 1024; bf16_t* B = MK + (size_t)layer * 2048 * 1024;
#pragma unroll
            for (int ai = 0; ai < 2; ++ai)
#pragma unroll
                for (int m = 0; m < 4; ++m) { const size_t off = (size_t)(row0 + ai * HALF + m * 16) * 1024 + col0;
#pragma unroll
                    for (int bj = 0; bj < 2; ++bj)
#pragma unroll
                        for (int n = 0; n < 2; ++n) { const f32x4 v = acc[ai][bj][m][n]; *(f32x4*)(O + off + bj * HALF + n * 16) = v;
                            v2u w; w.x = cvt_pk_bf16(v[0], v[1]); w.y = cvt_pk_bf16(v[2], v[3]); *(v2u*)(B + off + bj * HALF + n * 16) = w; } }
        } else {
            float* O = OV + (size_t)layer * 2048 * 1024; bf16_t* T = MVT + (size_t)layer * 2048 * 1024;
#pragma unroll
            for (int ai = 0; ai < 2; ++ai)
#pragma unroll
                for (int m = 0; m < 4; ++m) { const int row = row0 + ai * HALF + m * 16; const size_t off = (size_t)row * 1024 + col0; const int b_ = row >> 8, mm = row & 255;
#pragma unroll
                    for (int bj = 0; bj < 2; ++bj)
#pragma unroll
                        for (int n = 0; n < 2; ++n) { const f32x4 v = acc[ai][bj][m][n]; *(f32x4*)(O + off + bj * HALF + n * 16) = v;
                            const int c = col0 + bj * HALF + n * 16; const int hd = c >> 8, d = c & 255;
                            bf16_t* tp = T + ((size_t)(b_ * 4 + hd) * 256 + d) * 256 + mm;
                            const unsigned w0 = cvt_pk_bf16(v[0], v[1]), w1 = cvt_pk_bf16(v[2], v[3]);
                            tp[0] = (bf16_t)(w0 & 0xffffu); tp[256] = (bf16_t)(w0 >> 16); tp[512] = (bf16_t)(w1 & 0xffffu); tp[768] = (bf16_t)(w1 >> 16); } }
        }
    }
};

template <int CTRL> __device__ __forceinline__ float dppf(float x) { return __builtin_bit_cast(float, __builtin_amdgcn_update_dpp(0, __builtin_bit_cast(int, x), CTRL, 0xf, 0xf, true)); }
template <int CTRL> __device__ __forceinline__ float dpps(float oldv, float x) { return __builtin_bit_cast(float, __builtin_amdgcn_update_dpp(__builtin_bit_cast(int, oldv), __builtin_bit_cast(int, x), CTRL, 0xf, 0xf, false)); }
struct EpiUpConv {
    static constexpr bool PERM = true, AFTER_DRAIN = false, ROWSCALE = true;
    bf16_t* G; bf16_t* UB; bf16_t* US; const float* rs; const float* cw; const float* cb;
    __device__ __forceinline__ void operator()(const f32x4 (&acc)[2][2][4][2], const Unit& u, int wr, int wc, int fr, int fq) const {
        const int c0 = u.pn * 128 + wc * 32 + 8 * fq;
        if (u.pm == 64) {
#pragma unroll
            for (int m = 0; m < 4; ++m) { bf16_t* rowp = US + (size_t)(wr * 64 + m * 16 + fr) * UPW + c0;
#pragma unroll
                for (int bj = 0; bj < 2; ++bj) { const f32x4 v0 = acc[0][bj][m][0], v1 = acc[0][bj][m][1];
                    u32x4 w; w.x = cvt_pk_bf16(v0[0], v0[1]); w.y = cvt_pk_bf16(v0[2], v0[3]); w.z = cvt_pk_bf16(v1[0], v1[1]); w.w = cvt_pk_bf16(v1[2], v1[3]);
                    *(u32x4*)(rowp + bj * DFF) = w; } }
            return;
        }
#pragma unroll
        for (int n = 0; n < 2; ++n) {
            const int cc = c0 + 4 * n;
            const f32x4 wa0 = *(const f32x4*)(cw + cc), wa1 = *(const f32x4*)(cw + UPW + cc), wa2 = *(const f32x4*)(cw + 2 * UPW + cc), ba = *(const f32x4*)(cb + cc);
            const f32x4 wb0 = *(const f32x4*)(cw + DFF + cc), wb1 = *(const f32x4*)(cw + UPW + DFF + cc), wb2 = *(const f32x4*)(cw + 2 * UPW + DFF + cc), bb = *(const f32x4*)(cb + DFF + cc);
#pragma unroll
            for (int ai = 0; ai < 2; ++ai) {
                const int blk = u.pm * 4 + ai * 2 + wr, rowbase = u.pm * BM + ai * HALF + wr * 64;
                const bool seqstart = ((u.pm & 7) == 0) && ai == 0 && wr == 0;
#pragma unroll
                for (int m = 0; m < 4; ++m) {
                    const f32x4 ca = acc[ai][0][m][n], cv = acc[ai][1][m][n];
                    f32x4 g;
#pragma unroll
                    for (int e = 0; e < 4; ++e) {
                        float a1, a2, b1, b2;
                        if (m > 0) { const float pa = acc[ai][0][m - 1][n][e], pb = acc[ai][1][m - 1][n][e];
                            a1 = dpps<0x111>(dppf<0x121>(pa), ca[e]); a2 = dpps<0x112>(dppf<0x122>(pa), ca[e]); b1 = dpps<0x111>(dppf<0x121>(pb), cv[e]); b2 = dpps<0x112>(dppf<0x122>(pb), cv[e]); }
                        else { a1 = dppf<0x111>(ca[e]); a2 = dppf<0x112>(ca[e]); b1 = dppf<0x111>(cv[e]); b2 = dppf<0x112>(cv[e]); }
                        const float A = ba[e] + wa0[e] * a2 + wa1[e] * a1 + wa2[e] * ca[e];
                        const float B = bb[e] + wb0[e] * b2 + wb1[e] * b1 + wb2[e] * cv[e];
                        g[e] = A * __builtin_amdgcn_rcpf(1.f + __expf(-A)) * B;
                    }
                    const int row = rowbase + 16 * m + fr;
                    if (m > 0 || fr >= 2 || seqstart) { v2u w; w.x = cvt_pk_bf16(g[0], g[1]); w.y = cvt_pk_bf16(g[2], g[3]); *(v2u*)(G + (size_t)row * DFF + cc) = w; }
                    if ((m == 3 && fr >= 14) || (m == 0 && fr < 2)) { const int slot = (m == 3) ? fr - 14 : 2 + fr; bf16_t* up = UB + ((size_t)(blk * 4 + slot)) * UPW + cc;
                        v2u wa_; wa_.x = cvt_pk_bf16(ca[0], ca[1]); wa_.y = cvt_pk_bf16(ca[2], ca[3]); *(v2u*)up = wa_;
                        v2u wb_; wb_.x = cvt_pk_bf16(cv[0], cv[1]); wb_.y = cvt_pk_bf16(cv[2], cv[3]); *(v2u*)(up + DFF) = wb_; }
                }
            }
        }
    }
};
struct BlockDiagOrder {
    int G, c;
    __device__ __forceinline__ bool next(int i, Unit& u) const { const int L = i * G + c; if (L >= 256) return false; const int layer = L >> 6, r = L & 63; u.pm = layer * 8 + (r & 7); u.pn = layer * 8 + (r >> 3); return true; }
    __device__ __forceinline__ void a_ready(const Unit&) const {}
    __device__ __forceinline__ void done(const Unit&) const {}
};
}
#define XB_TMO      128
#define XB_XCNT(j)  (256  + 64 * (j))
#define XB_XSUB(j)  (1280 + 64 * (j))
#define XB_XGEN(j)  (2304 + 64 * (j))
#define XB_TOP      3328
#define XB_TOPGEN   3392
#define XCD_BAR_WORDS 3456
#define XB_SPIN_CAP (1u << 18)

__device__ __forceinline__ unsigned xb_ld(unsigned* p)              { return __hip_atomic_load(p, __ATOMIC_RELAXED, __HIP_MEMORY_SCOPE_AGENT); }
__device__ __forceinline__ unsigned xb_add(unsigned* p, unsigned v) { return __hip_atomic_fetch_add(p, v, __ATOMIC_RELAXED, __HIP_MEMORY_SCOPE_AGENT); }
__device__ __forceinline__ unsigned xb_xcc_id() { return (unsigned)__builtin_amdgcn_s_getreg((3 << 11) | 20) & 0xFu; }
#define XB_SPIN(cond, bar) do { unsigned _sp = 0; while (cond) { __builtin_amdgcn_s_sleep(1); \
    if ((++_sp & 255u) == 0u) { if (xb_ld(&(bar)[XB_TMO])) break; if (_sp > XB_SPIN_CAP) { atomicAdd(&(bar)[XB_TMO], 1u); break; } } } } while (0)

struct XcdBarrier {
    unsigned* bar; unsigned x;
    volatile LAS unsigned* st;
};

__device__ __forceinline__ XcdBarrier xcd_barrier_post(unsigned* bar, volatile LAS unsigned* st) {
    XcdBarrier b; b.bar = bar; b.x = xb_xcc_id(); b.st = st;
    if (threadIdx.x == 0) (void)xb_add(&bar[XB_XCNT(b.x)], 1u);
    return b;
}
__device__ __forceinline__ void xcd_barrier_complete(unsigned* bar, unsigned x, unsigned& nloc, unsigned& nx) {
    const unsigned G = gridDim.x * gridDim.y * gridDim.z;
    unsigned sum, cnt, mine, sp = 0u;
    for (;;) {
        sum = 0u; cnt = 0u; mine = 0u;
#pragma unroll
        for (unsigned j = 0; j < 16; ++j) { const unsigned c = xb_ld(&bar[XB_XCNT(j)]); sum += c; cnt += (c > 0u) ? 1u : 0u; mine = (j == x) ? c : mine; }
        if (sum == G) break;
        __builtin_amdgcn_s_sleep(1);
        if ((++sp & 255u) == 0u) { if (xb_ld(&bar[XB_TMO])) break; if (sp > XB_SPIN_CAP) { atomicAdd(&bar[XB_TMO], 1u); break; } }
    }
    nloc = mine > 0u ? mine : 1u; nx = cnt > 0u ? cnt : 1u;
}

__device__ __forceinline__ void xcd_barrier(const XcdBarrier& b) {
    asm volatile("s_waitcnt vmcnt(0)" ::: "memory");
    __syncthreads();
    if (threadIdx.x == 0) {
        unsigned* bar = b.bar;
        __builtin_amdgcn_s_waitcnt(0);
        unsigned nloc = b.st[0], nx = b.st[1];
        if (nloc == 0u) { xcd_barrier_complete(bar, b.x, nloc, nx); b.st[0] = nloc; b.st[1] = nx; }
        const unsigned old = xb_add(&bar[XB_XSUB(b.x)], 1u);
        const unsigned gen = old / nloc;
        if (old + 1u == (gen + 1u) * nloc) {
            __builtin_amdgcn_fence(__ATOMIC_RELEASE, "agent");
            asm volatile("s_waitcnt vmcnt(0)" ::: "memory");
            const unsigned og = xb_add(&bar[XB_TOP], 1u);
            const unsigned tg = og / nx;
            if (og + 1u == (tg + 1u) * nx) xb_add(&bar[XB_TOPGEN], 1u);
            else XB_SPIN(xb_ld(&bar[XB_TOPGEN]) == tg, bar);
            __builtin_amdgcn_fence(__ATOMIC_ACQUIRE, "agent");
            xb_add(&bar[XB_XGEN(b.x)], 1u);
            asm volatile("s_waitcnt vmcnt(0)" ::: "memory");
        } else {
            XB_SPIN(xb_ld(&bar[XB_XGEN(b.x)]) == gen, bar);
            __builtin_amdgcn_fence(__ATOMIC_ACQUIRE, "agent");
            asm volatile("s_waitcnt vmcnt(0)" ::: "memory");
        }
    }
    __syncthreads();
}

struct Frame {
    LAS unsigned char* lds;
    volatile LAS unsigned* MISC;
    unsigned* ctl;
    int tid, lane, wave, G, gw, ngw, vcu;
    const float* const* in; float* out; unsigned char* ws;
};
#define IN_XP 0
#define IN_XS 1
#define IN_CWK 2
#define IN_CWV 3
#define IN_CMK 4
#define IN_CMV 5
#define IN_SH 6
#define IN_CFC 7
#define IN_MEM 8
#define IN_WIN 9
#define IN_WO 10
#define IN_SINK 11
#define IN_LBL 12
#define IN_HN 13
#define IN_WXQ 14
#define IN_WXK 15
#define IN_WXV 16
#define IN_WXO 17
#define IN_WUP 18
#define IN_CW 19
#define IN_CB 20
#define IN_WDN 21
#define IN_GPM 22
#define IN_GQM 23
#define IN_GPX 24
#define IN_GQX 25
#define IN_GMEM 26
#define IN_GPF 27
#define IN_GQF 28

__device__ __forceinline__ void p0_transpose_item(const float* W, int K, int N, bf16* WT, int row_off, LAS float* scr, int item, int lane, const float* gk = nullptr, bf16* WTT = nullptr) {
    const int nblk = N / 32, kb = item / nblk, nb = item % nblk, k0 = 64 * kb, n0 = 32 * nb;
#pragma unroll 8
    for (int i = 0; i < 32; ++i) { const int kk = 2 * i + (lane >> 5); scr[kk * 33 + (lane & 31)] = W[(size_t)(k0 + kk) * N + n0 + (lane & 31)]; }
    LDS_WAIT(); asm volatile("" ::: "memory");
    const int c = lane & 7;
    float g8[8];
    if (gk) { const f32x4 a_ = *(const f32x4*)(gk + k0 + 8 * c), b_ = *(const f32x4*)(gk + k0 + 8 * c + 4); g8[0] = a_.x; g8[1] = a_.y; g8[2] = a_.z; g8[3] = a_.w; g8[4] = b_.x; g8[5] = b_.y; g8[6] = b_.z; g8[7] = b_.w; } else {
#pragma unroll
        for (int e = 0; e < 8; ++e) g8[e] = 1.f; }
#pragma unroll
    for (int j = 0; j < 4; ++j) { const int n = (lane >> 3) + 8 * j; const LAS float* s = scr + (8 * c) * 33 + n;
        v4u o; o.x = cvtpk(s[0 * 33] * g8[0], s[1 * 33] * g8[1]); o.y = cvtpk(s[2 * 33] * g8[2], s[3 * 33] * g8[3]); o.z = cvtpk(s[4 * 33] * g8[4], s[5 * 33] * g8[5]); o.w = cvtpk(s[6 * 33] * g8[6], s[7 * 33] * g8[7]);
        *(GAS v4u*)(WT + (size_t)(row_off + n0 + n) * K + k0 + 8 * c) = o;
        if (WTT) { const int nn = n0 + n, kk_ = k0 + 8 * c; *(GAS v4u*)(WTT + ((size_t)((nn >> 4) * (K >> 5) + (kk_ >> 5)) * 64 + ((kk_ & 31) >> 3) * 16 + (nn & 15)) * 8) = o; } }
    LDS_WAIT(); asm volatile("" ::: "memory");
}
__device__ __forceinline__ void row_load(const float* p, int lane, f32x4 (&v)[4]) {
    const GAS f32x4* r = (const GAS f32x4*)p + lane;
#pragma unroll
    for (int j = 0; j < 4; ++j) v[j] = r[64 * j];
}
__device__ __forceinline__ float row_ss(const f32x4 (&v)[4]) {
    float s = 0.f;
#pragma unroll
    for (int j = 0; j < 4; ++j) s += (v[j].x * v[j].x + v[j].y * v[j].y) + (v[j].z * v[j].z + v[j].w * v[j].w);
    return wave_sum(s);
}
__device__ __forceinline__ void row_store_bf16(bf16* p, int lane, const f32x4 (&v)[4]) {
    GAS unsigned long long* o8 = (GAS unsigned long long*)p + lane;
#pragma unroll
    for (int j = 0; j < 4; ++j) o8[64 * j] = (unsigned long long)pk2(v[j].x, v[j].y) | ((unsigned long long)pk2(v[j].z, v[j].w) << 32);
}
__device__ __forceinline__ void row_store_f32(float* p, int lane, const f32x4 (&v)[4]) {
    GAS f32x4* r = (GAS f32x4*)p + lane;
#pragma unroll
    for (int j = 0; j < 4; ++j) r[64 * j] = v[j];
}

__device__ __forceinline__ void p0_prologue(Frame& F) {
    LAS float* scr = (LAS float*)(F.lds + RING_OFF + F.wave * 16384);
    unsigned char* ws = F.ws;
    constexpr int I_IN = 16 * (PIN / 32), I_SQ = 16 * (DM / 32), I_UP = 16 * (UPW / 32), I_DN = (DFF / 64) * (DM / 32);
    constexpr int I_LAYER = I_IN + 5 * I_SQ + I_UP + I_DN;
    for (int it = F.gw; it < DEPTH * I_LAYER; it += F.ngw) {
        const int l = it / I_LAYER; int r = it % I_LAYER;
        if (r < I_IN) { p0_transpose_item(F.in[IN_WIN] + (size_t)l * DM * PIN, DM, PIN, (bf16*)(ws + WS_WIN) + (size_t)l * PIN * DM, 0, scr, r, F.lane); continue; } r -= I_IN;
        if (r < I_SQ) { p0_transpose_item(F.in[IN_WO] + (size_t)l * DM * DM, DM, DM, (bf16*)(ws + WS_WO) + (size_t)l * DM * DM, 0, scr, r, F.lane); continue; } r -= I_SQ;
        if (r < I_SQ) { p0_transpose_item(F.in[IN_WXQ] + (size_t)l * DM * DM, DM, DM, (bf16*)(ws + WS_WXQ) + (size_t)l * DM * DM, 0, scr, r, F.lane, F.in[IN_GPX] + l * DM); continue; } r -= I_SQ;
        if (r < I_SQ) { p0_transpose_item(F.in[IN_WXK] + (size_t)l * DM * DM, DM, DM, (bf16*)(ws + WS_WXKV) + (size_t)l * 2 * DM * DM, 0, scr, r, F.lane); continue; } r -= I_SQ;
        if (r < I_SQ) { p0_transpose_item(F.in[IN_WXV] + (size_t)l * DM * DM, DM, DM, (bf16*)(ws + WS_WXKV) + (size_t)l * 2 * DM * DM, DM, scr, r, F.lane); continue; } r -= I_SQ;
        if (r < I_SQ) { p0_transpose_item(F.in[IN_WXO] + (size_t)l * DM * DM, DM, DM, (bf16*)(ws + WS_WXO) + (size_t)l * DM * DM, 0, scr, r, F.lane); continue; } r -= I_SQ;
        if (r < I_UP) { const int n0_ = 32 * (r % (UPW / 32));
            const int cA_ = n0_ < DFF ? n0_ : n0_ - DFF; const int dst_ = 256 * (cA_ / 128) + (cA_ % 128) + (n0_ < DFF ? 0 : 128);
            p0_transpose_item(F.in[IN_WUP] + (size_t)l * DM * UPW, DM, UPW, (bf16*)(ws + WS_WUP) + (size_t)l * UPW * DM, dst_ - n0_, scr, r, F.lane, F.in[IN_GPF] + l * DM); continue; } r -= I_UP;
        p0_transpose_item(F.in[IN_WDN] + (size_t)l * DFF * DM, DFF, DM, (bf16*)(ws + WS_WDN) + (size_t)l * DM * DFF, 0, scr, r, F.lane);
    }
    {
        f32x4 g[4]; row_load(F.in[IN_GPM], F.lane, g);
        for (int m = F.gw; m < MR; m += F.ngw) {
            const float* src = (m < MP) ? F.in[IN_XP] + (size_t)m * DM : F.in[IN_XS] + (size_t)(m - MP) * DM;
            f32x4 v[4]; row_load(src, F.lane, v);
            row_store_bf16((bf16*)(ws + WS_X) + (size_t)m * DM, F.lane, v);
            const float r = rsqrtf(row_ss(v) * (1.f / DM) + EPS);
#pragma unroll
            for (int j = 0; j < 4; ++j) v[j] = v[j] * r * g[j];
            row_store_bf16((bf16*)(ws + WS_XN) + (size_t)m * DM, F.lane, v);
        }
    }
    for (int m = F.gw; m < NB * NMEM; m += F.ngw) {
        f32x4 v[4]; row_load(F.in[IN_MEM] + (size_t)m * DM, F.lane, v);
        const float r = rsqrtf(row_ss(v) * (1.f / DM) + EPS);
        for (int l = 0; l < DEPTH; ++l) { f32x4 g[4], o[4]; row_load(F.in[IN_GMEM] + (size_t)l * DM, F.lane, g);
#pragma unroll
            for (int j = 0; j < 4; ++j) o[j] = v[j] * r * g[j];
            row_store_bf16((bf16*)(ws + WS_MEMN) + ((size_t)l * 2048 + m) * DM, F.lane, o); }
    }
    {
        float* cs = (float*)(ws + WS_TAB + TAB_COS); float* sn = (float*)(ws + WS_TAB + TAB_SIN); float* lbt = (float*)(ws + WS_TAB + TAB_LB);
        const int gt = blockIdx.x * NTHR + F.tid; constexpr int nt = GRID * NTHR;
        for (int i = gt; i < 2049 * 32; i += nt) { const int p = i >> 5, d = i & 31; const double pos = (p == 2048) ? (double)PAST : (double)p;
            const double inv = pow(10000.0, -(double)d / 32.0); const double a = pos * inv; cs[i] = (float)cos(a); sn[i] = (float)sin(a); }
        for (int c = gt; c < 512; c += nt) { float z[DEPTH], mx = -1e30f;
            for (int l = 0; l < DEPTH; ++l) { z[l] = F.in[IN_LBL][l * 512 + c]; mx = fmaxf(mx, z[l]); }
            float s = 0.f; for (int l = 0; l < DEPTH; ++l) { z[l] = expf(z[l] - mx); s += z[l]; }
            float cum = 0.f, c0 = 0.f; for (int l = 0; l < DEPTH; ++l) { cum += z[l] / s; if (l == 0) c0 = cum; lbt[l * 512 + c] = cum - c0; } }
    }
}

__device__ __forceinline__ void row_load_bf16(const bf16* p, int lane, f32x4 (&v)[4]) {
    const GAS v2u* r = (const GAS v2u*)p + lane;
#pragma unroll
    for (int j = 0; j < 4; ++j) { const v2u w = r[64 * j]; v[j] = (f32x4){bflo(w.x), bfhi(w.x), bflo(w.y), bfhi(w.y)}; }
}
__device__ __forceinline__ void norm_row(Frame& F, int m, f32x4 (&y)[4], f32x4 (&x)[4], const f32x4 (&gq)[4], const f32x4 (&gp)[4], bool final_, bool xn_) {
    unsigned char* ws = F.ws;
    const float r = rsqrtf(row_ss(y) * (1.f / DM) + EPS);
#pragma unroll
    for (int j = 0; j < 4; ++j) x[j] = x[j] + y[j] * r * gq[j];
    if (final_) { float* o = (m < MP) ? F.out + O_YP + (size_t)m * DM : F.out + O_YS + (size_t)(m - MP) * DM; row_store_f32(o, F.lane, x); }
    else {
        row_store_bf16((bf16*)(ws + WS_X) + (size_t)m * DM, F.lane, x);
        const float r2 = rsqrtf(row_ss(x) * (1.f / DM) + EPS);
        if (xn_) {
#pragma unroll
            for (int j = 0; j < 4; ++j) x[j] = x[j] * r2 * gp[j];
            row_store_bf16((bf16*)(ws + WS_XN) + (size_t)m * DM, F.lane, x);
        } else if (F.lane == 0) ((float*)(ws + WS_RS))[m] = r2;
    }
}
__device__ __forceinline__ void norm_phase(Frame& F, const float* gpost, const float* gpre, bool final_) {
    unsigned char* ws = F.ws;
    f32x4 gq[4], gp[4]; row_load(gpost, F.lane, gq); row_load(gpre ? gpre : gpost, F.lane, gp);
    const bool xn_ = gpre != nullptr;
    const bf16* Y = (const bf16*)(ws + WS_Y); const bf16* X = (const bf16*)(ws + WS_X);
    const int rbeg = F.vcu * 65, rend = (rbeg + 65 < MR) ? rbeg + 65 : MR;
    for (int m = rbeg + F.wave; m < rend; m += 16) {
        const int m2 = m + 8; const bool two = m2 < rend;
        f32x4 y0[4], x0[4], y1[4], x1[4];
        row_load_bf16(Y + (size_t)m * DM, F.lane, y0); row_load_bf16(X + (size_t)m * DM, F.lane, x0);
        if (two) { row_load_bf16(Y + (size_t)m2 * DM, F.lane, y1); row_load_bf16(X + (size_t)m2 * DM, F.lane, x1); }
        norm_row(F, m, y0, x0, gq, gp, final_, xn_);
        if (two) norm_row(F, m2, y1, x1, gq, gp, final_, xn_);
    }
}

__device__ __forceinline__ void unpack8(const v4u w, float (&f)[8]) {
    f[0] = bflo(w.x); f[1] = bfhi(w.x); f[2] = bflo(w.y); f[3] = bfhi(w.y); f[4] = bflo(w.z); f[5] = bfhi(w.z); f[6] = bflo(w.w); f[7] = bfhi(w.w);
}
__device__ __forceinline__ void load8f(const float* p, float (&f)[8]) { const f32x4 a = *(const f32x4*)p, b = *(const f32x4*)(p + 4); f[0] = a.x; f[1] = a.y; f[2] = a.z; f[3] = a.w; f[4] = b.x; f[5] = b.y; f[6] = b.z; f[7] = b.w; }

__device__ __forceinline__ void conv_phase(Frame& F, int l) {
    unsigned char* ws = F.ws;
    const bf16* UB = (const bf16*)(ws + WS_U); const bf16* US = UB + (size_t)256 * 4 * UPW; bf16* Gb = (bf16*)(ws + WS_G);
    const float* cw = F.in[IN_CW] + (size_t)l * 3 * UPW; const float* cb = F.in[IN_CB] + (size_t)l * UPW;
    const float* cfc = F.in[IN_CFC] + (size_t)l * DB * 2 * UPW;
    const int gt = blockIdx.x * NTHR + F.tid; constexpr int nthr = GRID * NTHR;
    constexpr int NCG = DFF / 8;
    constexpr int N_P = 256 * 2 * NCG, N_S = MS * NCG;
    for (int it = gt; it < N_P + N_S; it += nthr) {
        const bool samp = it >= N_P; const int it2 = samp ? it - N_P : it;
        const int cg = it2 % NCG, c0 = cg * 8;
        float wa[3][8], wb[3][8], ba[8], bb[8];
#pragma unroll
        for (int j = 0; j < 3; ++j) { load8f(cw + j * UPW + c0, wa[j]); load8f(cw + j * UPW + DFF + c0, wb[j]); }
        load8f(cb + c0, ba); load8f(cb + DFF + c0, bb);
        float a2[8], a1[8], b2[8], b1[8], a0[8], b0[8]; int grow;
        if (samp) {
            const int sr = it2 / NCG; grow = MP + sr; const float* c = cfc + (size_t)sr * 2 * UPW;
            load8f(c + c0, a2); load8f(c + DFF + c0, b2); load8f(c + UPW + c0, a1); load8f(c + UPW + DFF + c0, b1);
            unpack8(*(const v4u*)(US + (size_t)sr * UPW + c0), a0); unpack8(*(const v4u*)(US + (size_t)sr * UPW + DFF + c0), b0);
        } else {
            const int k = it2 / (2 * NCG), j = (it2 / NCG) & 1;
            if ((k & 31) == 0) continue;
            grow = 64 * k + j;
            const bf16* r2 = UB + ((size_t)((k - 1) * 4 + j)) * UPW;
            const bf16* r1 = j ? UB + ((size_t)(k * 4 + 2)) * UPW : UB + ((size_t)((k - 1) * 4 + 1)) * UPW;
            const bf16* r0 = UB + ((size_t)(k * 4 + 2 + j)) * UPW;
            unpack8(*(const v4u*)(r2 + c0), a2); unpack8(*(const v4u*)(r2 + DFF + c0), b2); unpack8(*(const v4u*)(r1 + c0), a1); unpack8(*(const v4u*)(r1 + DFF + c0), b1);
            unpack8(*(const v4u*)(r0 + c0), a0); unpack8(*(const v4u*)(r0 + DFF + c0), b0);
        }
        float o[8];
#pragma unroll
        for (int e = 0; e < 8; ++e) { const float a = ba[e] + wa[0][e] * a2[e] + wa[1][e] * a1[e] + wa[2][e] * a0[e]; const float b = bb[e] + wb[0][e] * b2[e] + wb[1][e] * b1[e] + wb[2][e] * b0[e]; o[e] = siluf_(a) * b; }
        *(v4u*)(Gb + (size_t)grow * DFF + c0) = (v4u){cvtpk(o[0], o[1]), cvtpk(o[2], o[3]), cvtpk(o[4], o[5]), cvtpk(o[6], o[7])};
    }
    float* ocp = F.out + O_CP + (size_t)l * NB * 2 * UPW; float* ocs = F.out + O_CS + (size_t)l * DB * 2 * UPW;
    for (int i = gt; i < NB * 2 * UPW; i += nthr) { const int b = i / (2 * UPW), j = (i / UPW) % 2, c = i % UPW; ocp[i] = bf2f(UB[((size_t)((b * 32 + 31) * 4 + j)) * UPW + c]); }
    for (int i = gt; i < DB * 2 * UPW; i += nthr) { const int s = i / (2 * UPW), j = (i / UPW) % 2, c = i % UPW;
        ocs[i] = (j == 0) ? cfc[(size_t)s * 2 * UPW + UPW + c] : bf2f(US[(size_t)s * UPW + c]); }
}

__device__ __forceinline__ void xattn_unit_sample(Frame& F, int l, int s, int h) {
    unsigned char* ws = F.ws; const bf16* QX = (const bf16*)(ws + WS_QX); bf16* OX = (bf16*)(ws + WS_OX);
    const int lane = F.lane, wave = F.wave, m = MP + s;
    LAS float* scl = (LAS float*)(F.lds + RING_OFF); LAS float* part = scl + 256;
    const v2u qw = *(const v2u*)(QX + (size_t)m * DM + h * 256 + 4 * lane);
    const f32x4 q = {bflo(qw.x), bfhi(qw.x), bflo(qw.y), bfhi(qw.y)};
    const GAS f32x4* CK = (const GAS f32x4*)(F.in[IN_CMK] + ((size_t)(l * DB + s) * 256 + 32 * wave) * DM + h * 256) + lane;
    const GAS f32x4* CV = (const GAS f32x4*)(F.in[IN_CMV] + ((size_t)(l * DB + s) * 256 + 32 * wave) * DM + h * 256) + lane;
    LDS_BAR();
    {
        f32x4 k[32];
#pragma unroll
        for (int i = 0; i < 32; ++i) k[i] = CK[(size_t)i * (DM / 4)];
#pragma unroll
        for (int i = 0; i < 32; ++i) { const float d = wave_sum((k[i].x * q.x + k[i].y * q.y) + (k[i].z * q.z + k[i].w * q.w)); if (lane == 0) scl[32 * wave + i] = d; }
    }
    f32x4 v[32];
#pragma unroll
    for (int i = 0; i < 32; ++i) v[i] = CV[(size_t)i * (DM / 4)];
    LDS_BAR();
    float mx, inv;
    { const float s0 = scl[lane], s1 = scl[64 + lane], s2 = scl[128 + lane], s3 = scl[192 + lane];
      mx = wave_max(fmaxf(fmaxf(s0, s1), fmaxf(s2, s3)));
      inv = 1.f / wave_sum((exp2f(s0 - mx) + exp2f(s1 - mx)) + (exp2f(s2 - mx) + exp2f(s3 - mx))); }
    f32x4 o = {0.f, 0.f, 0.f, 0.f};
#pragma unroll
    for (int i = 0; i < 32; ++i) { const float p = exp2f(scl[32 * wave + i] - mx); o = o + v[i] * p; }
    *(LAS f32x4*)(part + wave * 256 + 4 * lane) = o;
    LDS_BAR();
    if (F.tid < 256) { float t = 0.f;
#pragma unroll
        for (int w = 0; w < 8; ++w) t += part[w * 256 + F.tid];
        OX[(size_t)m * DM + h * 256 + F.tid] = (bf16)(cvtpk(t * inv, 0.f) & 0xffffu); }
}

__device__ __forceinline__ void hgrn_unit_sample(Frame& F, int l, int s) {
    unsigned char* ws = F.ws; const bf16* P = (const bf16*)(ws + WS_PROJ); bf16* MIX = (bf16*)(ws + WS_MIX); const float* LFp = (const float*)(ws + WS_LF);
    const int lane = F.lane, wave = F.wave, m = MP + s, hd = wave >> 1, kh = wave & 1, vq = lane & 31, kp = lane >> 5;
    LAS float* wl = (LAS float*)(F.lds + RING_OFF + 102400 + wave * 2048);
    LAS f32x4* red = (LAS f32x4*)(F.lds + RING_OFF + 98304);
    LDS_BAR();
    { const int k = 64 * kh + lane; wl[lane] = exp2f(LFp[(size_t)m * 512 + hd * 128 + k]); wl[64 + lane] = bf2f(P[(size_t)m * PIN + C_FR + hd * 128 + k]); wl[128 + lane] = bf2f(P[(size_t)m * PIN + C_QR + hd * 128 + k]); }
    LDS_WAIT(); asm volatile("" ::: "memory");
    const v2u vw = *(const v2u*)(P + (size_t)m * PIN + C_IR + hd * 128 + 4 * vq);
    const f32x4 vv = {bflo(vw.x), bfhi(vw.x), bflo(vw.y), bfhi(vw.y)};
    const size_t sb = (((size_t)(l * DB + s) * 4 + hd) * 128 + 64 * kh) * 128 + 4 * vq;
    const GAS float* S0 = (const GAS float*)F.in[IN_SH] + sb; GAS float* S1 = (GAS float*)F.out + O_HS + sb;
    f32x4 o = {0.f, 0.f, 0.f, 0.f};
#pragma unroll 1
    for (int g = 0; g < 4; ++g) {
        f32x4 s0[8];
#pragma unroll
        for (int i = 0; i < 8; ++i) s0[i] = *(const GAS f32x4*)(S0 + (size_t)(16 * g + 2 * i + kp) * 128);
#pragma unroll
        for (int i = 0; i < 8; ++i) { const int kr = 16 * g + 2 * i + kp; const float f = wl[kr], kk = wl[64 + kr], q = wl[128 + kr];
            const f32x4 s1 = s0[i] * f + vv * kk; *(GAS f32x4*)(S1 + (size_t)kr * 128) = s1; o = o + s1 * q; }
    }
    o.x += __shfl_xor(o.x, 32); o.y += __shfl_xor(o.y, 32); o.z += __shfl_xor(o.z, 32); o.w += __shfl_xor(o.w, 32);
    if (lane < 32) red[wave * 32 + vq] = o;
    LDS_BAR();
    o = red[(2 * hd) * 32 + vq] + red[(2 * hd + 1) * 32 + vq];
    float ss = (o.x * o.x + o.y * o.y) + (o.z * o.z + o.w * o.w);
    ss += __shfl_xor(ss, 1); ss += __shfl_xor(ss, 2); ss += __shfl_xor(ss, 4); ss += __shfl_xor(ss, 8); ss += __shfl_xor(ss, 16);
    const float r = rsqrtf(ss * (1.f / 128.f) + EPS);
    if (kh == 0 && lane < 32) { const f32x4 g4 = *(const f32x4*)(F.in[IN_HN] + l * 512 + hd * 128 + 4 * vq); const v2u gw = *(const v2u*)(P + (size_t)m * PIN + C_GR + hd * 128 + 4 * vq);
        v2u w; w.x = cvtpk(o.x * r * g4.x * bflo(gw.x), o.y * r * g4.y * bfhi(gw.x)); w.y = cvtpk(o.z * r * g4.z * bflo(gw.y), o.w * r * g4.w * bfhi(gw.y));
        *(v2u*)(MIX + (size_t)m * DM + 512 + hd * 128 + 4 * vq) = w; }
}
__device__ __forceinline__ void swa_unit_sample(Frame& F, int l, int s) {
    unsigned char* ws = F.ws; const bf16* P = (const bf16*)(ws + WS_PROJ); bf16* MIX = (bf16*)(ws + WS_MIX);
    const float* cs = (const float*)(ws + WS_TAB + TAB_COS) + 2048 * 32; const float* sn = (const float*)(ws + WS_TAB + TAB_SIN) + 2048 * 32;
    constexpr int RS = 136;
    LAS unsigned char* KL = F.lds + RING_OFF; LAS unsigned char* VL = KL + 128 * RS * 2;
    const int lane = F.lane, h = F.wave, m = MP + s, kvh = h >> 2;
    LAS float* wl = (LAS float*)(F.lds + RING_OFF + 102400 + h * 2048);
    const GAS float* ck = (const GAS float*)F.in[IN_CWK] + (size_t)(l * DB + s) * 128 * 128; const GAS float* cv = (const GAS float*)F.in[IN_CWV] + (size_t)(l * DB + s) * 128 * 128;
    LDS_BAR();
    { f32x4 kx[8], vx[8];
#pragma unroll
      for (int i = 0; i < 8; ++i) { const int ch = F.tid + 512 * i; kx[i] = *(const GAS f32x4*)(ck + (size_t)(ch >> 5) * 128 + 4 * (ch & 31)); vx[i] = *(const GAS f32x4*)(cv + (size_t)(ch >> 5) * 128 + 4 * (ch & 31)); }
#pragma unroll
      for (int i = 0; i < 8; ++i) { const int ch = F.tid + 512 * i; const int off = ((ch >> 5) * RS + 4 * (ch & 31)) * 2;
          *(LAS v2u*)(KL + off) = (v2u){cvtpk(kx[i].x, kx[i].y), cvtpk(kx[i].z, kx[i].w)}; *(LAS v2u*)(VL + off) = (v2u){cvtpk(vx[i].x, vx[i].y), cvtpk(vx[i].z, vx[i].w)}; } }
    float knew = 0.f;
    { const int d = lane & 31; const float c = cs[d], sv = sn[d];
      const float q1 = bf2f(P[(size_t)m * PIN + h * 64 + d]), q2 = bf2f(P[(size_t)m * PIN + h * 64 + 32 + d]);
      const float k1 = bf2f(P[(size_t)m * PIN + C_K + kvh * 64 + d]), k2 = bf2f(P[(size_t)m * PIN + C_K + kvh * 64 + 32 + d]);
      if (lane < 32) { wl[lane] = (q1 * c - q2 * sv) * 0.125f; knew = k1 * c - k2 * sv; } else { wl[lane] = (q2 * c + q1 * sv) * 0.125f; knew = k2 * c + k1 * sv; } }
    const float vnew = bf2f(P[(size_t)m * PIN + C_V + kvh * 64 + lane]);
    if ((h & 3) == 0) { F.out[O_WKS + ((size_t)(l * DB + s) * 2 + kvh) * 64 + lane] = knew; F.out[O_WVS + ((size_t)(l * DB + s) * 2 + kvh) * 64 + lane] = vnew; }
    LDS_BAR();
    const float snew = wave_sum(wl[lane] * knew);
    float sc[2];
#pragma unroll
    for (int i = 0; i < 2; ++i) { const LAS unsigned char* kr = KL + ((lane + 64 * i) * RS + kvh * 64) * 2; float acc = 0.f;
#pragma unroll
        for (int c8 = 0; c8 < 8; ++c8) { float kf[8]; unpack8(*(const LAS v4u*)(kr + 16 * c8), kf);
#pragma unroll
            for (int e = 0; e < 8; ++e) acc += wl[c8 * 8 + e] * kf[e]; }
        sc[i] = acc; }
    const float sink = F.in[IN_SINK][l * 8 + h];
    const float mx = fmaxf(fmaxf(wave_max(fmaxf(sc[0], sc[1])), snew), sink);
    const float p0 = __expf(sc[0] - mx), p1 = __expf(sc[1] - mx), pn = __expf(snew - mx);
    const float den = wave_sum(p0 + p1) + pn + __expf(sink - mx);
    wl[64 + lane] = p0; wl[128 + lane] = p1;
    LDS_WAIT(); asm volatile("" ::: "memory");
    float o = pn * vnew;
    const LAS bf16* vp = (const LAS bf16*)VL + kvh * 64 + lane;
#pragma unroll 8
    for (int j = 0; j < 128; ++j) o += wl[64 + j] * bf2f(vp[j * RS]);
    MIX[(size_t)m * DM + h * 64 + lane] = (bf16)(cvtpk(o / den, 0.f) & 0xffffu);
}

__device__ __forceinline__ void hgrn_pass1(Frame& F, int l, int b, int h, int seg) {
    unsigned char* ws = F.ws; bf16* QB = (bf16*)(ws + WS_HQB); bf16* OP = (bf16*)(ws + WS_HOP);
    constexpr int RSK = 136, RST = 72;
    constexpr int O_QT = 0, O_KT = O_QT + 64 * RSK * 2, O_KTT = O_KT + 64 * RSK * 2, O_VT = O_KTT + 128 * RST * 2, O_SP = O_VT + 128 * RST * 2,
                  O_SEG = O_SP + 128 * RSK * 2, O_EB = O_SEG + 2048, O_EBR = O_EB + 512, O_SSQ = O_EBR + 512, O_ENDL = O_SSQ + 1024;
    static_assert(O_ENDL <= RING_BYTES, "hgrn LDS map");
    LAS unsigned char* L = F.lds + RING_OFF;
    LAS bf16* QT = (LAS bf16*)(L + O_QT); LAS bf16* KT = (LAS bf16*)(L + O_KT);
    LAS float* SEG = (LAS float*)(L + O_SEG); LAS float* EB = (LAS float*)(L + O_EB); LAS float* EBR = (LAS float*)(L + O_EBR);
    const int tid = F.tid, lane = F.lane, wave = F.wave;
    const int vt = wave >> 1, tt = wave & 1;
    int k = tid & 127, sg = tid >> 7, l32 = lane & 31, hh = lane >> 5;
    f32x16 S0, S1;
#pragma unroll
    for (int r = 0; r < 16; ++r) { S0[r] = 0.f; S1[r] = 0.f; }
    float Bseg = 0.f;
    const size_t hb = ((size_t)(b * 4 + h) * 32 * 4 + sg) * 128 * 16 + (size_t)k * 16;
    const bf16* HQp = (const bf16*)(ws + WS_HQ) + hb; const bf16* HKp = (const bf16*)(ws + WS_HK) + hb; const bf16* HVp = (const bf16*)(ws + WS_HV) + hb; const float* HLp = (const float*)(ws + WS_HLF) + hb;
    v4u n_q0, n_q1, n_k0, n_k1, n_v0, n_v1;
#define HG_LOAD_L(cn) do { } while (0)
#define HG_LOAD_QKV(cn) do { const int o_ = 8192 * (cn); n_q0 = *(const v4u*)(HQp + o_); n_q1 = *(const v4u*)(HQp + o_ + 8); n_k0 = *(const v4u*)(HKp + o_); n_k1 = *(const v4u*)(HKp + o_ + 8); \
        n_v0 = *(const v4u*)(HVp + o_); n_v1 = *(const v4u*)(HVp + o_ + 8); } while (0)
    HG_LOAD_L(4 * seg); HG_LOAD_QKV(4 * seg);
    LDS_BAR();
    for (int c = 4 * seg; c < 4 * seg + 4; ++c) {
        const int mb = b * SEQ + c * 64;
        asm volatile("" : "+v"(k), "+v"(sg), "+v"(l32), "+v"(hh));
        float cl[16], q[16], kk[16];
        { float run = 0.f;
#pragma unroll
          for (int j = 0; j < 8; ++j) { const unsigned w_ = j < 4 ? n_k0[j] : n_k1[j - 4];
              const float l0_ = (float)__builtin_bit_cast(_Float16, (unsigned short)(w_ & 0xffffu)), l1_ = (float)__builtin_bit_cast(_Float16, (unsigned short)(w_ >> 16));
              run += l0_; cl[2 * j] = run; kk[2 * j] = 1.f - __builtin_amdgcn_exp2f(l0_); run += l1_; cl[2 * j + 1] = run; kk[2 * j + 1] = 1.f - __builtin_amdgcn_exp2f(l1_); }
          SEG[sg * 128 + k] = run; }
#define HG_UNP(dst, o, V_) do { const v4u u_ = (V_); dst[o] = bflo(u_.x); dst[o + 1] = bfhi(u_.x); dst[o + 2] = bflo(u_.y); dst[o + 3] = bfhi(u_.y); dst[o + 4] = bflo(u_.z); dst[o + 5] = bfhi(u_.z); dst[o + 6] = bflo(u_.w); dst[o + 7] = bfhi(u_.w); } while (0)
        HG_UNP(q, 0, n_q0); HG_UNP(q, 8, n_q1);
#undef HG_UNP
        const v4u vv0 = n_v0, vv1 = n_v1;
        if (c + 1 < 4 * seg + 4) { HG_LOAD_L(c + 1); HG_LOAD_QKV(c + 1); }
        LDS_BAR();
#pragma unroll
        for (int kti = 0; kti < 2; ++kti) { const int kt = 2 * tt + kti;
#pragma unroll
            for (int g = 0; g < 4; ++g) { const int k0 = 32 * kt + 8 * g + 4 * hh;
                const f32x4 r0 = *(const LAS f32x4*)(SEG + k0), r1 = *(const LAS f32x4*)(SEG + 128 + k0);
                const float s0 = kti ? S1[4 * g] : S0[4 * g], s1 = kti ? S1[4 * g + 1] : S0[4 * g + 1], s2 = kti ? S1[4 * g + 2] : S0[4 * g + 2], s3 = kti ? S1[4 * g + 3] : S0[4 * g + 3];
                v2u w; w.x = cvtpk(s0 * __builtin_amdgcn_exp2f(r0.x + r1.x), s1 * __builtin_amdgcn_exp2f(r0.y + r1.y));
                w.y = cvtpk(s2 * __builtin_amdgcn_exp2f(r0.z + r1.z), s3 * __builtin_amdgcn_exp2f(r0.w + r1.w));
                *(LAS v2u*)(L + O_SP + ((32 * vt + l32) * RSK + k0) * 2) = w; } }
        {
            const float t0 = SEG[k], t1 = SEG[128 + k], t2 = SEG[256 + k], t3 = SEG[384 + k];
            const float pre = (sg > 0 ? t0 : 0.f) + (sg > 1 ? t1 : 0.f) + (sg > 2 ? t2 : 0.f);
            const float ref = t0 + t1, blast = ref + t2 + t3;
            unsigned kp[8];
#pragma unroll
            for (int i = 0; i < 16; i += 2) {
                const float b0 = pre + cl[i], b1 = pre + cl[i + 1];
                const float qt0 = q[i] * __builtin_amdgcn_exp2f(b0 - ref), qt1 = q[i + 1] * __builtin_amdgcn_exp2f(b1 - ref);
                const float kt0 = kk[i] * __builtin_amdgcn_exp2f(ref - b0), kt1 = kk[i + 1] * __builtin_amdgcn_exp2f(ref - b1);
                const unsigned wq = cvtpk(qt0, qt1), wk = cvtpk(kt0, kt1), wb = cvtpk(q[i] * __builtin_amdgcn_exp2f(Bseg + b0), q[i + 1] * __builtin_amdgcn_exp2f(Bseg + b1));
                const int t = 16 * sg + i;
                QB[(size_t)(mb + t) * 512 + h * 128 + k] = (bf16)(wb & 0xffffu); QB[(size_t)(mb + t + 1) * 512 + h * 128 + k] = (bf16)(wb >> 16);
                QT[t * RSK + k] = (bf16)(wq & 0xffffu); QT[(t + 1) * RSK + k] = (bf16)(wq >> 16);
                KT[t * RSK + k] = (bf16)(wk & 0xffffu); KT[(t + 1) * RSK + k] = (bf16)(wk >> 16);
                kp[i >> 1] = wk;
            }
            *(LAS v4u*)(L + O_KTT + (k * RST + 16 * sg) * 2) = (v4u){kp[0], kp[1], kp[2], kp[3]};
            *(LAS v4u*)(L + O_KTT + (k * RST + 16 * sg + 8) * 2) = (v4u){kp[4], kp[5], kp[6], kp[7]};
            *(LAS v4u*)(L + O_VT + (k * RST + 16 * sg) * 2) = vv0;
            *(LAS v4u*)(L + O_VT + (k * RST + 16 * sg + 8) * 2) = vv1;
            if (sg == 0) { EB[k] = __builtin_amdgcn_exp2f(blast); EBR[k] = __builtin_amdgcn_exp2f(blast - ref); }
            Bseg += blast;
        }
        LDS_BAR();
        __builtin_amdgcn_sched_barrier(0);
        f32x16 oT;
#pragma unroll
        for (int r = 0; r < 16; ++r) oT[r] = 0.f;
#pragma unroll
        for (int st = 0; st < 2; ++st) {
            if (st <= tt) {
                f32x16 a;
#pragma unroll
                for (int r = 0; r < 16; ++r) a[r] = 0.f;
#pragma unroll
                for (int ks = 0; ks < 8; ++ks) {
                    const bf16x8 A = *(const LAS bf16x8*)(L + O_KT + ((32 * st + l32) * RSK + 16 * ks + 8 * hh) * 2);
                    const bf16x8 B = *(const LAS bf16x8*)(L + O_QT + ((32 * tt + l32) * RSK + 16 * ks + 8 * hh) * 2);
                    a = MFMA32(A, B, a);
                    if (ks & 1) __builtin_amdgcn_sched_barrier(0);
                }
                if (st == tt) {
#pragma unroll
                    for (int r = 0; r < 16; ++r) { const int sl = 8 * (r >> 2) + 4 * hh + (r & 3); if (sl > l32) a[r] = 0.f; }
                }
#pragma unroll
                for (int j = 0; j < 2; ++j) {
                    v4u bp; bp.x = cvtpk(a[8 * j], a[8 * j + 1]); bp.y = cvtpk(a[8 * j + 2], a[8 * j + 3]); bp.z = cvtpk(a[8 * j + 4], a[8 * j + 5]); bp.w = cvtpk(a[8 * j + 6], a[8 * j + 7]);
                    const v2u lo = *(const LAS v2u*)(L + O_VT + ((32 * vt + l32) * RST + 32 * st + 16 * j + 4 * hh) * 2);
                    const v2u hi = *(const LAS v2u*)(L + O_VT + ((32 * vt + l32) * RST + 32 * st + 16 * j + 8 + 4 * hh) * 2);
                    const v4u av = (v4u){lo.x, lo.y, hi.x, hi.y};
                    oT = MFMA32(__builtin_bit_cast(bf16x8, av), __builtin_bit_cast(bf16x8, bp), oT);
                    __builtin_amdgcn_sched_barrier(0);
                }
            }
            __builtin_amdgcn_sched_barrier(0);
        }
#pragma unroll
        for (int ks = 0; ks < 8; ++ks) {
            const bf16x8 A = *(const LAS bf16x8*)(L + O_SP + ((32 * vt + l32) * RSK + 16 * ks + 8 * hh) * 2);
            const bf16x8 B = *(const LAS bf16x8*)(L + O_QT + ((32 * tt + l32) * RSK + 16 * ks + 8 * hh) * 2);
            oT = MFMA32(A, B, oT);
            if (ks & 1) __builtin_amdgcn_sched_barrier(0);
        }
        __builtin_amdgcn_sched_barrier(0);
#pragma unroll
        for (int kti = 0; kti < 2; ++kti) {
            const int kt = 2 * tt + kti;
            f32x16 T;
#pragma unroll
            for (int r = 0; r < 16; ++r) T[r] = 0.f;
#pragma unroll
            for (int ts = 0; ts < 4; ++ts) {
                const bf16x8 A = *(const LAS bf16x8*)(L + O_KTT + ((32 * kt + l32) * RST + 16 * ts + 8 * hh) * 2);
                const bf16x8 B = *(const LAS bf16x8*)(L + O_VT + ((32 * vt + l32) * RST + 16 * ts + 8 * hh) * 2);
                T = MFMA32(A, B, T);
                if (ts & 1) __builtin_amdgcn_sched_barrier(0);
            }
#pragma unroll
            for (int g = 0; g < 4; ++g) {
                const f32x4 eb = *(const LAS f32x4*)(EB + 32 * kt + 8 * g + 4 * hh), ebr = *(const LAS f32x4*)(EBR + 32 * kt + 8 * g + 4 * hh);
#pragma unroll
                for (int e = 0; e < 4; ++e) { if (kti) S1[4 * g + e] = eb[e] * S1[4 * g + e] + ebr[e] * T[4 * g + e]; else S0[4 * g + e] = eb[e] * S0[4 * g + e] + ebr[e] * T[4 * g + e]; }
            }
            __builtin_amdgcn_sched_barrier(0);
        }
        {
            bf16* op = OP + ((size_t)(((b * 4 + h) * 8 + seg) * 4 + (c & 3)) * 8 + wave) * 1024 + (size_t)lane * 4;
#pragma unroll
            for (int g = 0; g < 4; ++g) *(v2u*)(op + 256 * g) = (v2u){cvtpk(oT[4 * g], oT[4 * g + 1]), cvtpk(oT[4 * g + 2], oT[4 * g + 3])};
        }
    }
#undef HG_LOAD_L
#undef HG_LOAD_QKV
    asm volatile("" : "+v"(l32), "+v"(hh));
    const int un = (b * 4 + h) * 8 + seg;
    float* So = (float*)(ws + WS_HSL) + (size_t)un * 128 * 128;
    if (sg == 0) ((float*)(ws + WS_HDE))[un * 128 + k] = __builtin_amdgcn_exp2f(Bseg);
#pragma unroll
    for (int kti = 0; kti < 2; ++kti)
#pragma unroll
        for (int g = 0; g < 4; ++g) *(f32x4*)(So + (size_t)(((wave * 2 + kti) * 4 + g) * 64 + lane) * 4) = kti ? (f32x4){S1[4 * g], S1[4 * g + 1], S1[4 * g + 2], S1[4 * g + 3]} : (f32x4){S0[4 * g], S0[4 * g + 1], S0[4 * g + 2], S0[4 * g + 3]};
    LDS_BAR();
}

__device__ __forceinline__ void hgrn_pass2(Frame& F, int l, int b, int h, int seg) {
    unsigned char* ws = F.ws; const bf16* P = (const bf16*)(ws + WS_PROJ); bf16* MIX = (bf16*)(ws + WS_MIX); const bf16* QB = (const bf16*)(ws + WS_HQB); const bf16* OP = (const bf16*)(ws + WS_HOP);
    constexpr int RSK = 136;
    constexpr int O_SP = 0, O_QB = 128 * RSK * 2, O_SSQ = O_QB + 256 * RSK * 2, O_ENDL = O_SSQ + 4096;
    static_assert(O_ENDL <= RING_BYTES, "hgrn pass 2 LDS map");
    LAS unsigned char* L = F.lds + RING_OFF; LAS float* SSQ = (LAS float*)(L + O_SSQ);
    const int tid = F.tid, lane = F.lane, wave = F.wave, vt = wave >> 1, tt = wave & 1;
    int l32 = lane & 31, hh = lane >> 5;
    const int u0 = (b * 4 + h) * 8, m0 = b * SEQ + seg * 256;
    const float* SL = (const float*)(ws + WS_HSL); const float* DE = (const float*)(ws + WS_HDE);
    f32x16 S0, S1;
    {
        f32x4 w[8], acc[8];
#pragma unroll
        for (int q = 0; q < 8; ++q) { w[q] = (f32x4){1.f, 1.f, 1.f, 1.f}; acc[q] = (f32x4){0.f, 0.f, 0.f, 0.f}; }
#pragma unroll 1
        for (int j = seg - 1; j >= 0; --j) {
            const float* sl = SL + (size_t)(u0 + j) * 128 * 128 + (size_t)(wave * 8 * 64 + lane) * 4;
            f32x4 x[8];
#pragma unroll
            for (int q = 0; q < 8; ++q) x[q] = *(const f32x4*)(sl + (size_t)q * 256);
#pragma unroll
            for (int q = 0; q < 8; ++q) acc[q] = acc[q] + w[q] * x[q];
            if (j > 0) { const float* de = DE + (u0 + j) * 128;
#pragma unroll
                for (int q = 0; q < 8; ++q) w[q] = w[q] * *(const f32x4*)(de + 32 * (2 * tt + (q >> 2)) + 8 * (q & 3) + 4 * hh); }
        }
#pragma unroll
        for (int g = 0; g < 4; ++g) { S0[4 * g] = acc[g].x; S0[4 * g + 1] = acc[g].y; S0[4 * g + 2] = acc[g].z; S0[4 * g + 3] = acc[g].w;
            S1[4 * g] = acc[4 + g].x; S1[4 * g + 1] = acc[4 + g].y; S1[4 * g + 2] = acc[4 + g].z; S1[4 * g + 3] = acc[4 + g].w; }
    }
    v4u qv[8];
    if (seg > 0) {
#pragma unroll
        for (int i = 0; i < 8; ++i) { const int ch = tid + 512 * i; qv[i] = *(const v4u*)(QB + (size_t)(m0 + (ch >> 4)) * 512 + h * 128 + 8 * (ch & 15)); } }
    LDS_BAR();
#pragma unroll
    for (int kti = 0; kti < 2; ++kti) { const int kt = 2 * tt + kti;
#pragma unroll
        for (int g = 0; g < 4; ++g) { const int k0 = 32 * kt + 8 * g + 4 * hh;
            v2u w; w.x = kti ? cvtpk(S1[4 * g], S1[4 * g + 1]) : cvtpk(S0[4 * g], S0[4 * g + 1]); w.y = kti ? cvtpk(S1[4 * g + 2], S1[4 * g + 3]) : cvtpk(S0[4 * g + 2], S0[4 * g + 3]);
            *(LAS v2u*)(L + O_SP + ((32 * vt + l32) * RSK + k0) * 2) = w; } }
    if (seg > 0) {
#pragma unroll
        for (int i = 0; i < 8; ++i) { const int ch = tid + 512 * i; *(LAS v4u*)(L + O_QB + ((ch >> 4) * RSK + 8 * (ch & 15)) * 2) = qv[i]; } }
    if (seg == 7) {
        const float* sl = SL + (size_t)(u0 + 7) * 128 * 128 + (size_t)(wave * 8 * 64 + lane) * 4; const float* de = DE + (u0 + 7) * 128;
        float* So = F.out + O_HP + ((size_t)(l * NB + b) * 4 + h) * 128 * 128 + 32 * vt + l32;
#pragma unroll
        for (int kti = 0; kti < 2; ++kti) { const int kt = 2 * tt + kti;
#pragma unroll
            for (int g = 0; g < 4; ++g) { const int k0 = 32 * kt + 8 * g + 4 * hh; const f32x4 d4 = *(const f32x4*)(de + k0); const f32x4 x4 = *(const f32x4*)(sl + (size_t)(kti * 4 + g) * 256);
#pragma unroll
                for (int e = 0; e < 4; ++e) So[(size_t)(k0 + e) * 128] = d4[e] * (kti ? S1[4 * g + e] : S0[4 * g + e]) + x4[e]; } }
    }
    LDS_BAR();
    asm volatile("" : "+v"(l32), "+v"(hh));
    f32x16 oT[4];
#pragma unroll
    for (int i = 0; i < 4; ++i) {
        { const bf16* op = OP + ((size_t)((u0 + seg) * 4 + i) * 8 + wave) * 1024 + (size_t)lane * 4;
#pragma unroll
          for (int g = 0; g < 4; ++g) { const v2u x = *(const v2u*)(op + 256 * g); oT[i][4 * g] = bflo(x.x); oT[i][4 * g + 1] = bfhi(x.x); oT[i][4 * g + 2] = bflo(x.y); oT[i][4 * g + 3] = bfhi(x.y); } }
        if (seg > 0) {
            LAS unsigned char* spb = L + O_SP + ((32 * vt + l32) * RSK + 8 * hh) * 2; asm volatile("" : "+v"(spb));
            LAS unsigned char* qbb = L + O_QB + ((64 * i + 32 * tt + l32) * RSK + 8 * hh) * 2; asm volatile("" : "+v"(qbb));
#pragma unroll
            for (int ks = 0; ks < 8; ++ks) { const bf16x8 A = *(const LAS bf16x8*)(spb + 32 * ks); const bf16x8 B = *(const LAS bf16x8*)(qbb + 32 * ks); oT[i] = MFMA32(A, B, oT[i]);
                if (ks & 1) __builtin_amdgcn_sched_barrier(0); }
        }
        float ss = 0.f;
#pragma unroll
        for (int r = 0; r < 16; ++r) ss += oT[i][r] * oT[i][r];
        ss += __shfl_xor(ss, 32);
        if (hh == 0) SSQ[vt * 256 + 64 * i + 32 * tt + l32] = ss;
    }
    LDS_BAR();
    const float* gn = F.in[IN_HN] + l * 512 + h * 128;
#pragma unroll
    for (int i = 0; i < 4; ++i) {
        const int tl = 64 * i + 32 * tt + l32;
        const float tot = (SSQ[tl] + SSQ[256 + tl]) + (SSQ[512 + tl] + SSQ[768 + tl]);
        const float rinv = rsqrtf(tot * (1.f / 128.f) + EPS);
#pragma unroll
        for (int g = 0; g < 4; ++g) { const int v0 = 32 * vt + 8 * g + 4 * hh; const f32x4 g4 = *(const f32x4*)(gn + v0);
            v2u w; w.x = cvtpk(oT[i][4 * g] * rinv * g4.x, oT[i][4 * g + 1] * rinv * g4.y); w.y = cvtpk(oT[i][4 * g + 2] * rinv * g4.z, oT[i][4 * g + 3] * rinv * g4.w);
            *(LAS v2u*)(L + O_QB + (tl * RSK + v0) * 2) = w; }
    }
    LDS_BAR();
#pragma unroll
    for (int i = 0; i < 8; ++i) { const int ch = tid + 512 * i, row = ch >> 4, c8 = 8 * (ch & 15);
        float o[8], g[8]; unpack8(*(const LAS v4u*)(L + O_QB + (row * RSK + c8) * 2), o); unpack8(*(const v4u*)(P + (size_t)(m0 + row) * PIN + C_GR + h * 128 + c8), g);
        *(v4u*)(MIX + (size_t)(m0 + row) * DM + 512 + h * 128 + c8) = (v4u){cvtpk(o[0] * g[0], o[1] * g[1]), cvtpk(o[2] * g[2], o[3] * g[3]), cvtpk(o[4] * g[4], o[5] * g[5]), cvtpk(o[6] * g[6], o[7] * g[7])}; }
}

__device__ __forceinline__ void swa_unit_prompt(Frame& F, int l, int b, int kvh, int jb) {
    unsigned char* ws = F.ws; const bf16* P = (const bf16*)(ws + WS_PROJ); bf16* MIX = (bf16*)(ws + WS_MIX);
    const float* cs = (const float*)(ws + WS_TAB + TAB_COS); const float* sn = (const float*)(ws + WS_TAB + TAB_SIN);
    constexpr int RK = 72, RV = 264;
    constexpr int O_KR = 0, O_VT = 256 * RK * 2, O_E = O_VT + 64 * RV * 2;
    static_assert(O_E <= 100 * 1024, "swa LDS map");
    LAS unsigned char* L = F.lds + RING_OFF;
    const int tid = F.tid, lane = F.lane, wave = F.wave;
    const int l32 = lane & 31, hh = lane >> 5;
    const int p0 = jb * 128 - 128;
    LDS_BAR();
#pragma unroll
    for (int i = 0; i < 2; ++i) { const int item = tid + 512 * i, ci = item >> 2, c8 = item & 3, kp = p0 + ci;
        v4u w1 = {0u, 0u, 0u, 0u}, w2 = w1;
        if (kp >= 0) { const bf16* kr = P + (size_t)(b * SEQ + kp) * PIN + C_K + kvh * 64 + c8 * 8;
            float k1[8], k2[8], cc[8], ss[8]; unpack8(*(const v4u*)kr, k1); unpack8(*(const v4u*)(kr + 32), k2); load8f(cs + kp * 32 + c8 * 8, cc); load8f(sn + kp * 32 + c8 * 8, ss);
            float r1[8], r2[8];
#pragma unroll
            for (int e = 0; e < 8; ++e) { r1[e] = k1[e] * cc[e] - k2[e] * ss[e]; r2[e] = k2[e] * cc[e] + k1[e] * ss[e]; }
            w1 = (v4u){cvtpk(r1[0], r1[1]), cvtpk(r1[2], r1[3]), cvtpk(r1[4], r1[5]), cvtpk(r1[6], r1[7])};
            w2 = (v4u){cvtpk(r2[0], r2[1]), cvtpk(r2[2], r2[3]), cvtpk(r2[4], r2[5]), cvtpk(r2[6], r2[7])};
            if (jb == SEQ / 128 - 1 && ci >= 128) { float* ok = F.out + O_WKP + (((size_t)(l * NB + b) * 128 + (ci - 128)) * 2 + kvh) * 64 + c8 * 8;
                *(f32x4*)ok = (f32x4){r1[0], r1[1], r1[2], r1[3]}; *(f32x4*)(ok + 4) = (f32x4){r1[4], r1[5], r1[6], r1[7]};
                *(f32x4*)(ok + 32) = (f32x4){r2[0], r2[1], r2[2], r2[3]}; *(f32x4*)(ok + 36) = (f32x4){r2[4], r2[5], r2[6], r2[7]}; } }
        *(LAS v4u*)(L + O_KR + (ci * RK + c8 * 8) * 2) = w1; *(LAS v4u*)(L + O_KR + (ci * RK + 32 + c8 * 8) * 2) = w2; }
    { const int d = tid & 63, kg = tid >> 6;
#pragma unroll
      for (int q4 = 0; q4 < 4; ++q4) { unsigned w[4];
#pragma unroll
          for (int e = 0; e < 4; ++e) { const int ci = 32 * kg + 8 * q4 + 2 * e, kp = p0 + ci; unsigned short a = 0, c = 0;
              if (kp >= 0) { a = P[(size_t)(b * SEQ + kp) * PIN + C_V + kvh * 64 + d]; c = P[(size_t)(b * SEQ + kp + 1) * PIN + C_V + kvh * 64 + d];
                  if (jb == SEQ / 128 - 1 && ci >= 128) { float* ov = F.out + O_WVP + (((size_t)(l * NB + b) * 128 + (ci - 128)) * 2 + kvh) * 64 + d; ov[0] = bf2f(a); ov[128] = bf2f(c); } }
              w[e] = (unsigned)a | ((unsigned)c << 16); }
          *(LAS v4u*)(L + O_VT + (d * RV + 32 * kg + 8 * q4) * 2) = (v4u){w[0], w[1], w[2], w[3]}; } }
    LDS_BAR();
    const int g = wave >> 1, h = kvh * 4 + g;
    const float sink2 = F.in[IN_SINK][l * 8 + h] * 1.4426950408889634f;
#pragma unroll 1
    for (int s = 0; s < 2; ++s) {
        const int r0 = 64 * (wave & 1) + 32 * s;
        const int t = jb * 128 + r0 + l32;
        bf16x8 qf[4];
        { const bf16* qr = P + (size_t)(b * SEQ + t) * PIN + h * 64 + 8 * hh;
          float x[4][8]; unpack8(*(const v4u*)qr, x[0]); unpack8(*(const v4u*)(qr + 16), x[1]); unpack8(*(const v4u*)(qr + 32), x[2]); unpack8(*(const v4u*)(qr + 48), x[3]);
          const float qs = 0.125f * 1.4426950408889634f;
#pragma unroll
          for (int ks = 0; ks < 2; ++ks) { float cc[8], ss[8]; load8f(cs + t * 32 + 16 * ks + 8 * hh, cc); load8f(sn + t * 32 + 16 * ks + 8 * hh, ss); float r1[8], r2[8];
#pragma unroll
              for (int e = 0; e < 8; ++e) { r1[e] = (x[ks][e] * cc[e] - x[ks + 2][e] * ss[e]) * qs; r2[e] = (x[ks + 2][e] * cc[e] + x[ks][e] * ss[e]) * qs; }
              qf[ks] = __builtin_bit_cast(bf16x8, (v4u){cvtpk(r1[0], r1[1]), cvtpk(r1[2], r1[3]), cvtpk(r1[4], r1[5]), cvtpk(r1[6], r1[7])});
              qf[ks + 2] = __builtin_bit_cast(bf16x8, (v4u){cvtpk(r2[0], r2[1]), cvtpk(r2[2], r2[3]), cvtpk(r2[4], r2[5]), cvtpk(r2[6], r2[7])}); } }
        f32x16 sc[5];
#pragma unroll
        for (int kt = 0; kt < 5; ++kt) {
#pragma unroll
            for (int r = 0; r < 16; ++r) sc[kt][r] = 0.f;
#pragma unroll
            for (int ks = 0; ks < 4; ++ks) { const bf16x8 A = *(const LAS bf16x8*)(L + O_KR + ((r0 + 32 * kt + l32) * RK + 16 * ks + 8 * hh) * 2); sc[kt] = MFMA32(A, qf[ks], sc[kt]); }
            __builtin_amdgcn_sched_barrier(0);
        }
        const int kt_lo = (jb == 0) ? 4 - (r0 >> 5) : 0;
        float mx = sink2;
#pragma unroll
        for (int kt = 0; kt < 5; ++kt)
#pragma unroll
            for (int r = 0; r < 16; ++r) { const int kl = 8 * (r >> 2) + 4 * hh + (r & 3);
                bool ok = kt >= kt_lo; if (kt == 0) ok = ok && (kl >= l32); if (kt == 4) ok = ok && (kl <= l32);
                const float v = ok ? sc[kt][r] : -INFINITY; sc[kt][r] = v; mx = fmaxf(mx, v); }
        mx = fmaxf(mx, __shfl_xor(mx, 32));
        float sum = 0.f;
#pragma unroll
        for (int kt = 0; kt < 5; ++kt)
#pragma unroll
            for (int r = 0; r < 16; ++r) { const float p = __builtin_amdgcn_exp2f(sc[kt][r] - mx); sc[kt][r] = p; sum += p; }
        sum += __shfl_xor(sum, 32);
        const float inv = 1.f / (sum + __builtin_amdgcn_exp2f(sink2 - mx));
        f32x16 o[2];
#pragma unroll
        for (int dt = 0; dt < 2; ++dt) {
#pragma unroll
            for (int r = 0; r < 16; ++r) o[dt][r] = 0.f; }
#pragma unroll
        for (int kt = 0; kt < 5; ++kt) {
#pragma unroll
            for (int j = 0; j < 2; ++j) {
                const v4u bp = {cvtpk(sc[kt][8 * j], sc[kt][8 * j + 1]), cvtpk(sc[kt][8 * j + 2], sc[kt][8 * j + 3]), cvtpk(sc[kt][8 * j + 4], sc[kt][8 * j + 5]), cvtpk(sc[kt][8 * j + 6], sc[kt][8 * j + 7])};
#pragma unroll
                for (int dt = 0; dt < 2; ++dt) {
                    const v2u lo = *(const LAS v2u*)(L + O_VT + ((32 * dt + l32) * RV + r0 + 32 * kt + 16 * j + 4 * hh) * 2);
                    const v2u hi = *(const LAS v2u*)(L + O_VT + ((32 * dt + l32) * RV + r0 + 32 * kt + 16 * j + 8 + 4 * hh) * 2);
                    o[dt] = MFMA32(__builtin_bit_cast(bf16x8, (v4u){lo.x, lo.y, hi.x, hi.y}), __builtin_bit_cast(bf16x8, bp), o[dt]);
                }
            }
            __builtin_amdgcn_sched_barrier(0);
        }
        bf16* orow = MIX + (size_t)(b * SEQ + t) * DM + h * 64 + 4 * hh;
#pragma unroll
        for (int dt = 0; dt < 2; ++dt)
#pragma unroll
            for (int g4 = 0; g4 < 4; ++g4) { v2u w; w.x = cvtpk(o[dt][4 * g4] * inv, o[dt][4 * g4 + 1] * inv); w.y = cvtpk(o[dt][4 * g4 + 2] * inv, o[dt][4 * g4 + 3] * inv);
                *(v2u*)(orow + 32 * dt + 8 * g4) = w; }
    }
}

#define MFMA16(a, b, c) __builtin_amdgcn_mfma_f32_16x16x32_bf16((a), (b), (c), 0, 0, 0)
__device__ __forceinline__ void xattn_unit_prompt(Frame& F, int l, int b, int h, int qb) {
    unsigned char* ws = F.ws; const bf16* QX = (const bf16*)(ws + WS_QX); bf16* OX = (bf16*)(ws + WS_OX);
    const bf16* MK = (const bf16*)(ws + WS_MK) + ((size_t)l * 2048 + b * 256) * DM + h * 256;
    const bf16* MVT = (const bf16*)(ws + WS_MVT) + ((size_t)((l * NB + b) * 4 + h) * 256) * 256;
    constexpr int RKX = 264, RVX = 68;
    constexpr int TILE_K = 64 * RKX * 2, TILE_V = 256 * RVX * 2;
    static_assert(2 * TILE_V <= 100 * 1024, "xattn LDS map");
    LAS unsigned char* L = F.lds + RING_OFF;
    const int tid = F.tid, lane = F.lane, wave = F.wave;
    const int l32 = lane & 31, hh = lane >> 5;
    const int row = b * SEQ + qb * 256 + wave * 32 + l32;
    bf16x8 qf[16];
    { const bf16* qr = QX + (size_t)row * DM + h * 256 + 8 * hh;
#pragma unroll
      for (int ks = 0; ks < 16; ++ks) qf[ks] = *(const bf16x8*)(qr + 16 * ks); }
    v4u pre[2];
    bf16x8 pf[16];
    float tmx[4], runM = -INFINITY, runL = 0.f;
    unsigned koff[4];
#pragma unroll
    for (int j_ = 0; j_ < 4; ++j_) { const int ch_ = tid + 512 * j_; koff[j_] = (unsigned)(((ch_ >> 5) * DM + 8 * (ch_ & 31)) * 2); }
#define XK_LOAD(mt, hf) do { const char* kb_ = (const char*)MK + (size_t)(64 * (mt)) * DM * 2; _Pragma("unroll") for (int j_ = 0; j_ < 2; ++j_) pre[j_] = *(const v4u*)(kb_ + koff[2 * (hf) + j_]); } while (0)
#define XK_STORE(buf, hf) do { _Pragma("unroll") for (int j_ = 0; j_ < 2; ++j_) { const int ch_ = tid + 512 * (2 * (hf) + j_); *(LAS v4u*)(L + (buf) * TILE_K + ((ch_ >> 5) * RKX + 8 * (ch_ & 31)) * 2) = pre[j_]; } } while (0)
    LDS_BAR();
    XK_LOAD(0, 0); XK_STORE(0, 0); XK_LOAD(0, 1); XK_STORE(0, 1);
#pragma unroll
    for (int mt = 0; mt < 4; ++mt) {
        LDS_BAR();
        LAS unsigned char* kbp = L + (mt & 1) * TILE_K + (l32 * RKX + 8 * hh) * 2; asm volatile("" : "+v"(kbp));
        f32x16 sc[2];
#pragma unroll
        for (int i = 0; i < 2; ++i) {
            if (mt + 1 < 4) XK_LOAD(mt + 1, i);
#pragma unroll
            for (int r = 0; r < 16; ++r) sc[i][r] = 0.f;
#pragma unroll
            for (int ks = 0; ks < 16; ++ks) { const bf16x8 A = *(const LAS bf16x8*)(kbp + (32 * i * RKX + 16 * ks) * 2); sc[i] = MFMA32(A, qf[ks], sc[i]);
                if ((ks & 3) == 3) __builtin_amdgcn_sched_barrier(0); }
            if (mt + 1 < 4) XK_STORE((mt + 1) & 1, i);
        }
        float m_ = -INFINITY;
#pragma unroll
        for (int i = 0; i < 2; ++i)
#pragma unroll
            for (int r = 0; r < 16; ++r) m_ = fmaxf(m_, sc[i][r]);
        m_ = fmaxf(m_, __shfl_xor(m_, 32));
        float s_ = 0.f;
#pragma unroll
        for (int i = 0; i < 2; ++i) {
#pragma unroll
            for (int r = 0; r < 16; ++r) { const float p = __builtin_amdgcn_exp2f(sc[i][r] - m_); sc[i][r] = p; s_ += p; }
#pragma unroll
            for (int j = 0; j < 2; ++j) pf[4 * mt + 2 * i + j] = __builtin_bit_cast(bf16x8, (v4u){cvtpk(sc[i][8 * j], sc[i][8 * j + 1]), cvtpk(sc[i][8 * j + 2], sc[i][8 * j + 3]), cvtpk(sc[i][8 * j + 4], sc[i][8 * j + 5]), cvtpk(sc[i][8 * j + 6], sc[i][8 * j + 7])});
        }
        tmx[mt] = m_; { const float nM = fmaxf(runM, m_); runL = runL * __builtin_amdgcn_exp2f(runM - nM) + s_ * __builtin_amdgcn_exp2f(m_ - nM); runM = nM; }
    }
#undef XK_LOAD
#undef XK_STORE
    const float mx = runM;
    float sum = runL;
#pragma unroll
    for (int mt = 0; mt < 4; ++mt) { const float scl_ = __builtin_amdgcn_exp2f(tmx[mt] - mx);
#pragma unroll
        for (int f = 0; f < 4; ++f) { const v4u w = __builtin_bit_cast(v4u, pf[4 * mt + f]);
            pf[4 * mt + f] = __builtin_bit_cast(bf16x8, (v4u){cvtpk(bflo(w.x) * scl_, bfhi(w.x) * scl_), cvtpk(bflo(w.y) * scl_, bfhi(w.y) * scl_), cvtpk(bflo(w.z) * scl_, bfhi(w.z) * scl_), cvtpk(bflo(w.w) * scl_, bfhi(w.w) * scl_)}); } }
    sum += __shfl_xor(sum, 32);
    const float inv = 1.f / sum;
    constexpr int TILE_H = 128 * RVX * 2;
    unsigned voff[2];
#pragma unroll
    for (int j_ = 0; j_ < 2; ++j_) { const int ch_ = tid + 512 * j_; voff[j_] = (unsigned)(((ch_ >> 3) * 256 + 8 * (ch_ & 7)) * 2); }
#define XV_LOAD(st) do { const char* vb_ = (const char*)MVT + ((size_t)(128 * ((st) >> 2)) * 256 + 64 * ((st) & 3)) * 2; _Pragma("unroll") for (int j_ = 0; j_ < 2; ++j_) pre[j_] = *(const v4u*)(vb_ + voff[j_]); } while (0)
#define XV_STORE(buf) do { _Pragma("unroll") for (int j_ = 0; j_ < 2; ++j_) { const int ch_ = tid + 512 * j_; LAS unsigned char* d_ = L + (buf) * TILE_H + ((ch_ >> 3) * RVX + 8 * (ch_ & 7)) * 2; *(LAS v2u*)d_ = (v2u){pre[j_].x, pre[j_].y}; *(LAS v2u*)(d_ + 8) = (v2u){pre[j_].z, pre[j_].w}; } } while (0)
    XV_LOAD(0);
    LDS_BAR();
    XV_STORE(0);
    bf16* orow = OX + (size_t)row * DM + h * 256 + 4 * hh;
#pragma unroll
    for (int dh = 0; dh < 2; ++dh) {
        f32x16 o[4];
#pragma unroll
        for (int i = 0; i < 4; ++i)
#pragma unroll
            for (int r = 0; r < 16; ++r) o[i][r] = 0.f;
#pragma unroll
        for (int mt = 0; mt < 4; ++mt) {
            const int st = 4 * dh + mt;
            if (st + 1 < 8) XV_LOAD(st + 1);
            LDS_BAR();
            LAS unsigned char* vbp = L + (st & 1) * TILE_H + (l32 * RVX + 4 * hh) * 2; asm volatile("" : "+v"(vbp));
#pragma unroll
            for (int dt = 0; dt < 4; ++dt) {
#pragma unroll
                for (int k4 = 0; k4 < 4; ++k4) {
                    const v2u lo = *(const LAS v2u*)(vbp + (32 * dt * RVX + 16 * k4) * 2);
                    const v2u hi = *(const LAS v2u*)(vbp + (32 * dt * RVX + 16 * k4 + 8) * 2);
                    o[dt] = MFMA32(__builtin_bit_cast(bf16x8, (v4u){lo.x, lo.y, hi.x, hi.y}), pf[4 * mt + k4], o[dt]);
                }
                __builtin_amdgcn_sched_barrier(0);
            }
            if (st + 1 < 8) XV_STORE((st + 1) & 1);
        }
#pragma unroll
        for (int dt = 0; dt < 4; ++dt)
#pragma unroll
            for (int g = 0; g < 4; ++g) { v2u w; w.x = cvtpk(o[dt][4 * g] * inv, o[dt][4 * g + 1] * inv); w.y = cvtpk(o[dt][4 * g + 2] * inv, o[dt][4 * g + 3] * inv); *(v2u*)(orow + 128 * dh + 32 * dt + 8 * g) = w; }
    }
#undef XV_LOAD
#undef XV_STORE
}

template <int K>
__device__ __forceinline__ void sample_slice_gemm(Frame& F, const bf16* A, const bf16* Wt, float* Yf, bf16* Qb, float sc, const float* rs = nullptr) {
    const int lane = F.lane, l16 = lane & 15, hq = lane >> 4, wave = F.wave;
    const int rg = blockIdx.x & 7, cs = blockIdx.x >> 3;
    constexpr int NKS = (K >> 5) / 8;
    const GAS bf16* ap = (const GAS bf16*)A + (size_t)(16 * rg + l16) * K + 8 * hq + 32 * NKS * wave;
    const GAS bf16* wp = (const GAS bf16*)Wt + (size_t)(32 * cs + l16) * K + 8 * hq + 32 * NKS * wave;
    f32x4 acc0 = {0.f, 0.f, 0.f, 0.f}, acc1 = acc0;
    bf16x8 a[NKS], b0[NKS], b1[NKS];
#pragma unroll
    for (int i = 0; i < NKS; ++i) { a[i] = *(const GAS bf16x8*)(ap + 32 * i); b0[i] = *(const GAS bf16x8*)(wp + 32 * i); b1[i] = *(const GAS bf16x8*)(wp + (size_t)16 * K + 32 * i); }
#pragma unroll
    for (int i = 0; i < NKS; ++i) { acc0 = MFMA16(a[i], b0[i], acc0); acc1 = MFMA16(a[i], b1[i], acc1); }
    LAS f32x4* red = (LAS f32x4*)(F.lds + RING_OFF);
    LDS_BAR();
    red[(wave * 2 + 0) * 64 + lane] = acc0; red[(wave * 2 + 1) * 64 + lane] = acc1;
    LDS_BAR();
    if (wave < 2) {
        f32x4 s = {0.f, 0.f, 0.f, 0.f};
#pragma unroll
        for (int w = 0; w < 8; ++w) s = s + red[(w * 2 + wave) * 64 + lane];
        const int n = 32 * cs + 16 * wave + l16;
#pragma unroll
        for (int e = 0; e < 4; ++e) { const size_t off = (size_t)(MP + 16 * rg + 4 * hq + e) * DM + n;
            const float rv = rs ? rs[16 * rg + 4 * hq + e] : 1.f;
            if (Yf) Yf[off] = s[e] * rv; else Qb[off] = (bf16)(cvtpk(s[e] * sc * rv, 0.f) & 0xffffu); }
    }
    LDS_BAR();
}

#ifndef MK_PER_PHASE
#define MK_PER_PHASE 0
#endif
#ifndef EN_CONV
#define EN_CONV 1
#endif
#ifndef EN_DOWN
#define EN_DOWN 1
#endif
#ifndef EN_INPROJ
#define EN_INPROJ 1
#endif
#ifndef EN_MEMKV
#define EN_MEMKV 1
#endif
#ifndef EN_MIX
#define EN_MIX 1
#endif
#ifndef EN_NORM
#define EN_NORM 1
#endif
#ifndef EN_PROLOG
#define EN_PROLOG 1
#endif
#ifndef EN_UP
#define EN_UP 1
#endif
#ifndef EN_WO
#define EN_WO 1
#endif
#ifndef EN_XATTN
#define EN_XATTN 1
#endif
#ifndef EN_XO
#define EN_XO 1
#endif
#ifndef EN_XQ
#define EN_XQ 1
#endif
#ifndef HGRN_NAIVE
#define HGRN_NAIVE 0
#endif
#ifndef DUP_PROLOG
#define DUP_PROLOG 0
#endif
#ifndef DUP_UP
#define DUP_UP 0
#endif
#ifndef DUP_WO
#define DUP_WO 0
#endif
#ifndef DUP_DOWN
#define DUP_DOWN 0
#endif
#ifndef DUP_P1
#define DUP_P1 0
#endif
#ifndef DUP_SWA
#define DUP_SWA 0
#endif
#ifndef DUP_SMP
#define DUP_SMP 0
#endif
#ifndef DUP_XP
#define DUP_XP 0
#endif
#ifndef DUP_XS
#define DUP_XS 0
#endif
#ifndef DUP_MIXB
#define DUP_MIXB 0
#endif
#ifndef DUP_MIX
#define DUP_MIX 0
#endif
#ifndef DUP_XATTN
#define DUP_XATTN 0
#endif
#ifndef DUP_CONV
#define DUP_CONV 0
#endif
#ifndef DUP_INPROJ
#define DUP_INPROJ 0
#endif
constexpr int N_PHASES = 2 + 13 * DEPTH;

struct Args { const float* in[29]; float* out; unsigned char* ws; int ph_lo, ph_hi; };

__global__ void __launch_bounds__(NTHR, 2) mk_fwd(Args args) {
    extern __shared__ __attribute__((aligned(16))) unsigned char lds[];
    Frame F;
    F.lds = (LAS unsigned char*)lds;
    F.MISC = (volatile LAS unsigned*)(F.lds + MISC_OFF);
    F.tid = threadIdx.x; F.lane = F.tid & 63; F.wave = __builtin_amdgcn_readfirstlane(F.tid >> 6);
    F.G = gridDim.x; F.gw = blockIdx.x * NWAVES + F.wave; F.ngw = F.G * NWAVES;
    F.ws = args.ws; F.out = args.out; F.ctl = (unsigned*)(args.ws + WS_CTL);
    F.in = args.in;
    for (int u = F.tid; u < (LDS_BYTES - LDSCTL_OFF) / 4; u += NTHR) ((LAS unsigned*)(F.lds + LDSCTL_OFF))[u] = 0u;
    __syncthreads();
    XcdBarrier bar = xcd_barrier_post(F.ctl + CW_BAR, F.MISC + 8);
    const int lo = args.ph_lo, hi = args.ph_hi;
    unsigned char* ws = args.ws; int bx = blockIdx.x;
#define FRESH() do { bx = blockIdx.x; F.vcu = (bx & 7) * (GRID / 8) + (bx >> 3); F.lane = (int)__builtin_amdgcn_mbcnt_hi(~0u, __builtin_amdgcn_mbcnt_lo(~0u, 0u)); F.tid = F.wave * 64 + F.lane; asm volatile("" : "+s"(ws), "+v"(F.tid), "+v"(F.lane), "+s"(F.wave), "+s"(F.gw), "+s"(bx), "+s"(F.vcu)); F.ws = ws; } while (0)
#define IN(k) (lo <= (k) && (k) < hi)
#define SEAM(k) do { if (IN((k) + 1)) xcd_barrier(bar); } while (0)
    LAS float* wl = (LAS float*)(F.lds + RING_OFF + 102400 + F.wave * 2048);

    if (EN_PROLOG && IN(0)) { _Pragma("unroll 1") for (int rep_ = 0; rep_ <= DUP_PROLOG; ++rep_) { FRESH(); p0_prologue(F); } SEAM(0); }
    if (EN_MEMKV && IN(1)) { FRESH();
        pg8::Gemm g{(const pg8::bf16_t*)(ws + WS_MEMN), (const pg8::bf16_t*)(ws + WS_WXKV), DEPTH * 2048, DEPTH * 2048, DM};
        pg8::BlockDiagOrder S{F.G, bx};
        pg8::EpiMemKV E{F.out + O_MKP, F.out + O_MVP, (pg8::bf16_t*)(ws + WS_MK), (pg8::bf16_t*)(ws + WS_MVT)};
        pg8::gemm_phase<pg8::EpiMemKV, pg8::BlockDiagOrder, true, true>(F.lds + RING_OFF, g, S, E, F.wave);
        SEAM(1);
    }
    for (int l = 0; l < DEPTH; ++l) {
        const int pb = 2 + 13 * l;
        if (EN_INPROJ && IN(pb + 0)) { FRESH();
            pg8::Gemm g{(const pg8::bf16_t*)(ws + WS_XN), (const pg8::bf16_t*)(ws + WS_WIN) + (size_t)l * PIN * DM, MT, PIN, DM};
            pg8::StaticOrder S; S.init(MT, PIN, F.G, bx);
            pg8::EpiProj E{(pg8::bf16_t*)(ws + WS_PROJ), (float*)(ws + WS_LF), (const float*)(ws + WS_TAB + TAB_LB) + l * 512, (pg8::bf16_t*)(ws + WS_HQ), (pg8::bf16_t*)(ws + WS_HK), (pg8::bf16_t*)(ws + WS_HV), (float*)(ws + WS_HLF)};
            _Pragma("unroll 1") for (int rep_ = 0; rep_ <= DUP_INPROJ; ++rep_) pg8::gemm_phase<pg8::EpiProj, pg8::StaticOrder, true, true>(F.lds + RING_OFF, g, S, E, F.wave);
            SEAM(pb + 0);
        }
        if (EN_MIX && IN(pb + 1)) { FRESH();
          _Pragma("unroll 1") for (int rep_ = 0; rep_ <= DUP_MIX; ++rep_) { FRESH();
            _Pragma("unroll 1") for (int r2_ = 0; r2_ <= DUP_P1; ++r2_) { FRESH(); for (int u = F.vcu; u < NB * 4 * 8; u += F.G) hgrn_pass1(F, l, u >> 5, (u >> 3) & 3, u & 7); }
            _Pragma("unroll 1") for (int r2_ = 0; r2_ <= DUP_SWA; ++r2_) { FRESH(); for (int u = F.vcu; u < NB * 2 * 16; u += F.G) swa_unit_prompt(F, l, u >> 5, (u >> 4) & 1, u & 15); }
            _Pragma("unroll 1") for (int r2_ = 0; r2_ <= DUP_SMP; ++r2_) { FRESH(); if (bx < DB) hgrn_unit_sample(F, l, bx); else if (bx < 2 * DB) swa_unit_sample(F, l, bx - DB); }
          }
            SEAM(pb + 1);
        }
        if (EN_MIX && IN(pb + 2)) { FRESH();
            _Pragma("unroll 1") for (int rep_ = 0; rep_ <= DUP_MIXB; ++rep_) { FRESH(); for (int u = F.vcu; u < NB * 4 * 8; u += F.G) hgrn_pass2(F, l, u >> 5, (u >> 3) & 3, u & 7); }
            SEAM(pb + 2);
        }
        if (EN_WO && IN(pb + 3)) { FRESH();
            sample_slice_gemm<DM>(F, (const bf16*)(ws + WS_MIX) + (size_t)MP * DM, (const bf16*)(ws + WS_WO) + (size_t)l * DM * DM, nullptr, (bf16*)(ws + WS_Y), 1.f);
            pg8::Gemm g{(const pg8::bf16_t*)(ws + WS_MIX), (const pg8::bf16_t*)(ws + WS_WO) + (size_t)l * DM * DM, MP, DM, DM};
            pg8::StaticOrder S; S.init(MP, DM, F.G, bx);
            pg8::EpiB16 E{(pg8::bf16_t*)(ws + WS_Y), DM, 1.0f, nullptr};
            _Pragma("unroll 1") for (int rep_ = 0; rep_ <= DUP_WO; ++rep_) pg8::gemm_phase<pg8::EpiB16, pg8::StaticOrder, true, true>(F.lds + RING_OFF, g, S, E, F.wave);
            SEAM(pb + 3);
        }
        if (EN_NORM && IN(pb + 4)) { FRESH(); norm_phase(F, F.in[IN_GQM] + l * DM, nullptr, false); SEAM(pb + 4); }
        if (EN_XQ && IN(pb + 5)) { FRESH();
            sample_slice_gemm<DM>(F, (const bf16*)(ws + WS_X) + (size_t)MP * DM, (const bf16*)(ws + WS_WXQ) + (size_t)l * DM * DM, nullptr, (bf16*)(ws + WS_QX), 0.0625f * 1.4426950408889634f, (const float*)(ws + WS_RS) + MP);
            pg8::Gemm g{(const pg8::bf16_t*)(ws + WS_X), (const pg8::bf16_t*)(ws + WS_WXQ) + (size_t)l * DM * DM, MP, DM, DM};
            pg8::StaticOrder S; S.init(MP, DM, F.G, bx);
            pg8::EpiB16 E{(pg8::bf16_t*)(ws + WS_QX), DM, 0.0625f * 1.4426950408889634f, (const float*)(ws + WS_RS)};
            pg8::gemm_phase<pg8::EpiB16, pg8::StaticOrder, true, true>(F.lds + RING_OFF, g, S, E, F.wave);
            SEAM(pb + 5);
        }
        if (EN_XATTN && IN(pb + 6)) { FRESH();
          _Pragma("unroll 1") for (int rep_ = 0; rep_ <= DUP_XATTN; ++rep_) { FRESH();
            if ((bx >> 3) & 1) for (int u = bx; u < DB * 4; u += F.G) xattn_unit_sample(F, l, u >> 2, u & 3);
            _Pragma("unroll 1") for (int r2_ = 0; r2_ <= DUP_XP; ++r2_) { FRESH(); for (int u = F.vcu; u < NB * 4 * 8; u += F.G) xattn_unit_prompt(F, l, u >> 5, (u >> 3) & 3, u & 7); }
            if (!((bx >> 3) & 1)) for (int u = bx; u < DB * 4; u += F.G) xattn_unit_sample(F, l, u >> 2, u & 3);
            _Pragma("unroll 1") for (int r2_ = 0; r2_ < DUP_XS; ++r2_) { FRESH(); for (int u = bx; u < DB * 4; u += F.G) xattn_unit_sample(F, l, u >> 2, u & 3); }
          }
            SEAM(pb + 6);
        }
        if (EN_XO && IN(pb + 7)) { FRESH();
            sample_slice_gemm<DM>(F, (const bf16*)(ws + WS_OX) + (size_t)MP * DM, (const bf16*)(ws + WS_WXO) + (size_t)l * DM * DM, nullptr, (bf16*)(ws + WS_Y), 1.f);
            pg8::Gemm g{(const pg8::bf16_t*)(ws + WS_OX), (const pg8::bf16_t*)(ws + WS_WXO) + (size_t)l * DM * DM, MP, DM, DM};
            pg8::StaticOrder S; S.init(MP, DM, F.G, bx);
            pg8::EpiB16 E{(pg8::bf16_t*)(ws + WS_Y), DM, 1.0f, nullptr};
            pg8::gemm_phase<pg8::EpiB16, pg8::StaticOrder, true, true>(F.lds + RING_OFF, g, S, E, F.wave);
            SEAM(pb + 7);
        }
        if (EN_NORM && IN(pb + 8)) { FRESH(); norm_phase(F, F.in[IN_GQX] + l * DM, nullptr, false); SEAM(pb + 8); }
        if (EN_UP && IN(pb + 9)) { FRESH();
            pg8::Gemm g{(const pg8::bf16_t*)(ws + WS_X), (const pg8::bf16_t*)(ws + WS_WUP) + (size_t)l * UPW * DM, MT, UPW, DM};
            pg8::StaticOrder S; S.init(MT, UPW, F.G, bx);
            pg8::EpiUpConv E{(pg8::bf16_t*)(ws + WS_G), (pg8::bf16_t*)(ws + WS_U), (pg8::bf16_t*)(ws + WS_U) + (size_t)256 * 4 * UPW, (const float*)(ws + WS_RS), F.in[IN_CW] + (size_t)l * 3 * UPW, F.in[IN_CB] + (size_t)l * UPW};
            pg8::gemm_phase<pg8::EpiUpConv, pg8::StaticOrder, true, true>(F.lds + RING_OFF, g, S, E, F.wave);
            SEAM(pb + 9);
        }
        if (EN_CONV && IN(pb + 10)) { FRESH(); _Pragma("unroll 1") for (int rep_ = 0; rep_ <= DUP_CONV; ++rep_) { FRESH(); conv_phase(F, l); } SEAM(pb + 10); }
        if (EN_DOWN && IN(pb + 11)) { FRESH();
            sample_slice_gemm<DFF>(F, (const bf16*)(ws + WS_G) + (size_t)MP * DFF, (const bf16*)(ws + WS_WDN) + (size_t)l * DM * DFF, nullptr, (bf16*)(ws + WS_Y), 1.f);
            pg8::Gemm g{(const pg8::bf16_t*)(ws + WS_G), (const pg8::bf16_t*)(ws + WS_WDN) + (size_t)l * DM * DFF, MP, DM, DFF};
            pg8::StaticOrder S; S.init(MP, DM, F.G, bx);
            pg8::EpiB16 E{(pg8::bf16_t*)(ws + WS_Y), DM, 1.0f, nullptr};
            _Pragma("unroll 1") for (int rep_ = 0; rep_ <= DUP_DOWN; ++rep_) pg8::gemm_phase<pg8::EpiB16, pg8::StaticOrder, true, true>(F.lds + RING_OFF, g, S, E, F.wave);
            SEAM(pb + 11);
        }
        if (EN_NORM && IN(pb + 12)) { FRESH(); norm_phase(F, F.in[IN_GQF] + l * DM, F.in[IN_GPM] + (l + 1 < DEPTH ? l + 1 : 0) * DM, l == DEPTH - 1); SEAM(pb + 12); }
    }
#undef IN
#undef SEAM
}

extern "C" void kernel_launch(void* const* d_in, const int* in_sizes, int n_in, void* d_out, int out_size, void* d_ws, size_t ws_size, hipStream_t stream) {
    static int grid = 0;
    if (grid == 0) {
        if (n_in != 29 || (size_t)out_size != O_END || ws_size < WS_END) { fprintf(stderr, "kernel_launch: unexpected shapes (n_in %d out %d ws %zu need %zu)\n", n_in, out_size, ws_size, (size_t)WS_END); grid = -1; return; }
        int dev = 0, cus = 0, per_cu = 0;
        if (hipGetDevice(&dev) != hipSuccess || hipDeviceGetAttribute(&cus, hipDeviceAttributeMultiprocessorCount, dev) != hipSuccess) { grid = -1; return; }
        if (hipFuncSetAttribute((const void*)mk_fwd, hipFuncAttributeMaxDynamicSharedMemorySize, LDS_BYTES) != hipSuccess) { fprintf(stderr, "kernel_launch: hipFuncSetAttribute failed\n"); grid = -1; return; }
        if (hipOccupancyMaxActiveBlocksPerMultiprocessor(&per_cu, (const void*)mk_fwd, NTHR, LDS_BYTES) != hipSuccess || per_cu < 1) fprintf(stderr, "kernel_launch: occupancy query says %d\n", per_cu);
        (void)hipGetLastError();
        if (cus < GRID) { fprintf(stderr, "kernel_launch: %d CUs; this kernel needs %d (one resident workgroup per CU)\n", cus, GRID); grid = -1; return; }
        grid = GRID;
    }
    if (grid < 0) return;
    if (hipMemsetAsync((char*)d_ws + WS_CTL, 0, CTL_ZERO_BYTES, stream) != hipSuccess) return;
    Args a{};
    for (int i = 0; i < 29; ++i) a.in[i] = (const float*)d_in[i];
    a.out = (float*)d_out; a.ws = (unsigned char*)d_ws;
#if MK_PER_PHASE
    for (int p = 0; p < N_PHASES; ++p) { a.ph_lo = p; a.ph_hi = p + 1; hipLaunchKernelGGL(mk_fwd, dim3(grid), dim3(NTHR), LDS_BYTES, stream, a); }
#else
    a.ph_lo = 0; a.ph_hi = N_PHASES; hipLaunchKernelGGL(mk_fwd, dim3(grid), dim3(NTHR), LDS_BYTES, stream, a);
#endif
}
```
